# Optimizing an MI355X kernel written in HIP

```python
import math
import jax, jax.numpy as jnp
from jax import lax
import numpy as np

D_MODEL = 1024
BATCH = 8
SEQ = 2048
DEPTH = 4

N_MIXERS = 4
EXPAND = 2
D_INNER = EXPAND * D_MODEL
NORM_EPS = 1e-6
ROPE_THETA = 10000.0
Q_BLOCK = 128

A_HEADS = 16
A_HEAD_DIM = D_INNER // A_HEADS
A_IDX_HEADS = 16
A_IDX_DIM = 64
A_TOPK_MAX = 256
A_SPLITS = (A_HEADS * A_HEAD_DIM, A_HEAD_DIM, A_HEAD_DIM, A_IDX_HEADS * A_IDX_DIM, A_IDX_DIM, A_IDX_HEADS, D_INNER)

B_HEADS = 16
B_HEAD_DIM = D_INNER // B_HEADS
B_CONFIGS = ((128, 1), (512, 4), (2048, 16))

C_HEADS = 8
C_QK_DIM = D_MODEL // C_HEADS
C_V_DIM = D_INNER // C_HEADS
C_CHUNK = 128
C_SPLITS = (C_HEADS * C_QK_DIM, C_HEADS * C_QK_DIM, D_INNER, D_INNER)

D_HEADS = 16
D_K_DIM = D_INNER // D_HEADS
D_V_DIM = D_INNER // D_HEADS
D_CHUNK = 64

kernel_name = "hybrid_dsa_dilated_retnet_hgrn2_trunk"


def _n_layers_of(kind):
    return len(range(kind, DEPTH, N_MIXERS))


def rmsnorm(x, g):
    x32 = x.astype(jnp.float32)
    y = x32 * lax.rsqrt(jnp.mean(x32 * x32, axis=-1, keepdims=True) + NORM_EPS)
    return (y * g.astype(jnp.float32)).astype(x.dtype)


def head_rmsnorm(x):
    x32 = x.astype(jnp.float32)
    return x32 * lax.rsqrt(jnp.mean(x32 * x32, axis=-1, keepdims=True) + NORM_EPS)


def rotary(x, pos):
    dh = x.shape[-1]
    freqs = ROPE_THETA ** (-jnp.arange(0, dh, 2, dtype=jnp.float32) / dh)
    ang = pos.astype(jnp.float32)[:, None] * freqs[None, :]
    cos = jnp.cos(ang)[:, None, :].astype(x.dtype)
    sin = jnp.sin(ang)[:, None, :].astype(x.dtype)
    x1, x2 = jnp.split(x, 2, axis=-1)
    return jnp.concatenate([x1 * cos - x2 * sin, x1 * sin + x2 * cos], axis=-1)


def _split(t, sizes):
    return jnp.split(t, np.cumsum(sizes)[:-1].tolist(), axis=-1)


def dsa_mixer(h, w_in, w_out):
    B_, S, _ = h.shape
    pos = jnp.arange(S)
    q, k, v, iq, ik, iw, z = _split(h @ w_in, A_SPLITS)
    q = rotary(q.reshape(B_, S, A_HEADS, A_HEAD_DIM), pos) * (A_HEAD_DIM ** -0.5)
    k = rotary(k.reshape(B_, S, 1, A_HEAD_DIM), pos)[:, :, 0]
    iq = rotary(iq.reshape(B_, S, A_IDX_HEADS, A_IDX_DIM), pos)
    ik = rotary(ik.reshape(B_, S, 1, A_IDX_DIM), pos)[:, :, 0]
    iw = iw * (A_IDX_HEADS ** -0.5 * A_IDX_DIM ** -0.5)
    top_k = min(A_TOPK_MAX, S // 4)
    nb = S // Q_BLOCK

    def blockify(t):
        return t.reshape(B_, nb, Q_BLOCK, *t.shape[2:]).swapaxes(0, 1)

    def one_block(args):
        qb, iqb, iwb, tb = args
        rel = jax.nn.relu(jnp.einsum('bqhd,bsd->bqsh', iqb, ik))
        score = jnp.einsum('bqsh,bqh->bqs', rel, iwb).astype(jnp.float32)
        causal = pos[None, None, :] <= tb[None, :, None]
        score = jnp.where(causal, score, -jnp.inf)
        _, sel = lax.top_k(score, top_k)
        valid = sel <= tb[None, :, None]
        k_sel = jax.vmap(lambda kk, ii: kk[ii])(k, sel)
        v_sel = jax.vmap(lambda vv, ii: vv[ii])(v, sel)
        s = jnp.einsum('bqhd,bqkd->bhqk', qb, k_sel).astype(jnp.float32)
        s = jnp.where(valid[:, None], s, -jnp.inf)
        p = jax.nn.softmax(s, axis=-1).astype(v.dtype)
        return jnp.einsum('bhqk,bqkd->bqhd', p, v_sel)

    tpos = pos.reshape(nb, Q_BLOCK)
    o = lax.map(one_block, (blockify(q), blockify(iq), blockify(iw), tpos))
    o = o.swapaxes(0, 1).reshape(B_, S, D_INNER)
    return (o * jax.nn.silu(z)) @ w_out


def _dilated_band_attention(q, k, v, window, dilation):
    B_, S, H, dh = q.shape
    L = S // dilation
    span = window // dilation
    blk = Q_BLOCK
    nb = -(-L // blk)
    Lp = nb * blk

    def residues(t):
        t = t.reshape(B_, L, dilation, H, dh).transpose(0, 2, 1, 3, 4)
        return jnp.pad(t, ((0, 0), (0, 0), (0, Lp - L), (0, 0), (0, 0)))

    def band(t):
        tp = jnp.pad(t, ((0, 0), (0, 0), (blk, 0), (0, 0), (0, 0))).reshape(B_, dilation, nb + 1, blk, H, dh)
        return jnp.concatenate([tp[:, :, :-1], tp[:, :, 1:]], axis=3)

    qb = residues(q).reshape(B_, dilation, nb, blk, H, dh)
    kb, vb = band(residues(k)), band(residues(v))
    s = jnp.einsum('brnqhd,brnkhd->brnqhk', qb, kb).astype(jnp.float32)
    qi = jnp.arange(blk)[:, None]
    ki = jnp.arange(2 * blk)[None, :]
    dist = blk + qi - ki
    key_m = jnp.arange(nb)[:, None, None] * blk - blk + ki[None]
    valid = (dist >= 0)[None] & (dist <= span)[None] & (key_m >= 0)
    s = jnp.where(valid[:, :, None, :], s, -jnp.inf)
    m = jnp.max(s, axis=-1, keepdims=True)
    p = jnp.exp(s - m)
    den = jnp.sum(p, axis=-1, keepdims=True)
    o = jnp.einsum('brnqhk,brnkhd->brnqhd', (p / den).astype(v.dtype), vb)
    lse = (m + jnp.log(den))[..., 0]
    o = o.reshape(B_, dilation, Lp, H, dh)[:, :, :L].transpose(0, 2, 1, 3, 4).reshape(B_, S, H, dh)
    lse = lse.reshape(B_, dilation, Lp, H)[:, :, :L].transpose(0, 2, 1, 3).reshape(B_, S, H)
    return o, lse


def dilated_mixer(h, w_in, w_out):
    B_, S, _ = h.shape
    pos = jnp.arange(S)
    q, k, v, z = jnp.split(h @ w_in, 4, axis=-1)
    q = rotary(q.reshape(B_, S, B_HEADS, B_HEAD_DIM), pos) * (B_HEAD_DIM ** -0.5)
    k = rotary(k.reshape(B_, S, B_HEADS, B_HEAD_DIM), pos)
    v = v.reshape(B_, S, B_HEADS, B_HEAD_DIM)
    outs, lses = [], []
    for window, dilation in B_CONFIGS:
        o_g, lse_g = _dilated_band_attention(q, k, v, window, dilation)
        outs.append(o_g.astype(jnp.float32))
        lses.append(lse_g)
    alpha = jax.nn.softmax(jnp.stack(lses), axis=0)
    o = jnp.einsum('gbsh,gbshd->bshd', alpha, jnp.stack(outs)).astype(h.dtype).reshape(B_, S, D_INNER)
    return (o * jax.nn.silu(z)) @ w_out


def retention_mixer(h, w_in, w_out):
    B_, S, _ = h.shape
    pos = jnp.arange(S)
    q, k, v, z = _split(h @ w_in, C_SPLITS)
    q = rotary(q.reshape(B_, S, C_HEADS, C_QK_DIM), pos).astype(jnp.float32)
    k = (rotary(k.reshape(B_, S, C_HEADS, C_QK_DIM), pos) * (C_QK_DIM ** -0.5)).astype(jnp.float32)
    v = v.reshape(B_, S, C_HEADS, C_V_DIM).astype(jnp.float32)
    log_gamma = jnp.log1p(-jnp.exp2(-5.0 - jnp.arange(C_HEADS, dtype=jnp.float32)))
    n = S // C_CHUNK
    qc = q.reshape(B_, n, C_CHUNK, C_HEADS, C_QK_DIM)
    kc = k.reshape(B_, n, C_CHUNK, C_HEADS, C_QK_DIM)
    vc = v.reshape(B_, n, C_CHUNK, C_HEADS, C_V_DIM)
    idx = jnp.arange(C_CHUNK, dtype=jnp.float32)
    rel = idx[:, None] - idx[None, :]
    decay = jnp.where(rel[None] >= 0, jnp.exp(jnp.maximum(rel, 0.0)[None] * log_gamma[:, None, None]), 0.0)
    scores = jnp.einsum('bnihd,bnjhd->bnhij', qc, kc) * decay
    o_intra = jnp.einsum('bnhij,bnjhe->bnihe', scores, vc)
    k_decay = jnp.exp((C_CHUNK - 1 - idx)[None, :] * log_gamma[:, None])
    kv = jnp.einsum('bnjhd,hj,bnjhe->bnhde', kc, k_decay, vc)
    chunk_decay = jnp.exp(C_CHUNK * log_gamma)[:, None, None]

    def step(state, kv_n):
        return state * chunk_decay + kv_n, state

    _, prev = lax.scan(step, jnp.zeros((B_, C_HEADS, C_QK_DIM, C_V_DIM), jnp.float32), kv.swapaxes(0, 1))
    prev = prev.swapaxes(0, 1)
    q_decay = jnp.exp((idx + 1.0)[None, :] * log_gamma[:, None])
    o_inter = jnp.einsum('bnihd,hi,bnhde->bnihe', qc, q_decay, prev)
    o = head_rmsnorm((o_intra + o_inter).reshape(B_, S, C_HEADS, C_V_DIM))
    o = o.reshape(B_, S, D_INNER).astype(h.dtype)
    return (o * jax.nn.silu(z)) @ w_out


def hgrn2_mixer(h, w_in, w_out, lower_bound):
    B_, S, _ = h.shape
    q, f, i, z = jnp.split(h @ w_in, 4, axis=-1)
    q = jax.nn.silu(q.astype(jnp.float32)) * (D_K_DIM ** -0.5)
    g = lower_bound + (1.0 - lower_bound) * jax.nn.sigmoid(f.astype(jnp.float32))
    log_f = jnp.log(g)
    k = 1.0 - g
    n = S // D_CHUNK

    def chunks(t, d):
        return t.reshape(B_, n, D_CHUNK, D_HEADS, d).swapaxes(0, 1)

    qs, ks, ls = chunks(q, D_K_DIM), chunks(k, D_K_DIM), chunks(log_f, D_K_DIM)
    vs = chunks(i.astype(jnp.float32), D_V_DIM)
    tri = jnp.arange(D_CHUNK)[:, None] >= jnp.arange(D_CHUNK)[None, :]

    def step(state, inp):
        qn, kn, vn, ln = inp
        b = jnp.cumsum(ln, axis=1)
        diff = jnp.where(tri[None, :, :, None, None], b[:, :, None] - b[:, None, :], -jnp.inf)
        a = jnp.einsum('bthk,bshk,btshk->bhts', qn, kn, jnp.exp(diff))
        o = jnp.einsum('bhts,bshv->bthv', a, vn) + jnp.einsum('bthk,bhkv->bthv', qn * jnp.exp(b), state)
        b_last = b[:, -1]
        new_state = state * jnp.exp(b_last)[..., None] + jnp.einsum('bshk,bshv->bhkv', kn * jnp.exp(b_last[:, None] - b), vn)
        return new_state, o

    _, o = lax.scan(step, jnp.zeros((B_, D_HEADS, D_K_DIM, D_V_DIM), jnp.float32), (qs, ks, vs, ls))
    o = head_rmsnorm(o.swapaxes(0, 1).reshape(B_, S, D_HEADS, D_V_DIM))
    o = o.reshape(B_, S, D_INNER).astype(h.dtype)
    return (o * jax.nn.silu(z)) @ w_out


def setup_inputs(seed: int = 0) -> dict:
    key = jax.random.key(seed)
    ks = jax.random.split(key, 13)
    a_cols = sum(A_SPLITS)
    c_cols = sum(C_SPLITS)
    na, nb_, nc, nd = (_n_layers_of(m) for m in range(N_MIXERS))

    def w(k, shape, fan_in):
        return jax.random.normal(k, shape, jnp.float32) * (fan_in ** -0.5)

    return {
        "x": jax.random.normal(ks[0], (BATCH, SEQ, D_MODEL), jnp.float32),
        "norm_g": 1.0 + 0.02 * jax.random.normal(ks[1], (DEPTH, D_MODEL), jnp.float32),
        "final_g": 1.0 + 0.02 * jax.random.normal(ks[2], (D_MODEL,), jnp.float32),
        "a_w_in": w(ks[3], (na, D_MODEL, a_cols), D_MODEL),
        "a_w_out": w(ks[4], (na, D_INNER, D_MODEL), D_INNER),
        "b_w_in": w(ks[5], (nb_, D_MODEL, 4 * D_INNER), D_MODEL),
        "b_w_out": w(ks[6], (nb_, D_INNER, D_MODEL), D_INNER),
        "c_w_in": w(ks[7], (nc, D_MODEL, c_cols), D_MODEL),
        "c_w_out": w(ks[8], (nc, D_INNER, D_MODEL), D_INNER),
        "d_w_in": w(ks[9], (nd, D_MODEL, 4 * D_INNER), D_MODEL),
        "d_w_out": w(ks[10], (nd, D_INNER, D_MODEL), D_INNER),
        "hgrn_lb_logits": 0.5 * jax.random.normal(ks[11], (DEPTH, D_INNER), jnp.float32),
    }


def reference(x, norm_g, final_g, a_w_in, a_w_out, b_w_in, b_w_out, c_w_in, c_w_out, d_w_in, d_w_out, hgrn_lb_logits):
    lb_cum = jnp.cumsum(jax.nn.softmax(hgrn_lb_logits.astype(jnp.float32), axis=0), axis=0)
    lower_bounds = lb_cum - lb_cum[0]
    h = x
    for layer in range(DEPTH):
        kind = layer % N_MIXERS
        slot = layer // N_MIXERS
        u = rmsnorm(h, norm_g[layer])
        if kind == 0:
            y = dsa_mixer(u, a_w_in[slot], a_w_out[slot])
        elif kind == 1:
            y = dilated_mixer(u, b_w_in[slot], b_w_out[slot])
        elif kind == 2:
            y = retention_mixer(u, c_w_in[slot], c_w_out[slot])
        else:
            y = hgrn2_mixer(u, d_w_in[slot], d_w_out[slot], lower_bounds[layer])
        h = h + y
    return rmsnorm(h, final_g)
```

```cpp
#include <hip/hip_runtime.h>
#include <cstdio>
#include <cstdint>
namespace pg8 {
#define PG8_LAS __attribute__((address_space(3)))
typedef unsigned short bf16_t;
typedef short bf16x8 __attribute__((ext_vector_type(8)));
typedef float f32x4 __attribute__((ext_vector_type(4)));
typedef unsigned u32x4 __attribute__((ext_vector_type(4)));
constexpr int BM = 256, BK = 64, HALF = 128, HTB = HALF * BK * 2  , STAGE_BYTES = 8 * HTB, NXCD = 8, WGM = 8;

__host__ __device__ __forceinline__ int lds_byte(int r, int c) { const int st = (r >> 4) * 2 + (c >> 5), rr = r & 15, cc = c & 31, ob = rr * 64 + cc * 2; return st * 1024 + (ob ^ (((ob >> 9) & 1) << 5)); }
__host__ __device__ __forceinline__ void stage_rc(int b, int& R, int& C) { const int st = b / 1024, sb = b % 1024, swz = sb ^ (((sb >> 9) & 1) << 5); R = (st >> 1) * 16 + swz / 64; C = (st & 1) * 32 + (swz % 64) / 2; }
__host__ __device__ __forceinline__ int perm32(int rho) { const int n = rho >> 4, i = rho & 15; return 8 * (i >> 2) + 4 * n + (i & 3); }

struct Unit { int pm, pn; };
struct Gemm { const bf16_t* A; const bf16_t* Bt; int M, N, K; };

struct StaticOrder {
    int nM, nN, nwg, G, c;
    __host__ __device__ void init(int M, int N, int G_, int c_) { nM = M / BM; nN = N / BM; nwg = nM * nN; G = G_; c = c_; }
    __host__ __device__ bool next(int i, Unit& u) const {
        const long L = (long)i * G + c; if (L >= nwg) return false;
        int wgid = (int)L; { const int q = nwg / NXCD, r = nwg % NXCD, xcd = wgid % NXCD, off = wgid / NXCD; wgid = (xcd < r ? xcd * (q + 1) : r * (q + 1) + (xcd - r) * q) + off; }
        const int nig = WGM * nN, gid = wgid / nig, fm = gid * WGM, gsz = (nM - fm) < WGM ? (nM - fm) : WGM;
        u.pm = fm + ((wgid % nig) % gsz); u.pn = (wgid % nig) / gsz; return true;
    }
    __device__ __forceinline__ void a_ready(const Unit&) const {}
    __device__ __forceinline__ void done(const Unit&) const {}
};

__device__ __forceinline__ unsigned cvt_pk_bf16(float lo, float hi) { unsigned r; asm volatile("v_cvt_pk_bf16_f32 %0, %1, %2" : "=v"(r) : "v"(lo), "v"(hi)); return r; }
typedef float f32x2 __attribute__((ext_vector_type(2)));
template <class Epi, class Sched, bool ALIGN_EPI = false, bool SP2 = false>
__device__ __forceinline__ void gemm_phase(PG8_LAS unsigned char* lds, const Gemm g, const Sched& S, const Epi& E) {
    const int tid = threadIdx.x, wid = __builtin_amdgcn_readfirstlane(tid >> 6), lane = tid & 63, wr = wid >> 2, wc = wid & 3, fr = lane & 15, fq = lane >> 4;
    const int K = g.K, nt = K / BK;
    unsigned voffA[2], voffB[2];
#pragma unroll
    for (int i = 0; i < 2; ++i) { int R, C; stage_rc(tid * 16 + i * 8192, R, C); const int Rb = Epi::PERM ? ((R & ~31) + perm32(R & 31)) : R;
        voffA[i] = (unsigned)(R * K + C) * 2u; voffB[i] = (unsigned)(Rb * K + C) * 2u; }
    const size_t kstep = (size_t)(BK * 2);
    const size_t hstep = (size_t)HALF * K * 2;
    const size_t tstep = 2 * hstep;
    const unsigned ldsw = (unsigned)wid * 1024u;
    const int aoff = lds_byte(wr * 64 + fr, fq * 8), boff = lds_byte(wc * 32 + fr, fq * 8);
#define PG8_SA(b, h) (((b) * 2 + (h)) * HTB)
#define PG8_SB(b, h) ((4 + (b) * 2 + (h)) * HTB)
#define PG8_STAGE(bufoff, gbase, voff) do { _Pragma("unroll") for (int _i = 0; _i < 2; ++_i) \
        __builtin_amdgcn_global_load_lds((const unsigned*)((const char*)(gbase) + (voff)[_i]), (PG8_LAS unsigned*)(lds + (bufoff) + ldsw + _i * 8192), 16, 0, 0); } while (0)
#define PG8_LDA(dst, b, h) do { _Pragma("unroll") for (int m = 0; m < 4; ++m) _Pragma("unroll") for (int k = 0; k < 2; ++k) dst[m][k] = *(const PG8_LAS bf16x8*)(lds + PG8_SA(b, h) + aoff + m * 2048 + k * 1024); } while (0)
#define PG8_LDB(dst, b, h) do { _Pragma("unroll") for (int n = 0; n < 2; ++n) _Pragma("unroll") for (int k = 0; k < 2; ++k) dst[n][k] = *(const PG8_LAS bf16x8*)(lds + PG8_SB(b, h) + boff + n * 2048 + k * 1024); } while (0)
#define PG8_MMA(ai, bj, At, Bt) do { __builtin_amdgcn_s_setprio(1); _Pragma("unroll") for (int m = 0; m < 4; ++m) _Pragma("unroll") for (int n = 0; n < 2; ++n) _Pragma("unroll") for (int k = 0; k < 2; ++k) \
        acc[ai][bj][m][n] = __builtin_amdgcn_mfma_f32_16x16x32_bf16(Bt[n][k], At[m][k], acc[ai][bj][m][n], 0, 0, 0); __builtin_amdgcn_s_setprio(0); } while (0)
#define PG8_WAIT_V(n) asm volatile("s_waitcnt vmcnt(" #n ")" ::: "memory")
#define PG8_WAIT_L(n) asm volatile("s_waitcnt lgkmcnt(" #n ")" ::: "memory")
#define PG8_BAR __builtin_amdgcn_s_barrier()
#define PG8_SCHED __builtin_amdgcn_sched_barrier(0)
    Unit cur, nxt; int ui = 0;
    if (!S.next(0, cur)) return;
    f32x4 acc[2][2][4][2];
#pragma unroll
    for (int a = 0; a < 2; ++a)
#pragma unroll
        for (int b = 0; b < 2; ++b)
#pragma unroll
            for (int m = 0; m < 4; ++m)
#pragma unroll
                for (int n = 0; n < 2; ++n) acc[a][b][m][n] = (f32x4){0.f, 0.f, 0.f, 0.f};
    bf16x8 At[4][2], B0[2][2], B1[2][2];
    const char* cA = (const char*)g.A + (size_t)cur.pm * tstep; const char* cB = (const char*)g.Bt + (size_t)cur.pn * tstep;
    S.a_ready(cur);
    if constexpr (SP2) {
        PG8_STAGE(PG8_SB(0, 0), cB, voffB); PG8_STAGE(PG8_SB(0, 1), cB + hstep, voffB); PG8_STAGE(PG8_SA(0, 0), cA, voffA); PG8_STAGE(PG8_SA(0, 1), cA + hstep, voffA);
        if (wr == 1) PG8_BAR;
        PG8_WAIT_V(2); PG8_BAR;
        PG8_STAGE(PG8_SB(1, 0), cB + kstep, voffB); PG8_STAGE(PG8_SA(1, 0), cA + kstep, voffA); PG8_STAGE(PG8_SB(1, 1), cB + hstep + kstep, voffB);
        PG8_WAIT_V(6); PG8_BAR;
    } else {
        PG8_STAGE(PG8_SB(0, 0), cB, voffB); PG8_STAGE(PG8_SA(0, 0), cA, voffA); PG8_STAGE(PG8_SB(0, 1), cB + hstep, voffB); PG8_STAGE(PG8_SA(0, 1), cA + hstep, voffA);
        if (wr == 1) PG8_BAR;
        PG8_WAIT_V(4); PG8_BAR;
        PG8_STAGE(PG8_SB(1, 0), cB + kstep, voffB); PG8_STAGE(PG8_SA(1, 0), cA + kstep, voffA); PG8_STAGE(PG8_SB(1, 1), cB + hstep + kstep, voffB);
        PG8_WAIT_V(6); PG8_BAR;
    }
    for (;;) {
        const bool has_next = S.next(ui + 1, nxt);
        const char* nA = has_next ? (const char*)g.A + (size_t)nxt.pm * tstep : cA; const char* nB = has_next ? (const char*)g.Bt + (size_t)nxt.pn * tstep : cB;
        for (int t = 0; t < nt; t += 2) {
            const bool last = (t == nt - 2);
            const char* a1 = cA + (size_t)(t + 1) * kstep;
            const char* a2 = last ? nA : cA + (size_t)(t + 2) * kstep; const char* b2 = last ? nB : cB + (size_t)(t + 2) * kstep;
            const char* a3 = a2 + kstep; const char* b3 = b2 + kstep;
            if (last && has_next) S.a_ready(nxt);
            if constexpr (SP2) {
            PG8_LDB(B0, 0, 0); PG8_LDB(B1, 0, 1); PG8_SCHED; PG8_LDA(At, 0, 0); PG8_STAGE(PG8_SA(1, 1), a1 + hstep, voffA);
            PG8_WAIT_V(8); PG8_WAIT_L(0); PG8_BAR; PG8_MMA(0, 0, At, B0); PG8_MMA(0, 1, At, B1); PG8_BAR; PG8_SCHED;
            PG8_LDA(At, 0, 1); PG8_STAGE(PG8_SB(0, 0), b2, voffB); PG8_STAGE(PG8_SB(0, 1), b2 + hstep, voffB); PG8_STAGE(PG8_SA(0, 0), a2, voffA);
            PG8_WAIT_V(8); PG8_WAIT_L(0); PG8_BAR; PG8_MMA(1, 0, At, B0); PG8_MMA(1, 1, At, B1); PG8_BAR; PG8_SCHED;
            PG8_LDB(B0, 1, 0); PG8_LDB(B1, 1, 1); PG8_SCHED; PG8_LDA(At, 1, 0); PG8_STAGE(PG8_SA(0, 1), a2 + hstep, voffA);
            PG8_WAIT_V(8); PG8_WAIT_L(0); PG8_BAR; PG8_MMA(0, 0, At, B0); PG8_MMA(0, 1, At, B1); PG8_BAR; PG8_SCHED;
            PG8_LDA(At, 1, 1); PG8_STAGE(PG8_SB(1, 0), b3, voffB); PG8_STAGE(PG8_SB(1, 1), b3 + hstep, voffB); PG8_STAGE(PG8_SA(1, 0), a3, voffA);
            PG8_WAIT_V(8); PG8_WAIT_L(0); PG8_BAR; PG8_MMA(1, 0, At, B0); PG8_MMA(1, 1, At, B1); PG8_BAR; PG8_SCHED;
            } else {
            PG8_LDB(B0, 0, 0); PG8_SCHED; PG8_LDA(At, 0, 0); PG8_STAGE(PG8_SA(1, 1), a1 + hstep, voffA);
            PG8_WAIT_L(8); PG8_BAR; PG8_WAIT_L(0); PG8_MMA(0, 0, At, B0); PG8_BAR; PG8_SCHED;
            PG8_LDB(B1, 0, 1); PG8_STAGE(PG8_SB(0, 0), b2, voffB);
            PG8_BAR; PG8_WAIT_L(0); PG8_MMA(0, 1, At, B1); PG8_BAR;
            PG8_LDA(At, 0, 1); PG8_STAGE(PG8_SA(0, 0), a2, voffA);
            PG8_BAR; PG8_WAIT_L(0); PG8_MMA(1, 0, At, B0); PG8_BAR; PG8_SCHED;
            PG8_STAGE(PG8_SB(0, 1), b2 + hstep, voffB);
            PG8_WAIT_V(6); PG8_BAR; PG8_MMA(1, 1, At, B1); PG8_BAR;
            PG8_LDB(B0, 1, 0); PG8_SCHED; PG8_LDA(At, 1, 0); PG8_STAGE(PG8_SA(0, 1), a2 + hstep, voffA);
            PG8_WAIT_L(8); PG8_BAR; PG8_WAIT_L(0); PG8_MMA(0, 0, At, B0); PG8_BAR; PG8_SCHED;
            PG8_LDB(B1, 1, 1); PG8_STAGE(PG8_SB(1, 0), b3, voffB);
            PG8_BAR; PG8_WAIT_L(0); PG8_MMA(0, 1, At, B1); PG8_BAR;
            PG8_LDA(At, 1, 1); PG8_STAGE(PG8_SA(1, 0), a3, voffA);
            PG8_BAR; PG8_WAIT_L(0); PG8_MMA(1, 0, At, B0); PG8_BAR; PG8_SCHED;
            PG8_STAGE(PG8_SB(1, 1), b3 + hstep, voffB);
            PG8_WAIT_V(6); PG8_BAR; PG8_MMA(1, 1, At, B1); PG8_BAR;
            }
        }
        if constexpr (ALIGN_EPI) { if (wr == 0) PG8_BAR; }
        if constexpr (!Epi::AFTER_DRAIN) { E(acc, cur, wr, wc, fr, fq); S.done(cur); }
        if (!has_next) break;
#pragma unroll
        for (int a = 0; a < 2; ++a)
#pragma unroll
            for (int b = 0; b < 2; ++b)
#pragma unroll
                for (int m = 0; m < 4; ++m)
#pragma unroll
                    for (int n = 0; n < 2; ++n) acc[a][b][m][n] = (f32x4){0.f, 0.f, 0.f, 0.f};
        cur = nxt; cA = nA; cB = nB; ++ui;
        if constexpr (ALIGN_EPI) { if (wr == 1) PG8_BAR; }
    }
    PG8_WAIT_V(0);
    if constexpr (!ALIGN_EPI) { if (wr == 0) PG8_BAR; }
    PG8_BAR;
    if constexpr (Epi::AFTER_DRAIN) { E.fused(acc, cur, wr, wc, fr, fq, lds, wid, lane); S.done(cur); }
#undef PG8_SA
#undef PG8_SB
#undef PG8_STAGE
#undef PG8_LDA
#undef PG8_LDB
#undef PG8_MMA
#undef PG8_WAIT_V
#undef PG8_WAIT_L
#undef PG8_BAR
#undef PG8_SCHED
}
}

typedef unsigned short bf16;
typedef unsigned u32x4_t __attribute__((ext_vector_type(4)));
constexpr int D_MODEL = 1024, SEQ = 2048, D_INNER = 2048, MTOK = 16384, MH = 8192;
constexpr float QK_SCALE = 0.08838834764831845f;

__device__ __forceinline__ float bf2f(bf16 v) { return __uint_as_float(((unsigned)v) << 16); }
__device__ __forceinline__ bf16 f2bf(float f) { unsigned u = __float_as_uint(f); return (bf16)((u + 0x7fffu + ((u >> 16) & 1u)) >> 16); }
__device__ __forceinline__ float wave_sum(float v) {
#pragma unroll
    for (int o = 1; o < 64; o <<= 1) v += __shfl_xor(v, o);
    return v;
}
__device__ __forceinline__ float wave_max(float v) {
#pragma unroll
    for (int o = 1; o < 64; o <<= 1) v = fmaxf(v, __shfl_xor(v, o));
    return v;
}
__device__ __forceinline__ float silu_f(float z) { return z / (1.f + __expf(-z)); }
__device__ __forceinline__ float sigmoid_f(float z) { return 1.f / (1.f + __expf(-z)); }

__global__ void k_prep(float* cos128, float* sin128, float* cos64, float* sin64, float* lb, const float* logits) {
    const int i = blockIdx.x * blockDim.x + threadIdx.x;
    if (i < 2048 * 64) {
        const int pos = i >> 6, f = i & 63;
        const float freq = exp2f(-((float)(2 * f) / 128.f) * 13.287712379549449f);
        double rev = (double)pos * (double)freq * 0.15915494309189535; rev -= floor(rev);
        cos128[i] = __builtin_amdgcn_cosf((float)rev); sin128[i] = __builtin_amdgcn_sinf((float)rev);
    }
    if (i < 2048 * 32) {
        const int pos = i >> 5, f = i & 31;
        const float freq = exp2f(-((float)(2 * f) / 64.f) * 13.287712379549449f);
        double rev = (double)pos * (double)freq * 0.15915494309189535; rev -= floor(rev);
        cos64[i] = __builtin_amdgcn_cosf((float)rev); sin64[i] = __builtin_amdgcn_sinf((float)rev);
    }
    if (i < 2048) {
        const float l0 = logits[i], l1 = logits[2048 + i], l2 = logits[4096 + i], l3 = logits[6144 + i];
        const float m = fmaxf(fmaxf(l0, l1), fmaxf(l2, l3));
        const float e0 = __expf(l0 - m), e1 = __expf(l1 - m), e2 = __expf(l2 - m), e3 = __expf(l3 - m);
        lb[i] = (e1 + e2 + e3) / (e0 + e1 + e2 + e3);
    }
}

__global__ void k_wconv(const float* W, bf16* WT, int K, int N, int Npad) {
    __shared__ float tile[32][33];
    const int n0 = blockIdx.x * 32, k0 = blockIdx.y * 32, tx = threadIdx.x, ty = threadIdx.y;
#pragma unroll
    for (int i = 0; i < 4; ++i) { const int k = k0 + ty + 8 * i, n = n0 + tx; tile[ty + 8 * i][tx] = (n < N) ? W[(size_t)k * N + n] : 0.f; }
    __syncthreads();
#pragma unroll
    for (int i = 0; i < 4; ++i) { const int n = n0 + ty + 8 * i, k = k0 + tx; if (n < Npad) WT[(size_t)n * K + k] = f2bf(tile[tx][ty + 8 * i]); }
}

__global__ __launch_bounds__(256) void k_norm(const float* H, const float* g, bf16* U, float* Hcopy) {
    const int row = blockIdx.x * 4 + (threadIdx.x >> 6), lane = threadIdx.x & 63;
    const float4* xr = (const float4*)(H + (size_t)row * D_MODEL) + lane;
    float4 v[4]; float s = 0.f;
#pragma unroll
    for (int j = 0; j < 4; ++j) { v[j] = xr[64 * j]; s += v[j].x * v[j].x + v[j].y * v[j].y + v[j].z * v[j].z + v[j].w * v[j].w; }
    const float r = rsqrtf(wave_sum(s) * (1.f / D_MODEL) + 1e-6f);
#pragma unroll
    for (int j = 0; j < 4; ++j) {
        const float4 gg = ((const float4*)g)[lane + 64 * j];
        if (Hcopy) ((float4*)(Hcopy + (size_t)row * D_MODEL))[lane + 64 * j] = v[j];
        bf16* up = U + (size_t)row * D_MODEL + (lane + 64 * j) * 4;
        up[0] = f2bf(v[j].x * r * gg.x); up[1] = f2bf(v[j].y * r * gg.y); up[2] = f2bf(v[j].z * r * gg.z); up[3] = f2bf(v[j].w * r * gg.w);
    }
}
__global__ __launch_bounds__(256) void k_final(float* H, const float* g) {
    const int row = blockIdx.x * 4 + (threadIdx.x >> 6), lane = threadIdx.x & 63;
    float4* xr = (float4*)(H + (size_t)row * D_MODEL) + lane;
    float4 v[4]; float s = 0.f;
#pragma unroll
    for (int j = 0; j < 4; ++j) { v[j] = xr[64 * j]; s += v[j].x * v[j].x + v[j].y * v[j].y + v[j].z * v[j].z + v[j].w * v[j].w; }
    const float r = rsqrtf(wave_sum(s) * (1.f / D_MODEL) + 1e-6f);
#pragma unroll
    for (int j = 0; j < 4; ++j) { const float4 gg = ((const float4*)g)[lane + 64 * j]; xr[64 * j] = make_float4(v[j].x * r * gg.x, v[j].y * r * gg.y, v[j].z * r * gg.z, v[j].w * r * gg.w); }
}

struct EpiBf16Store {
    static constexpr bool PERM = true, AFTER_DRAIN = false;
    bf16* O; int ldc;
    __device__ __forceinline__ static EpiBf16Store make(void* C, int ldc) { return EpiBf16Store{(bf16*)C, ldc}; }
    __device__ __forceinline__ void operator()(const pg8::f32x4 (&acc)[2][2][4][2], const pg8::Unit& u, int wr, int wc, int fr, int fq) const {
        const int row0 = u.pm * 256 + wr * 64 + fr, col0 = u.pn * 256 + wc * 32 + 8 * fq;
#pragma unroll
        for (int ai = 0; ai < 2; ++ai)
#pragma unroll
            for (int m = 0; m < 4; ++m) { bf16* rowp = O + (size_t)(row0 + ai * 128 + m * 16) * ldc + col0;
#pragma unroll
                for (int bj = 0; bj < 2; ++bj) { const pg8::f32x4 v0 = acc[ai][bj][m][0], v1 = acc[ai][bj][m][1];
                    pg8::u32x4 w; w.x = pg8::cvt_pk_bf16(v0[0], v0[1]); w.y = pg8::cvt_pk_bf16(v0[2], v0[3]); w.z = pg8::cvt_pk_bf16(v1[0], v1[1]); w.w = pg8::cvt_pk_bf16(v1[2], v1[3]);
                    *(pg8::u32x4*)(rowp + bj * 128) = w; } }
    }
};
struct EpiAddF32 {
    static constexpr bool PERM = false, AFTER_DRAIN = false;
    float* C; int ldc;
    __device__ __forceinline__ static EpiAddF32 make(void* C, int ldc) { return EpiAddF32{(float*)C, ldc}; }
    __device__ __forceinline__ void operator()(const pg8::f32x4 (&acc)[2][2][4][2], const pg8::Unit& u, int wr, int wc, int fr, int fq) const {
        const int row0 = u.pm * 256 + wr * 64 + fr, col0 = u.pn * 256 + wc * 32 + 4 * fq;
#pragma unroll
        for (int ai = 0; ai < 2; ++ai)
#pragma unroll
            for (int m = 0; m < 4; ++m) { float* rowp = C + (size_t)(row0 + ai * 128 + m * 16) * ldc + col0;
#pragma unroll
                for (int bj = 0; bj < 2; ++bj)
#pragma unroll
                    for (int n = 0; n < 2; ++n) { pg8::f32x4* p = (pg8::f32x4*)(rowp + bj * 128 + n * 16); *p = *p + acc[ai][bj][m][n]; } }
    }
};
struct GArgs { const bf16* A; const bf16* Bt; void* C; int M, N, K, ldc; };
template <class Epi> __global__ void __launch_bounds__(512, 2) k_gemm(GArgs a) {
    extern __shared__ __attribute__((aligned(16))) unsigned char lds[];
    pg8::Gemm g{a.A, a.Bt, a.M, a.N, a.K};
    pg8::StaticOrder S; S.init(a.M, a.N, (int)gridDim.x, (int)blockIdx.x);
    const Epi E = Epi::make(a.C, a.ldc);
    pg8::gemm_phase<Epi, pg8::StaticOrder, true, true>((PG8_LAS unsigned char*)lds, g, S, E);
}

__global__ void k_rotary(bf16* P, int ldp, int rows, int off, int nh, int dh, const float* ct, const float* st) {
    const long idx = (long)blockIdx.x * 256 + threadIdx.x; const int half = dh >> 1; const long total = (long)rows * nh * half;
    if (idx >= total) return;
    const int i = (int)(idx % half), h = (int)((idx / half) % nh), row = (int)(idx / ((long)half * nh)), pos = row & (SEQ - 1);
    bf16* p = P + (size_t)row * ldp + off + h * dh;
    const float x1 = bf2f(p[i]), x2 = bf2f(p[i + half]), c = ct[pos * half + i], s = st[pos * half + i];
    p[i] = f2bf(x1 * c - x2 * s); p[i + half] = f2bf(x1 * s + x2 * c);
}

__device__ __forceinline__ unsigned fkey(float f) { const unsigned u = __float_as_uint(f + 0.0f); return (u & 0x80000000u) ? ~u : (u | 0x80000000u); }

constexpr int A_IQ = 2304, A_IK = 3328, A_IW = 3392, A_K = 2048, A_V = 2176, A_Z = 3408;
__global__ __launch_bounds__(256) void k_index_topk(const bf16* P, int ldp, unsigned* mask) {
    const int row = blockIdx.x, t = row & (SEQ - 1), rb = row - t, tid = threadIdx.x;
    __shared__ float iq[16 * 64]; __shared__ float iw[16]; __shared__ float sc[2048]; __shared__ unsigned mw[64]; __shared__ unsigned cnt;
    for (int i = tid; i < 1024; i += 256) iq[i] = bf2f(P[(size_t)row * ldp + A_IQ + i]);
    if (tid < 16) iw[tid] = bf2f(P[(size_t)row * ldp + A_IW + tid]) * (1.f / 32.f);
    if (tid < 64) mw[tid] = 0u;
    __syncthreads();
    for (int s = tid; s <= t; s += 256) {
        const uint4* kp = (const uint4*)(P + (size_t)(rb + s) * ldp + A_IK);
        float kk[64];
#pragma unroll
        for (int c = 0; c < 8; ++c) { const uint4 r = kp[c]; const unsigned w[4] = {r.x, r.y, r.z, r.w};
#pragma unroll
            for (int j = 0; j < 4; ++j) { kk[c * 8 + 2 * j] = __uint_as_float(w[j] << 16); kk[c * 8 + 2 * j + 1] = __uint_as_float(w[j] & 0xffff0000u); } }
        float score = 0.f;
        for (int h = 0; h < 16; ++h) { float d = 0.f;
#pragma unroll
            for (int j = 0; j < 64; ++j) d = fmaf(iq[h * 64 + j], kk[j], d);
            score += fmaxf(d, 0.f) * iw[h]; }
        sc[s] = score;
    }
    __syncthreads();
    if (t + 1 <= 256) { for (int s = tid; s <= t; s += 256) atomicOr(&mw[s >> 5], 1u << (s & 31)); }
    else {
        unsigned myk[8];
#pragma unroll
        for (int j = 0; j < 8; ++j) { const int s = tid + 256 * j; myk[j] = (s <= t) ? fkey(sc[s]) : 0u; }
        unsigned prefix = 0u;
        for (int bit = 31; bit >= 0; --bit) {
            const unsigned cand = prefix | (1u << bit); unsigned c = 0;
#pragma unroll
            for (int j = 0; j < 8; ++j) c += (myk[j] >= cand) ? 1u : 0u;
            if (tid == 0) cnt = 0u;
            __syncthreads(); if (c) atomicAdd(&cnt, c); __syncthreads();
            const unsigned total = cnt; __syncthreads();
            if (total >= 256u) prefix = cand;
        }
        unsigned cg = 0, ce = 0;
#pragma unroll
        for (int j = 0; j < 8; ++j) { cg += (myk[j] > prefix) ? 1u : 0u; ce += (myk[j] == prefix) ? 1u : 0u; }
        if (tid == 0) cnt = 0u;
        __syncthreads(); atomicAdd(&cnt, cg | (ce << 16)); __syncthreads();
        const unsigned tot = cnt; const int n_gt = (int)(tot & 0xffffu), n_eq = (int)(tot >> 16); const int need = 256 - n_gt;
#pragma unroll
        for (int j = 0; j < 8; ++j) { const int s = tid + 256 * j; if (myk[j] > prefix || (myk[j] == prefix && n_eq == need && prefix != 0u)) atomicOr(&mw[s >> 5], 1u << (s & 31)); }
        if (n_eq != need && tid == 0) { int left = need; for (int s = 0; s <= t && left > 0; ++s) if (fkey(sc[s]) == prefix) { atomicOr(&mw[s >> 5], 1u << (s & 31)); --left; } }
    }
    __syncthreads();
    if (tid < 64) mask[(size_t)row * 64 + tid] = mw[tid];
}

template <int MODE> __global__ __launch_bounds__(256) void k_attn_naive(const bf16* P, int ldp, int koff, int voff, int zoff, int kvhs, const unsigned* mask, bf16* O) {
    const int row = blockIdx.x, t = row & (SEQ - 1), rb = row - t, tid = threadIdx.x, lane = tid & 63, wv = tid >> 6;
    __shared__ int keys[400]; __shared__ float qs[16 * 128]; __shared__ float sc[16][400]; __shared__ float linv[16]; __shared__ int pre[64]; __shared__ int nk_s;
    for (int i = tid; i < 2048; i += 256) qs[i] = bf2f(P[(size_t)row * ldp + i]);
    if (MODE == 0) {
        unsigned w = 0; if (tid < 64) { w = mask[(size_t)row * 64 + tid]; pre[tid] = __popc(w); }
        __syncthreads();
        if (tid == 0) { int run = 0; for (int i = 0; i < 64; ++i) { const int x = pre[i]; pre[i] = run; run += x; } nk_s = run; }
        __syncthreads();
        if (tid < 64) { int pos = pre[tid]; while (w) { const int b = __ffs(w) - 1; keys[pos++] = tid * 32 + b; w &= w - 1; } }
    } else {
        for (int e = tid; e < 387; e += 256) { const int cfg = e / 129, j = e % 129, dil = cfg == 0 ? 1 : (cfg == 1 ? 4 : 16); const int s = t - j * dil; keys[e] = s >= 0 ? s : -1; }
        if (tid == 0) nk_s = 387;
    }
    __syncthreads();
    const int nk = nk_s;
    for (int e = tid; e < nk; e += 256) {
        const int s = keys[e];
        for (int h = 0; h < 16; ++h) {
            float d = -__builtin_inff();
            if (s >= 0) { const uint4* kp = (const uint4*)(P + (size_t)(rb + s) * ldp + koff + h * kvhs); d = 0.f;
#pragma unroll
                for (int c = 0; c < 16; ++c) { const uint4 r = kp[c]; const unsigned w[4] = {r.x, r.y, r.z, r.w}; const float* qp = qs + h * 128 + c * 8;
#pragma unroll
                    for (int j = 0; j < 4; ++j) { d = fmaf(qp[2 * j], __uint_as_float(w[j] << 16), d); d = fmaf(qp[2 * j + 1], __uint_as_float(w[j] & 0xffff0000u), d); } }
                d *= QK_SCALE; }
            sc[h][e] = d;
        }
    }
    __syncthreads();
    for (int hh = 0; hh < 4; ++hh) { const int h = wv * 4 + hh; float m = -__builtin_inff();
        for (int e = lane; e < nk; e += 64) m = fmaxf(m, sc[h][e]);
        m = wave_max(m); float sum = 0.f;
        for (int e = lane; e < nk; e += 64) { const float p = __expf(sc[h][e] - m); sc[h][e] = p; sum += p; }
        sum = wave_sum(sum); if (lane == 0) linv[h] = 1.f / sum; }
    __syncthreads();
    const int d = tid & 127, hg = tid >> 7; float acc[8];
#pragma unroll
    for (int j = 0; j < 8; ++j) acc[j] = 0.f;
    for (int e = 0; e < nk; ++e) { const int s = keys[e]; if (s < 0) continue; const bf16* vp = P + (size_t)(rb + s) * ldp + voff + d;
#pragma unroll
        for (int j = 0; j < 8; ++j) { const int h = hg * 8 + j; acc[j] = fmaf(sc[h][e], bf2f(vp[h * kvhs]), acc[j]); } }
#pragma unroll
    for (int j = 0; j < 8; ++j) { const int h = hg * 8 + j; const float z = bf2f(P[(size_t)row * ldp + zoff + h * 128 + d]);
        O[(size_t)row * D_INNER + h * 128 + d] = f2bf(acc[j] * linv[h] * silu_f(z)); }
}

__global__ __launch_bounds__(256) void k_ret_naive(const bf16* P, int ldp, bf16* O) {
    const int bl = blockIdx.x >> 3, h = blockIdx.x & 7, tid = threadIdx.x, lane = tid & 63, wv = tid >> 6;
    const float gamma = 1.f - exp2f(-5.f - (float)h);
    __shared__ __attribute__((aligned(16))) float qs[16][128]; __shared__ __attribute__((aligned(16))) float ks[16][128]; __shared__ float ob[16][256]; __shared__ float ssq[16];
    float S[128];
#pragma unroll
    for (int i = 0; i < 128; ++i) S[i] = 0.f;
    for (int t0 = 0; t0 < SEQ; t0 += 16) {
        const size_t row0 = (size_t)bl * SEQ + t0;
        for (int i = tid; i < 16 * 128; i += 256) { const int tt = i >> 7, c = i & 127; const bf16* pr = P + (row0 + tt) * ldp + h * 128 + c;
            qs[tt][c] = bf2f(pr[0]); ks[tt][c] = bf2f(pr[1024]) * QK_SCALE; }
        __syncthreads();
#pragma unroll 1
        for (int tt = 0; tt < 16; ++tt) {
            const float v = bf2f(P[(row0 + tt) * ldp + 2048 + h * 256 + tid]); float o = 0.f;
#pragma unroll
            for (int i = 0; i < 128; i += 4) { const float4 k4 = *(const float4*)&ks[tt][i], q4 = *(const float4*)&qs[tt][i];
                S[i] = fmaf(gamma, S[i], k4.x * v); o = fmaf(q4.x, S[i], o); S[i + 1] = fmaf(gamma, S[i + 1], k4.y * v); o = fmaf(q4.y, S[i + 1], o);
                S[i + 2] = fmaf(gamma, S[i + 2], k4.z * v); o = fmaf(q4.z, S[i + 2], o); S[i + 3] = fmaf(gamma, S[i + 3], k4.w * v); o = fmaf(q4.w, S[i + 3], o); }
            ob[tt][tid] = o;
        }
        __syncthreads();
        for (int j = 0; j < 4; ++j) { const int tt = wv * 4 + j; float s = 0.f; for (int c = lane; c < 256; c += 64) s += ob[tt][c] * ob[tt][c]; s = wave_sum(s); if (lane == 0) ssq[tt] = s; }
        __syncthreads();
        for (int tt = 0; tt < 16; ++tt) { const float o = ob[tt][tid] * rsqrtf(ssq[tt] * (1.f / 256.f) + 1e-6f); const float z = bf2f(P[(row0 + tt) * ldp + 4096 + h * 256 + tid]);
            O[(row0 + tt) * D_INNER + h * 256 + tid] = f2bf(o * silu_f(z)); }
        __syncthreads();
    }
}

__global__ __launch_bounds__(128) void k_hgrn_naive(const bf16* P, int ldp, const float* lb, bf16* O) {
    const int bl = blockIdx.x >> 4, h = blockIdx.x & 15, tid = threadIdx.x, lane = tid & 63, wv = tid >> 6;
    __shared__ __attribute__((aligned(16))) float qs[16][128]; __shared__ __attribute__((aligned(16))) float gs[16][128]; __shared__ float ob[16][128]; __shared__ float ssq[16];
    const float lbc = lb[h * 128 + tid];
    float S[128];
#pragma unroll
    for (int i = 0; i < 128; ++i) S[i] = 0.f;
    for (int t0 = 0; t0 < SEQ; t0 += 16) {
        const size_t row0 = (size_t)bl * SEQ + t0;
        for (int tt = 0; tt < 16; ++tt) { const bf16* pr = P + (row0 + tt) * ldp + h * 128 + tid;
            qs[tt][tid] = silu_f(bf2f(pr[0])) * QK_SCALE; gs[tt][tid] = lbc + (1.f - lbc) * sigmoid_f(bf2f(pr[2048])); }
        __syncthreads();
#pragma unroll 1
        for (int tt = 0; tt < 16; ++tt) {
            const float v = bf2f(P[(row0 + tt) * ldp + 4096 + h * 128 + tid]); float o = 0.f;
#pragma unroll
            for (int i = 0; i < 128; i += 4) { const float4 g4 = *(const float4*)&gs[tt][i], q4 = *(const float4*)&qs[tt][i];
                S[i] = fmaf(g4.x, S[i] - v, v); o = fmaf(q4.x, S[i], o); S[i + 1] = fmaf(g4.y, S[i + 1] - v, v); o = fmaf(q4.y, S[i + 1], o);
                S[i + 2] = fmaf(g4.z, S[i + 2] - v, v); o = fmaf(q4.z, S[i + 2], o); S[i + 3] = fmaf(g4.w, S[i + 3] - v, v); o = fmaf(q4.w, S[i + 3], o); }
            ob[tt][tid] = o;
        }
        __syncthreads();
        for (int j = 0; j < 8; ++j) { const int tt = wv * 8 + j; float s = ob[tt][lane] * ob[tt][lane] + ob[tt][lane + 64] * ob[tt][lane + 64]; s = wave_sum(s); if (lane == 0) ssq[tt] = s; }
        __syncthreads();
        for (int tt = 0; tt < 16; ++tt) { const float o = ob[tt][tid] * rsqrtf(ssq[tt] * (1.f / 128.f) + 1e-6f); const float z = bf2f(P[(row0 + tt) * ldp + 6144 + h * 128 + tid]);
            O[(row0 + tt) * D_INNER + h * 128 + tid] = f2bf(o * silu_f(z)); }
        __syncthreads();
    }
}

constexpr size_t MiB = 1u << 20;
constexpr size_t WS_TAB = 1 * MiB, WS_WIN = 4 * MiB, WS_WOUT = 20 * MiB, WS_U = 24 * MiB, WS_O = 56 * MiB, WS_MASK = 88 * MiB, WS_P = 120 * MiB;
template <class Epi> static void launch_gemm(const bf16* A, const bf16* Bt, void* C, int M, int N, int K, int ldc, hipStream_t st) {
    static bool attr = false;
    if (!attr) { (void)hipFuncSetAttribute((const void*)k_gemm<Epi>, hipFuncAttributeMaxDynamicSharedMemorySize, pg8::STAGE_BYTES); attr = true; }
    GArgs a; a.A = A; a.Bt = Bt; a.C = C; a.M = M; a.N = N; a.K = K; a.ldc = ldc;
    hipLaunchKernelGGL(k_gemm<Epi>, dim3(256), dim3(512), pg8::STAGE_BYTES, st, a);
}
extern "C" void kernel_launch(void* const* d_in, const int* in_sizes, int n_in, void* d_out, int out_size, void* d_ws, size_t ws_size, hipStream_t stream) {
    const float* x = (const float*)d_in[0]; const float* norm_g = (const float*)d_in[1]; const float* final_g = (const float*)d_in[2];
    const float* w_in[4] = {(const float*)d_in[3], (const float*)d_in[5], (const float*)d_in[7], (const float*)d_in[9]};
    const float* w_out[4] = {(const float*)d_in[4], (const float*)d_in[6], (const float*)d_in[8], (const float*)d_in[10]};
    const float* lb_logits = (const float*)d_in[11];
    unsigned char* ws = (unsigned char*)d_ws; float* H = (float*)d_out;
    float* cos128 = (float*)(ws + WS_TAB); float* sin128 = cos128 + 2048 * 64; float* cos64 = sin128 + 2048 * 64; float* sin64 = cos64 + 2048 * 32; float* lb = sin64 + 2048 * 32;
    bf16* WIN = (bf16*)(ws + WS_WIN); bf16* WOUT = (bf16*)(ws + WS_WOUT); bf16* U = (bf16*)(ws + WS_U); bf16* O = (bf16*)(ws + WS_O); bf16* P = (bf16*)(ws + WS_P);
    unsigned* mask = (unsigned*)(ws + WS_MASK);
    const int ncols[4] = {5456, 8192, 6144, 8192}, npad[4] = {5632, 8192, 6144, 8192};
    k_prep<<<512, 256, 0, stream>>>(cos128, sin128, cos64, sin64, lb, lb_logits);
    for (int layer = 0; layer < 4; ++layer) {
        const int N = ncols[layer], Np = npad[layer];
        k_wconv<<<dim3(Np / 32, 1024 / 32), dim3(32, 8), 0, stream>>>(w_in[layer], WIN, 1024, N, Np);
        k_wconv<<<dim3(1024 / 32, 2048 / 32), dim3(32, 8), 0, stream>>>(w_out[layer], WOUT, 2048, 1024, 1024);
        k_norm<<<MTOK / 4, 256, 0, stream>>>(layer == 0 ? x : H, norm_g + layer * 1024, U, layer == 0 ? H : nullptr);
        for (int half = 0; half < 2; ++half) {
            launch_gemm<EpiBf16Store>(U + (size_t)half * MH * 1024, WIN, P, MH, Np, 1024, Np, stream);
            if (layer == 0) {
                k_rotary<<<(MH * 16 * 64 + 255) / 256, 256, 0, stream>>>(P, Np, MH, 0, 16, 128, cos128, sin128);
                k_rotary<<<(MH * 1 * 64 + 255) / 256, 256, 0, stream>>>(P, Np, MH, A_K, 1, 128, cos128, sin128);
                k_rotary<<<(MH * 16 * 32 + 255) / 256, 256, 0, stream>>>(P, Np, MH, A_IQ, 16, 64, cos64, sin64);
                k_rotary<<<(MH * 1 * 32 + 255) / 256, 256, 0, stream>>>(P, Np, MH, A_IK, 1, 64, cos64, sin64);
                k_index_topk<<<MH, 256, 0, stream>>>(P, Np, mask);
                k_attn_naive<0><<<MH, 256, 0, stream>>>(P, Np, A_K, A_V, A_Z, 0, mask, O);
            } else if (layer == 1) {
                k_rotary<<<(MH * 32 * 64 + 255) / 256, 256, 0, stream>>>(P, Np, MH, 0, 32, 128, cos128, sin128);
                k_attn_naive<1><<<MH, 256, 0, stream>>>(P, Np, 2048, 4096, 6144, 128, mask, O);
            } else if (layer == 2) {
                k_rotary<<<(MH * 16 * 64 + 255) / 256, 256, 0, stream>>>(P, Np, MH, 0, 16, 128, cos128, sin128);
                k_ret_naive<<<4 * 8, 256, 0, stream>>>(P, Np, O);
            } else {
                k_hgrn_naive<<<4 * 16, 128, 0, stream>>>(P, Np, lb, O);
            }
            launch_gemm<EpiAddF32>(O, WOUT, H + (size_t)half * MH * 1024, MH, 1024, 2048, 1024, stream);
        }
    }
    k_final<<<MTOK / 4, 256, 0, stream>>>(H, final_g);
}
```

```cpp
#include <hip/hip_runtime.h>
#include <cstdio>
#include <cstdint>
#define GAS __attribute__((address_space(1)))
#define LAS __attribute__((address_space(3)))
namespace pg8 {
#define PG8_LAS __attribute__((address_space(3)))
typedef unsigned short bf16_t;
typedef short bf16x8 __attribute__((ext_vector_type(8)));
typedef float f32x4 __attribute__((ext_vector_type(4)));
typedef unsigned u32x4 __attribute__((ext_vector_type(4)));
constexpr int BM = 256, BK = 64, HALF = 128, HTB = HALF * BK * 2  , STAGE_BYTES = 8 * HTB, NXCD = 8, WGM = 8;

__host__ __device__ __forceinline__ int lds_byte(int r, int c) { const int st = (r >> 4) * 2 + (c >> 5), rr = r & 15, cc = c & 31, ob = rr * 64 + cc * 2; return st * 1024 + (ob ^ (((ob >> 9) & 1) << 5)); }
__host__ __device__ __forceinline__ void stage_rc(int b, int& R, int& C) { const int st = b / 1024, sb = b % 1024, swz = sb ^ (((sb >> 9) & 1) << 5); R = (st >> 1) * 16 + swz / 64; C = (st & 1) * 32 + (swz % 64) / 2; }
__host__ __device__ __forceinline__ int perm32(int rho) { const int n = rho >> 4, i = rho & 15; return 8 * (i >> 2) + 4 * n + (i & 3); }

struct Unit { int pm, pn; };
struct Gemm { const bf16_t* A; const bf16_t* Bt; int M, N, K, lda; };

struct StaticOrder {
    int nM, nN, nwg, G, c;
    __host__ __device__ void init(int M, int N, int G_, int c_) { nM = M / BM; nN = N / BM; nwg = nM * nN; G = G_; c = c_; }
    __host__ __device__ bool next(int i, Unit& u) const {
        const long L = (long)i * G + c; if (L >= nwg) return false;
        int wgid = (int)L; { const int q = nwg / NXCD, r = nwg % NXCD, xcd = wgid % NXCD, off = wgid / NXCD; wgid = (xcd < r ? xcd * (q + 1) : r * (q + 1) + (xcd - r) * q) + off; }
        const int nig = WGM * nN, gid = wgid / nig, fm = gid * WGM, gsz = (nM - fm) < WGM ? (nM - fm) : WGM;
        u.pm = fm + ((wgid % nig) % gsz); u.pn = (wgid % nig) / gsz; return true;
    }
    __device__ __forceinline__ void a_ready(const Unit&) const {}
    __device__ __forceinline__ void done(const Unit&) const {}
};

__device__ __forceinline__ unsigned cvt_pk_bf16(float lo, float hi) { unsigned r; asm volatile("v_cvt_pk_bf16_f32 %0, %1, %2" : "=v"(r) : "v"(lo), "v"(hi)); return r; }
typedef float f32x2 __attribute__((ext_vector_type(2)));
template <class Epi, class Sched, bool ALIGN_EPI = false, bool SP2 = false>
__device__ __forceinline__ void gemm_phase(PG8_LAS unsigned char* lds, const Gemm g, const Sched& S, const Epi& E) {
    int tid_o = threadIdx.x; asm volatile("" : "+v"(tid_o));
    const int tid = tid_o, wid = __builtin_amdgcn_readfirstlane(tid >> 6), lane = tid & 63, wr = wid >> 2, wc = wid & 3, fr = lane & 15, fq = lane >> 4;
    const int K = g.K, nt = K / BK;
    unsigned voffA[2], voffB[2];
#pragma unroll
    for (int i = 0; i < 2; ++i) { int R, C; stage_rc(tid * 16 + i * 8192, R, C); const int Rb = Epi::PERM ? ((R & ~31) + perm32(R & 31)) : R;
        voffA[i] = (unsigned)(R * g.lda + C) * 2u; voffB[i] = (unsigned)(Rb * K + C) * 2u; }
    const size_t kstep = (size_t)(BK * 2);
    const size_t hstepA = (size_t)HALF * g.lda * 2, hstepB = (size_t)HALF * K * 2;
    const size_t tstepA = 2 * hstepA, tstepB = 2 * hstepB;
    const unsigned ldsw = (unsigned)wid * 1024u;
    const int aoff = lds_byte(wr * 64 + fr, fq * 8), boff = lds_byte(wc * 32 + fr, fq * 8);
#define PG8_SA(b, h) (((b) * 2 + (h)) * HTB)
#define PG8_SB(b, h) ((4 + (b) * 2 + (h)) * HTB)
#define PG8_STAGE(bufoff, gbase, voff) do { _Pragma("unroll") for (int _i = 0; _i < 2; ++_i) \
        __builtin_amdgcn_global_load_lds((const unsigned*)((const char*)(gbase) + (voff)[_i]), (PG8_LAS unsigned*)(lds + (bufoff) + ldsw + _i * 8192), 16, 0, 0); } while (0)
#define PG8_LDA(dst, b, h) do { _Pragma("unroll") for (int m = 0; m < 4; ++m) _Pragma("unroll") for (int k = 0; k < 2; ++k) dst[m][k] = *(const PG8_LAS bf16x8*)(lds + PG8_SA(b, h) + aoff + m * 2048 + k * 1024); } while (0)
#define PG8_LDB(dst, b, h) do { _Pragma("unroll") for (int n = 0; n < 2; ++n) _Pragma("unroll") for (int k = 0; k < 2; ++k) dst[n][k] = *(const PG8_LAS bf16x8*)(lds + PG8_SB(b, h) + boff + n * 2048 + k * 1024); } while (0)
#define PG8_MMA(ai, bj, At, Bt) do { __builtin_amdgcn_s_setprio(1); _Pragma("unroll") for (int m = 0; m < 4; ++m) _Pragma("unroll") for (int n = 0; n < 2; ++n) _Pragma("unroll") for (int k = 0; k < 2; ++k) \
        acc[ai][bj][m][n] = __builtin_amdgcn_mfma_f32_16x16x32_bf16(Bt[n][k], At[m][k], acc[ai][bj][m][n], 0, 0, 0); __builtin_amdgcn_s_setprio(0); } while (0)
#define PG8_WAIT_V(n) asm volatile("s_waitcnt vmcnt(" #n ")" ::: "memory")
#define PG8_WAIT_L(n) asm volatile("s_waitcnt lgkmcnt(" #n ")" ::: "memory")
#define PG8_BAR __builtin_amdgcn_s_barrier()
#define PG8_SCHED __builtin_amdgcn_sched_barrier(0)
    Unit cur, nxt; int ui = 0;
    if (!S.next(0, cur)) return;
    f32x4 acc[2][2][4][2];
#pragma unroll
    for (int a = 0; a < 2; ++a)
#pragma unroll
        for (int b = 0; b < 2; ++b)
#pragma unroll
            for (int m = 0; m < 4; ++m)
#pragma unroll
                for (int n = 0; n < 2; ++n) acc[a][b][m][n] = (f32x4){0.f, 0.f, 0.f, 0.f};
    bf16x8 At[4][2], B0[2][2], B1[2][2];
    const char* cA = (const char*)g.A + (size_t)cur.pm * tstepA; const char* cB = (const char*)g.Bt + (size_t)cur.pn * tstepB;
    S.a_ready(cur);
    if constexpr (SP2) {
        PG8_STAGE(PG8_SB(0, 0), cB, voffB); PG8_STAGE(PG8_SB(0, 1), cB + hstepB, voffB); PG8_STAGE(PG8_SA(0, 0), cA, voffA); PG8_STAGE(PG8_SA(0, 1), cA + hstepA, voffA);
        if (wr == 1) PG8_BAR;
        PG8_WAIT_V(2); PG8_BAR;
        PG8_STAGE(PG8_SB(1, 0), cB + kstep, voffB); PG8_STAGE(PG8_SA(1, 0), cA + kstep, voffA); PG8_STAGE(PG8_SB(1, 1), cB + hstepB + kstep, voffB);
        PG8_WAIT_V(6); PG8_BAR;
    } else {
        PG8_STAGE(PG8_SB(0, 0), cB, voffB); PG8_STAGE(PG8_SA(0, 0), cA, voffA); PG8_STAGE(PG8_SB(0, 1), cB + hstepB, voffB); PG8_STAGE(PG8_SA(0, 1), cA + hstepA, voffA);
        if (wr == 1) PG8_BAR;
        PG8_WAIT_V(4); PG8_BAR;
        PG8_STAGE(PG8_SB(1, 0), cB + kstep, voffB); PG8_STAGE(PG8_SA(1, 0), cA + kstep, voffA); PG8_STAGE(PG8_SB(1, 1), cB + hstepB + kstep, voffB);
        PG8_WAIT_V(6); PG8_BAR;
    }
    for (;;) {
        const bool has_next = S.next(ui + 1, nxt);
        const char* nA = has_next ? (const char*)g.A + (size_t)nxt.pm * tstepA : cA; const char* nB = has_next ? (const char*)g.Bt + (size_t)nxt.pn * tstepB : cB;
        for (int t = 0; t < nt; t += 2) {
            const bool last = (t == nt - 2);
            const char* a1 = cA + (size_t)(t + 1) * kstep;
            const char* a2 = last ? nA : cA + (size_t)(t + 2) * kstep; const char* b2 = last ? nB : cB + (size_t)(t + 2) * kstep;
            const char* a3 = a2 + kstep; const char* b3 = b2 + kstep;
            if (last && has_next) S.a_ready(nxt);
            if constexpr (SP2) {
            PG8_LDB(B0, 0, 0); PG8_LDB(B1, 0, 1); PG8_SCHED; PG8_LDA(At, 0, 0); PG8_STAGE(PG8_SA(1, 1), a1 + hstepA, voffA);
            PG8_WAIT_V(8); PG8_WAIT_L(0); PG8_BAR; PG8_MMA(0, 0, At, B0); PG8_MMA(0, 1, At, B1); PG8_BAR; PG8_SCHED;
            PG8_LDA(At, 0, 1); PG8_STAGE(PG8_SB(0, 0), b2, voffB); PG8_STAGE(PG8_SB(0, 1), b2 + hstepB, voffB); PG8_STAGE(PG8_SA(0, 0), a2, voffA);
            PG8_WAIT_V(8); PG8_WAIT_L(0); PG8_BAR; PG8_MMA(1, 0, At, B0); PG8_MMA(1, 1, At, B1); PG8_BAR; PG8_SCHED;
            PG8_LDB(B0, 1, 0); PG8_LDB(B1, 1, 1); PG8_SCHED; PG8_LDA(At, 1, 0); PG8_STAGE(PG8_SA(0, 1), a2 + hstepA, voffA);
            PG8_WAIT_V(8); PG8_WAIT_L(0); PG8_BAR; PG8_MMA(0, 0, At, B0); PG8_MMA(0, 1, At, B1); PG8_BAR; PG8_SCHED;
            PG8_LDA(At, 1, 1); PG8_STAGE(PG8_SB(1, 0), b3, voffB); PG8_STAGE(PG8_SB(1, 1), b3 + hstepB, voffB); PG8_STAGE(PG8_SA(1, 0), a3, voffA);
            PG8_WAIT_V(8); PG8_WAIT_L(0); PG8_BAR; PG8_MMA(1, 0, At, B0); PG8_MMA(1, 1, At, B1); PG8_BAR; PG8_SCHED;
            } else {
            PG8_LDB(B0, 0, 0); PG8_SCHED; PG8_LDA(At, 0, 0); PG8_STAGE(PG8_SA(1, 1), a1 + hstepA, voffA);
            PG8_WAIT_L(8); PG8_BAR; PG8_WAIT_L(0); PG8_MMA(0, 0, At, B0); PG8_BAR; PG8_SCHED;
            PG8_LDB(B1, 0, 1); PG8_STAGE(PG8_SB(0, 0), b2, voffB);
            PG8_BAR; PG8_WAIT_L(0); PG8_MMA(0, 1, At, B1); PG8_BAR;
            PG8_LDA(At, 0, 1); PG8_STAGE(PG8_SA(0, 0), a2, voffA);
            PG8_BAR; PG8_WAIT_L(0); PG8_MMA(1, 0, At, B0); PG8_BAR; PG8_SCHED;
            PG8_STAGE(PG8_SB(0, 1), b2 + hstepB, voffB);
            PG8_WAIT_V(6); PG8_BAR; PG8_MMA(1, 1, At, B1); PG8_BAR;
            PG8_LDB(B0, 1, 0); PG8_SCHED; PG8_LDA(At, 1, 0); PG8_STAGE(PG8_SA(0, 1), a2 + hstepA, voffA);
            PG8_WAIT_L(8); PG8_BAR; PG8_WAIT_L(0); PG8_MMA(0, 0, At, B0); PG8_BAR; PG8_SCHED;
            PG8_LDB(B1, 1, 1); PG8_STAGE(PG8_SB(1, 0), b3, voffB);
            PG8_BAR; PG8_WAIT_L(0); PG8_MMA(0, 1, At, B1); PG8_BAR;
            PG8_LDA(At, 1, 1); PG8_STAGE(PG8_SA(1, 0), a3, voffA);
            PG8_BAR; PG8_WAIT_L(0); PG8_MMA(1, 0, At, B0); PG8_BAR; PG8_SCHED;
            PG8_STAGE(PG8_SB(1, 1), b3 + hstepB, voffB);
            PG8_WAIT_V(6); PG8_BAR; PG8_MMA(1, 1, At, B1); PG8_BAR;
            }
        }
        if constexpr (ALIGN_EPI) { if (wr == 0) PG8_BAR; }
        if constexpr (!Epi::AFTER_DRAIN) { E(acc, cur, wr, wc, fr, fq); S.done(cur); }
        if (!has_next) break;
#pragma unroll
        for (int a = 0; a < 2; ++a)
#pragma unroll
            for (int b = 0; b < 2; ++b)
#pragma unroll
                for (int m = 0; m < 4; ++m)
#pragma unroll
                    for (int n = 0; n < 2; ++n) acc[a][b][m][n] = (f32x4){0.f, 0.f, 0.f, 0.f};
        cur = nxt; cA = nA; cB = nB; ++ui;
        if constexpr (ALIGN_EPI) { if (wr == 1) PG8_BAR; }
    }
    PG8_WAIT_V(0);
    if constexpr (!ALIGN_EPI) { if (wr == 0) PG8_BAR; }
    PG8_BAR;
    if constexpr (Epi::AFTER_DRAIN) { E.fused(acc, cur, wr, wc, fr, fq, lds, wid, lane); S.done(cur); }
#undef PG8_SA
#undef PG8_SB
#undef PG8_STAGE
#undef PG8_LDA
#undef PG8_LDB
#undef PG8_MMA
#undef PG8_WAIT_V
#undef PG8_WAIT_L
#undef PG8_BAR
#undef PG8_SCHED
}
}
#define XB_TMO      128
#define XB_XCNT(j)  (256  + 64 * (j))
#define XB_XSUB(j)  (1280 + 64 * (j))
#define XB_XGEN(j)  (2304 + 64 * (j))
#define XB_TOP      3328
#define XB_TOPGEN   3392
#define XCD_BAR_WORDS 3456
#define XB_SPIN_CAP (1u << 18)

__device__ __forceinline__ unsigned xb_ld(unsigned* p)              { return __hip_atomic_load(p, __ATOMIC_RELAXED, __HIP_MEMORY_SCOPE_AGENT); }
__device__ __forceinline__ unsigned xb_add(unsigned* p, unsigned v) { return __hip_atomic_fetch_add(p, v, __ATOMIC_RELAXED, __HIP_MEMORY_SCOPE_AGENT); }
__device__ __forceinline__ unsigned xb_xcc_id() { return (unsigned)__builtin_amdgcn_s_getreg((3 << 11) | 20) & 0xFu; }
#define XB_SPIN(cond, bar) do { unsigned _sp = 0; while (cond) { __builtin_amdgcn_s_sleep(1); \
    if ((++_sp & 255u) == 0u) { if (xb_ld(&(bar)[XB_TMO])) break; if (_sp > XB_SPIN_CAP) { atomicAdd(&(bar)[XB_TMO], 1u); break; } } } } while (0)

struct XcdBarrier {
    unsigned* bar; unsigned x;
    volatile LAS unsigned* st;
};

__device__ __forceinline__ XcdBarrier xcd_barrier_post(unsigned* bar, volatile LAS unsigned* st) {
    XcdBarrier b; b.bar = bar; b.x = xb_xcc_id(); b.st = st;
    if (threadIdx.x == 0) (void)xb_add(&bar[XB_XCNT(b.x)], 1u);
    return b;
}
__device__ __forceinline__ void xcd_barrier_complete(unsigned* bar, unsigned x, unsigned& nloc, unsigned& nx) {
    const unsigned G = gridDim.x * gridDim.y * gridDim.z;
    unsigned sum, cnt, mine, sp = 0u;
    for (;;) {
        sum = 0u; cnt = 0u; mine = 0u;
#pragma unroll
        for (unsigned j = 0; j < 16; ++j) { const unsigned c = xb_ld(&bar[XB_XCNT(j)]); sum += c; cnt += (c > 0u) ? 1u : 0u; mine = (j == x) ? c : mine; }
        if (sum == G) break;
        __builtin_amdgcn_s_sleep(1);
        if ((++sp & 255u) == 0u) { if (xb_ld(&bar[XB_TMO])) break; if (sp > XB_SPIN_CAP) { atomicAdd(&bar[XB_TMO], 1u); break; } }
    }
    nloc = mine > 0u ? mine : 1u; nx = cnt > 0u ? cnt : 1u;
}

__device__ __forceinline__ void xcd_barrier(const XcdBarrier& b) {
    asm volatile("s_waitcnt vmcnt(0)" ::: "memory");
    __syncthreads();
    if (threadIdx.x == 0) {
        unsigned* bar = b.bar;
        __builtin_amdgcn_s_waitcnt(0);
        unsigned nloc = b.st[0], nx = b.st[1];
        if (nloc == 0u) { xcd_barrier_complete(bar, b.x, nloc, nx); b.st[0] = nloc; b.st[1] = nx; }
        const unsigned old = xb_add(&bar[XB_XSUB(b.x)], 1u);
        const unsigned gen = old / nloc;
        if (old + 1u == (gen + 1u) * nloc) {
            __builtin_amdgcn_fence(__ATOMIC_RELEASE, "agent");
            asm volatile("s_waitcnt vmcnt(0)" ::: "memory");
            const unsigned og = xb_add(&bar[XB_TOP], 1u);
            const unsigned tg = og / nx;
            if (og + 1u == (tg + 1u) * nx) xb_add(&bar[XB_TOPGEN], 1u);
            else XB_SPIN(xb_ld(&bar[XB_TOPGEN]) == tg, bar);
            __builtin_amdgcn_fence(__ATOMIC_ACQUIRE, "agent");
            xb_add(&bar[XB_XGEN(b.x)], 1u);
            asm volatile("s_waitcnt vmcnt(0)" ::: "memory");
        } else {
            XB_SPIN(xb_ld(&bar[XB_XGEN(b.x)]) == gen, bar);
            __builtin_amdgcn_fence(__ATOMIC_ACQUIRE, "agent");
            asm volatile("s_waitcnt vmcnt(0)" ::: "memory");
        }
    }
    __syncthreads();
}

typedef unsigned short bf16;
typedef GAS unsigned gu32;
constexpr int D_MODEL = 1024, SEQ = 2048, D_INNER = 2048, MTOK = 16384, NWAVES = 8;
constexpr float QK_SCALE = 0.08838834764831845f;
constexpr size_t MiB = 1u << 20;
constexpr size_t WS_CTL = 0, CTL_ZERO_BYTES = 64 * 1024, WS_TAB = 1 * MiB, WS_SSQ = 3 * MiB, WS_MASK = 5 * MiB, WS_WIN = 10 * MiB, WS_WOUT = 26 * MiB, WS_U = 30 * MiB, WS_P = 62 * MiB, WS_END = 254 * MiB;
constexpr int CW_BAR = 1024;
constexpr int RING_BYTES = 131072, MISC_OFF = RING_BYTES + 320, LDS_BYTES = 147456;
__host__ __device__ constexpr int n1pad(int L) { return L == 0 ? 3584 : (L == 1 ? 6144 : (L == 2 ? 4096 : 6144)); }
__host__ __device__ constexpr int n1real(int L) { return L == 0 ? 3408 : (L == 1 ? 6144 : (L == 2 ? 4096 : 6144)); }
__host__ __device__ constexpr int nsrc(int L) { return L == 0 ? 5456 : (L == 1 ? 8192 : (L == 2 ? 6144 : 8192)); }
__host__ __device__ constexpr int ocol(int L) { return L == 0 ? 0 : (L == 1 ? 0 : (L == 2 ? 2048 : 4096)); }
constexpr int A_K = 2048, A_V = 2176, A_IQ = 2304, A_IK = 3328, A_IW = 3392;

__device__ __forceinline__ float bf2f(bf16 v) { return __uint_as_float(((unsigned)v) << 16); }
__device__ __forceinline__ bf16 f2bf(float f) { unsigned u = __float_as_uint(f); return (bf16)((u + 0x7fffu + ((u >> 16) & 1u)) >> 16); }
__device__ __forceinline__ unsigned pk2(float lo, float hi) { return (unsigned)f2bf(lo) | ((unsigned)f2bf(hi) << 16); }
__device__ __forceinline__ float wave_sum(float v) {
#pragma unroll
    for (int o = 1; o < 64; o <<= 1) v += __shfl_xor(v, o);
    return v;
}
__device__ __forceinline__ float wave_max(float v) {
#pragma unroll
    for (int o = 1; o < 64; o <<= 1) v = fmaxf(v, __shfl_xor(v, o));
    return v;
}
__device__ __forceinline__ float silu_f(float z) { return z * __builtin_amdgcn_rcpf(1.f + __expf(-z)); }
__device__ __forceinline__ float sigmoid_f(float z) { return __builtin_amdgcn_rcpf(1.f + __expf(-z)); }
#define LDS_WAIT() asm volatile("s_waitcnt lgkmcnt(0)" ::: "memory")

struct Frame {
    LAS unsigned char* lds; volatile LAS unsigned* MISC; unsigned* ctl;
    int tid, lane, wave, G;
    const float* x; const float* norm_g; const float* final_g; const float* w_in[4]; const float* w_out[4]; const float* lb_logits;
    float* H;
    float *cos128, *sin128, *cos64, *sin64, *lb, *ssq; unsigned* mask;
    bf16 *WIN, *WOUT, *U, *P;
};

template <int L> __device__ __forceinline__ int proj_mode(int g32) {
    if (L == 0) return g32 < 68 ? 1 : (g32 < 72 ? 0 : (g32 < 106 ? 2 : 0));
    if (L == 1) return g32 < 128 ? 1 : 0;
    if (L == 2) return g32 < 32 ? 1 : (g32 < 64 ? 3 : 0);
    return 0;
}
template <int L> struct EpiProj {
    static constexpr bool PERM = true, AFTER_DRAIN = false;
    bf16* P; int ldp; const float *c128, *s128, *c64, *s64;
    __device__ __forceinline__ void operator()(const pg8::f32x4 (&acc)[2][2][4][2], const pg8::Unit& u, int wr, int wc, int fr, int fq) const {
        const int row0 = u.pm * 256 + wr * 64 + fr, colb = u.pn * 256 + wc * 32 + 8 * fq;
#pragma unroll
        for (int bj = 0; bj < 2; ++bj) {
            const int col = colb + bj * 128; const int mode = proj_mode<L>(__builtin_amdgcn_readfirstlane(col >> 5));
#pragma unroll
            for (int ai = 0; ai < 2; ++ai)
#pragma unroll
                for (int m = 0; m < 4; ++m) {
                    const int row = row0 + ai * 128 + m * 16, pos = row & (SEQ - 1);
                    pg8::f32x4 v0 = acc[ai][bj][m][0], v1 = acc[ai][bj][m][1];
                    if (mode == 1 || mode == 3) { const int i0 = ((col & 127) >> 3) * 4;
                        const pg8::f32x4 c = *(const pg8::f32x4*)(c128 + pos * 64 + i0), s = *(const pg8::f32x4*)(s128 + pos * 64 + i0);
                        const pg8::f32x4 o1 = v0 * c - v1 * s, o2 = v0 * s + v1 * c; v0 = o1; v1 = o2;
                        if (mode == 3) { v0 = v0 * QK_SCALE; v1 = v1 * QK_SCALE; } }
                    else if (mode == 2) { const int i0 = ((col & 63) >> 3) * 4;
                        const pg8::f32x4 c = *(const pg8::f32x4*)(c64 + pos * 32 + i0), s = *(const pg8::f32x4*)(s64 + pos * 32 + i0);
                        const pg8::f32x4 o1 = v0 * c - v1 * s, o2 = v0 * s + v1 * c; v0 = o1; v1 = o2; }
                    pg8::u32x4 w; w.x = pg8::cvt_pk_bf16(v0[0], v0[1]); w.y = pg8::cvt_pk_bf16(v0[2], v0[3]); w.z = pg8::cvt_pk_bf16(v1[0], v1[1]); w.w = pg8::cvt_pk_bf16(v1[2], v1[3]);
                    *(pg8::u32x4*)(P + (size_t)row * ldp + col) = w;
                }
        }
    }
};
template <int L> struct EpiGate {
    static constexpr bool PERM = true, AFTER_DRAIN = false;
    bf16* O; int ldo; const float* ssq;
    __device__ __forceinline__ void operator()(const pg8::f32x4 (&acc)[2][2][4][2], const pg8::Unit& u, int wr, int wc, int fr, int fq) const {
        const int row0 = u.pm * 256 + wr * 64 + fr, colb = u.pn * 256 + wc * 32 + 8 * fq;
#pragma unroll
        for (int ai = 0; ai < 2; ++ai)
#pragma unroll
            for (int m = 0; m < 4; ++m) {
                const int row = row0 + ai * 128 + m * 16;
#pragma unroll
                for (int bj = 0; bj < 2; ++bj) {
                    const int col = colb + bj * 128; float rs = 1.f;
                    if (L == 2) { const pg8::f32x4 q = *(const pg8::f32x4*)(ssq + ((size_t)row * 8 + (col >> 8)) * 4); rs = rsqrtf(((q[0] + q[1]) + (q[2] + q[3])) * (1.f / 256.f) + 1e-6f); }
                    if (L == 3) { const float2 q = *(const float2*)(ssq + ((size_t)row * 16 + (col >> 7)) * 2); rs = rsqrtf((q.x + q.y) * (1.f / 128.f) + 1e-6f); }
                    bf16* p = O + (size_t)row * ldo + col; const pg8::u32x4 r = *(const pg8::u32x4*)p;
                    const pg8::f32x4 z0 = acc[ai][bj][m][0], z1 = acc[ai][bj][m][1];
                    float o[8]; o[0] = __uint_as_float(r.x << 16); o[1] = __uint_as_float(r.x & 0xffff0000u); o[2] = __uint_as_float(r.y << 16); o[3] = __uint_as_float(r.y & 0xffff0000u);
                    o[4] = __uint_as_float(r.z << 16); o[5] = __uint_as_float(r.z & 0xffff0000u); o[6] = __uint_as_float(r.w << 16); o[7] = __uint_as_float(r.w & 0xffff0000u);
#pragma unroll
                    for (int j = 0; j < 4; ++j) { o[j] = o[j] * rs * silu_f(z0[j]); o[4 + j] = o[4 + j] * rs * silu_f(z1[j]); }
                    pg8::u32x4 w; w.x = pg8::cvt_pk_bf16(o[0], o[1]); w.y = pg8::cvt_pk_bf16(o[2], o[3]); w.z = pg8::cvt_pk_bf16(o[4], o[5]); w.w = pg8::cvt_pk_bf16(o[6], o[7]);
                    *(pg8::u32x4*)p = w;
                }
            }
    }
};
struct EpiAddF32 {
    static constexpr bool PERM = false, AFTER_DRAIN = false;
    float* C; int ldc;
    __device__ __forceinline__ void operator()(const pg8::f32x4 (&acc)[2][2][4][2], const pg8::Unit& u, int wr, int wc, int fr, int fq) const {
        const int row0 = u.pm * 256 + wr * 64 + fr, col0 = u.pn * 256 + wc * 32 + 4 * fq;
#pragma unroll
        for (int ai = 0; ai < 2; ++ai)
#pragma unroll
            for (int m = 0; m < 4; ++m) { float* rowp = C + (size_t)(row0 + ai * 128 + m * 16) * ldc + col0;
#pragma unroll
                for (int bj = 0; bj < 2; ++bj)
#pragma unroll
                    for (int n = 0; n < 2; ++n) { pg8::f32x4* p = (pg8::f32x4*)(rowp + bj * 128 + n * 16); *p = *p + acc[ai][bj][m][n]; } }
    }
};

template <int L> __device__ __forceinline__ int srccol(int n) {
    if (n >= n1pad(L)) return n1real(L) + (n - n1pad(L));
    if (n >= n1real(L)) return -1;
    const int mode = proj_mode<L>(n >> 5);
    if (mode == 1 || mode == 3) { const int w = n & 127; return (n & ~127) + 64 * ((w >> 2) & 1) + 4 * (w >> 3) + (w & 3); }
    if (mode == 2) { const int r = n - A_IQ, w = r & 63; return A_IQ + (r & ~63) + 32 * ((w >> 2) & 1) + 4 * (w >> 3) + (w & 3); }
    return n;
}
template <int L  > __device__ __forceinline__ void conv_item(const float* W, int Nsrc, bf16* WT, int Kdim, int nblk, int item, LAS float* scr, int lane) {
    const int kb = item / nblk, nb = item % nblk, k0 = 64 * kb, n0 = 32 * nb;
    int src = n0 + (lane & 31); if (L >= 0) src = srccol<(L < 0 ? 0 : L)>(src);
#pragma unroll 8
    for (int i = 0; i < 32; ++i) { const int kk = 2 * i + (lane >> 5); scr[kk * 33 + (lane & 31)] = (src >= 0) ? W[(size_t)(k0 + kk) * Nsrc + src] : 0.f; }
    LDS_WAIT();
    const int c = lane & 7;
#pragma unroll
    for (int j = 0; j < 4; ++j) { const int n = (lane >> 3) + 8 * j; const LAS float* s = scr + (8 * c) * 33 + n;
        pg8::u32x4 o; o.x = pk2(s[0 * 33], s[1 * 33]); o.y = pk2(s[2 * 33], s[3 * 33]); o.z = pk2(s[4 * 33], s[5 * 33]); o.w = pk2(s[6 * 33], s[7 * 33]);
        *(pg8::u32x4*)(WT + (size_t)(n0 + n) * Kdim + k0 + 8 * c) = o; }
    LDS_WAIT();
}
template <int L> __device__ __forceinline__ void conv_weights(Frame& F) {
    LAS float* scr = (LAS float*)(F.lds + F.wave * 16384);
    const int gw = blockIdx.x * NWAVES + F.wave, NGW = F.G * NWAVES;
    constexpr int NB_IN = (n1pad(L) + 2048) / 32, I_IN = NB_IN * (1024 / 64), NB_OUT = 1024 / 32, I_OUT = NB_OUT * (2048 / 64);
    for (int it = gw; it < I_IN + I_OUT; it += NGW) {
        if (it < I_IN) conv_item<L>(F.w_in[L], nsrc(L), F.WIN, 1024, NB_IN, it, scr, F.lane);
        else conv_item<-1>(F.w_out[L], 1024, F.WOUT, 2048, NB_OUT, it - I_IN, scr, F.lane);
    }
}
__device__ __forceinline__ void norm_rows(Frame& F, const float* src, const float* g, float* copy_to) {
    const int gw = blockIdx.x * NWAVES + F.wave, NGW = F.G * NWAVES;
    for (int row = gw; row < MTOK; row += NGW) {
        const float4* xr = (const float4*)(src + (size_t)row * D_MODEL) + F.lane;
        float4 v[4]; float s = 0.f;
#pragma unroll
        for (int j = 0; j < 4; ++j) { v[j] = xr[64 * j]; s += v[j].x * v[j].x + v[j].y * v[j].y + v[j].z * v[j].z + v[j].w * v[j].w; }
        const float r = rsqrtf(wave_sum(s) * (1.f / D_MODEL) + 1e-6f);
#pragma unroll
        for (int j = 0; j < 4; ++j) {
            const float4 gg = ((const float4*)g)[F.lane + 64 * j];
            if (copy_to) ((float4*)(copy_to + (size_t)row * D_MODEL))[F.lane + 64 * j] = v[j];
            uint2 o; o.x = pk2(v[j].x * r * gg.x, v[j].y * r * gg.y); o.y = pk2(v[j].z * r * gg.z, v[j].w * r * gg.w);
            *(uint2*)(F.U + (size_t)row * D_MODEL + (F.lane + 64 * j) * 4) = o;
        }
    }
}
__device__ __forceinline__ void final_rows(Frame& F) {
    const int gw = blockIdx.x * NWAVES + F.wave, NGW = F.G * NWAVES;
    for (int row = gw; row < MTOK; row += NGW) {
        float4* xr = (float4*)(F.H + (size_t)row * D_MODEL) + F.lane;
        float4 v[4]; float s = 0.f;
#pragma unroll
        for (int j = 0; j < 4; ++j) { v[j] = xr[64 * j]; s += v[j].x * v[j].x + v[j].y * v[j].y + v[j].z * v[j].z + v[j].w * v[j].w; }
        const float r = rsqrtf(wave_sum(s) * (1.f / D_MODEL) + 1e-6f);
#pragma unroll
        for (int j = 0; j < 4; ++j) { const float4 gg = ((const float4*)F.final_g)[F.lane + 64 * j]; xr[64 * j] = make_float4(v[j].x * r * gg.x, v[j].y * r * gg.y, v[j].z * r * gg.z, v[j].w * r * gg.w); }
    }
}
__device__ __forceinline__ void make_tables(Frame& F) {
    const int gt = blockIdx.x * 512 + F.tid, NT = F.G * 512;
    for (int i = gt; i < 2048 * 64; i += NT) {
        { const int pos = i >> 6, f = i & 63; const float freq = exp2f(-((float)(2 * f) / 128.f) * 13.287712379549449f);
          double rev = (double)pos * (double)freq * 0.15915494309189535; rev -= floor(rev);
          F.cos128[i] = __builtin_amdgcn_cosf((float)rev); F.sin128[i] = __builtin_amdgcn_sinf((float)rev); }
        if (i < 2048 * 32) { const int pos = i >> 5, f = i & 31; const float freq = exp2f(-((float)(2 * f) / 64.f) * 13.287712379549449f);
          double rev = (double)pos * (double)freq * 0.15915494309189535; rev -= floor(rev);
          F.cos64[i] = __builtin_amdgcn_cosf((float)rev); F.sin64[i] = __builtin_amdgcn_sinf((float)rev); }
        if (i < 2048) { const float l0 = F.lb_logits[i], l1 = F.lb_logits[2048 + i], l2 = F.lb_logits[4096 + i], l3 = F.lb_logits[6144 + i];
          const float m = fmaxf(fmaxf(l0, l1), fmaxf(l2, l3)); const float e0 = __expf(l0 - m), e1 = __expf(l1 - m), e2 = __expf(l2 - m), e3 = __expf(l3 - m);
          F.lb[i] = (e1 + e2 + e3) / (e0 + e1 + e2 + e3); }
    }
}

__device__ __forceinline__ unsigned fkey(float f) { const unsigned u = __float_as_uint(f + 0.0f); return (u & 0x80000000u) ? ~u : (u | 0x80000000u); }

__device__ __forceinline__ void naive_index_topk(Frame& F) {
    const bf16* P = F.P; constexpr int ldp = n1pad(0); const int tid = F.tid;
    LAS float* iq = (LAS float*)F.lds; LAS float* iw = iq + 1024; LAS float* sc = iw + 16; LAS unsigned* mw = (LAS unsigned*)(sc + 2048); LAS unsigned* cnt = mw + 64;
    for (int row = blockIdx.x; row < MTOK; row += F.G) {
        const int t = row & (SEQ - 1), rb = row - t;
        for (int i = tid; i < 1024; i += 512) iq[i] = bf2f(P[(size_t)row * ldp + A_IQ + i]);
        if (tid < 16) iw[tid] = bf2f(P[(size_t)row * ldp + A_IW + tid]) * (1.f / 32.f);
        if (tid < 64) mw[tid] = 0u;
        __syncthreads();
        for (int s = tid; s <= t; s += 512) {
            const uint4* kp = (const uint4*)(P + (size_t)(rb + s) * ldp + A_IK);
            float kk[64];
#pragma unroll
            for (int c = 0; c < 8; ++c) { const uint4 r = kp[c]; const unsigned w[4] = {r.x, r.y, r.z, r.w};
#pragma unroll
                for (int j = 0; j < 4; ++j) { kk[c * 8 + 2 * j] = __uint_as_float(w[j] << 16); kk[c * 8 + 2 * j + 1] = __uint_as_float(w[j] & 0xffff0000u); } }
            float score = 0.f;
            for (int h = 0; h < 16; ++h) { float d = 0.f;
#pragma unroll
                for (int j = 0; j < 64; ++j) d = fmaf(iq[h * 64 + j], kk[j], d);
                score += fmaxf(d, 0.f) * iw[h]; }
            sc[s] = score;
        }
        __syncthreads();
        if (t + 1 <= 256) { for (int s = tid; s <= t; s += 512) atomicOr((unsigned*)&mw[s >> 5], 1u << (s & 31)); }
        else {
            unsigned myk[4];
#pragma unroll
            for (int j = 0; j < 4; ++j) { const int s = tid + 512 * j; myk[j] = (s <= t) ? fkey(sc[s]) : 0u; }
            unsigned prefix = 0u;
            for (int bit = 31; bit >= 0; --bit) {
                const unsigned cand = prefix | (1u << bit); unsigned c = 0;
#pragma unroll
                for (int j = 0; j < 4; ++j) c += (myk[j] >= cand) ? 1u : 0u;
                if (tid == 0) *cnt = 0u;
                __syncthreads(); if (c) atomicAdd((unsigned*)cnt, c); __syncthreads();
                const unsigned total = *cnt; __syncthreads();
                if (total >= 256u) prefix = cand;
            }
            unsigned cg = 0, ce = 0;
#pragma unroll
            for (int j = 0; j < 4; ++j) { cg += (myk[j] > prefix) ? 1u : 0u; ce += (myk[j] == prefix) ? 1u : 0u; }
            if (tid == 0) *cnt = 0u;
            __syncthreads(); atomicAdd((unsigned*)cnt, cg | (ce << 16)); __syncthreads();
            const unsigned tot = *cnt; const int n_gt = (int)(tot & 0xffffu), n_eq = (int)(tot >> 16); const int need = 256 - n_gt;
#pragma unroll
            for (int j = 0; j < 4; ++j) { const int s = tid + 512 * j; if (myk[j] > prefix || (myk[j] == prefix && n_eq == need)) atomicOr((unsigned*)&mw[s >> 5], 1u << (s & 31)); }
            if (n_eq != need && tid == 0) { int left = need; for (int s = 0; s <= t && left > 0; ++s) if (fkey(sc[s]) == prefix) { atomicOr((unsigned*)&mw[s >> 5], 1u << (s & 31)); --left; } }
        }
        __syncthreads();
        if (tid < 64) F.mask[(size_t)row * 64 + tid] = mw[tid];
        __syncthreads();
    }
}

template <int MODE> __device__ __forceinline__ void naive_attn(Frame& F, int ldp, int koff, int voff, int kvhs) {
    bf16* P = F.P; const int tid = F.tid, lane = F.lane, wv = F.wave;
    LAS int* keys = (LAS int*)F.lds; LAS float* qs = (LAS float*)(keys + 400); LAS float* sc = qs + 2048; LAS float* linv = sc + 16 * 400; LAS int* pre = (LAS int*)(linv + 16); LAS int* nk_s = pre + 64;
    for (int row = blockIdx.x; row < MTOK; row += F.G) {
        const int t = row & (SEQ - 1), rb = row - t;
        for (int i = tid; i < 2048; i += 512) qs[i] = bf2f(P[(size_t)row * ldp + i]);
        if (MODE == 0) {
            unsigned w = 0; if (tid < 64) { w = F.mask[(size_t)row * 64 + tid]; pre[tid] = __popc(w); }
            __syncthreads();
            if (tid == 0) { int run = 0; for (int i = 0; i < 64; ++i) { const int x = pre[i]; pre[i] = run; run += x; } *nk_s = run; }
            __syncthreads();
            if (tid < 64) { int pos = pre[tid]; while (w) { const int b = __ffs(w) - 1; keys[pos++] = tid * 32 + b; w &= w - 1; } }
        } else {
            if (tid < 387) { const int cfg = tid / 129, j = tid % 129, dil = cfg == 0 ? 1 : (cfg == 1 ? 4 : 16); const int s = t - j * dil; keys[tid] = s >= 0 ? s : -1; }
            if (tid == 0) *nk_s = 387;
        }
        __syncthreads();
        const int nk = *nk_s;
        if (tid < nk) {
            const int e = tid, s = keys[e];
#pragma unroll 1
            for (int h = 0; h < 16; ++h) {
                float d = -__builtin_inff();
                if (s >= 0) { const uint4* kp = (const uint4*)(P + (size_t)(rb + s) * ldp + koff + h * kvhs); d = 0.f;
#pragma unroll
                    for (int c = 0; c < 16; ++c) { const uint4 r = kp[c]; const unsigned w[4] = {r.x, r.y, r.z, r.w}; const LAS float* qp = qs + h * 128 + c * 8;
#pragma unroll
                        for (int j = 0; j < 4; ++j) { d = fmaf(qp[2 * j], __uint_as_float(w[j] << 16), d); d = fmaf(qp[2 * j + 1], __uint_as_float(w[j] & 0xffff0000u), d); } }
                    d *= QK_SCALE; }
                sc[h * 400 + e] = d;
            }
        }
        __syncthreads();
        for (int hh = 0; hh < 2; ++hh) { const int h = wv * 2 + hh; float m = -__builtin_inff();
            for (int e = lane; e < nk; e += 64) m = fmaxf(m, sc[h * 400 + e]);
            m = wave_max(m); float sum = 0.f;
            for (int e = lane; e < nk; e += 64) { const float p = __expf(sc[h * 400 + e] - m); sc[h * 400 + e] = p; sum += p; }
            sum = wave_sum(sum); if (lane == 0) linv[h] = 1.f / sum; }
        __syncthreads();
        const int d = tid & 127, hg = tid >> 7; float acc[4] = {0.f, 0.f, 0.f, 0.f};
        for (int e = 0; e < nk; ++e) { const int s = keys[e]; if (s < 0) continue; const bf16* vp = P + (size_t)(rb + s) * ldp + voff + d;
#pragma unroll
            for (int j = 0; j < 4; ++j) { const int h = hg * 4 + j; acc[j] = fmaf(sc[h * 400 + e], bf2f(vp[h * kvhs]), acc[j]); } }
#pragma unroll
        for (int j = 0; j < 4; ++j) { const int h = hg * 4 + j; P[(size_t)row * ldp + h * 128 + d] = f2bf(acc[j] * linv[h]); }
        __syncthreads();
    }
}

__device__ __forceinline__ void naive_ret(Frame& F) {
    if (blockIdx.x >= 32) return;
    bf16* P = F.P; constexpr int ldp = n1pad(2);
    const int grp = F.tid >> 8, tid = F.tid & 255, lane = tid & 63, wv = tid >> 6, item = blockIdx.x * 2 + grp, bl = item >> 3, h = item & 7;
    const float gamma = 1.f - exp2f(-5.f - (float)h);
    LAS float* base = (LAS float*)(F.lds + grp * 40960);
    LAS float* qs = base; LAS float* ks = qs + 16 * 128; LAS float* ob = ks + 16 * 128; LAS float* sq = ob + 16 * 256;
    float S[128];
#pragma unroll
    for (int i = 0; i < 128; ++i) S[i] = 0.f;
    for (int t0 = 0; t0 < SEQ; t0 += 16) {
        const size_t row0 = (size_t)bl * SEQ + t0;
        for (int i = tid; i < 16 * 128; i += 256) { const int tt = i >> 7, c = i & 127; const bf16* pr = P + (row0 + tt) * ldp + h * 128 + c; qs[i] = bf2f(pr[0]); ks[i] = bf2f(pr[1024]); }
        __syncthreads();
#pragma unroll 1
        for (int tt = 0; tt < 16; ++tt) {
            const float v = bf2f(P[(row0 + tt) * ldp + 2048 + h * 256 + tid]); float o = 0.f;
#pragma unroll
            for (int i = 0; i < 128; i += 4) { const pg8::f32x4 k4 = *(const LAS pg8::f32x4*)&ks[tt * 128 + i], q4 = *(const LAS pg8::f32x4*)&qs[tt * 128 + i];
                S[i] = fmaf(gamma, S[i], k4.x * v); o = fmaf(q4.x, S[i], o); S[i + 1] = fmaf(gamma, S[i + 1], k4.y * v); o = fmaf(q4.y, S[i + 1], o);
                S[i + 2] = fmaf(gamma, S[i + 2], k4.z * v); o = fmaf(q4.z, S[i + 2], o); S[i + 3] = fmaf(gamma, S[i + 3], k4.w * v); o = fmaf(q4.w, S[i + 3], o); }
            ob[tt * 256 + tid] = o;
        }
        __syncthreads();
        for (int j = 0; j < 4; ++j) { const int tt = wv * 4 + j; float s = 0.f; for (int c = lane; c < 256; c += 64) s += ob[tt * 256 + c] * ob[tt * 256 + c]; s = wave_sum(s);
            if (lane < 4) F.ssq[((row0 + tt) * 8 + h) * 4 + lane] = lane == 0 ? s : 0.f; }
        for (int tt = 0; tt < 16; ++tt) P[(row0 + tt) * ldp + 2048 + h * 256 + tid] = f2bf(ob[tt * 256 + tid]);
        __syncthreads();
    }
}

__device__ __forceinline__ void naive_hgrn(Frame& F) {
    if (blockIdx.x >= 32) return;
    bf16* P = F.P; constexpr int ldp = n1pad(3);
    const int grp = F.tid >> 7, tid = F.tid & 127, lane = tid & 63, wv = tid >> 6, item = blockIdx.x * 4 + grp, bl = item >> 4, h = item & 15;
    LAS float* base = (LAS float*)(F.lds + grp * 28672);
    LAS float* qs = base; LAS float* gs = qs + 16 * 128; LAS float* ob = gs + 16 * 128;
    const float lbc = F.lb[h * 128 + tid];
    float S[128];
#pragma unroll
    for (int i = 0; i < 128; ++i) S[i] = 0.f;
    for (int t0 = 0; t0 < SEQ; t0 += 16) {
        const size_t row0 = (size_t)bl * SEQ + t0;
        for (int tt = 0; tt < 16; ++tt) { const bf16* pr = P + (row0 + tt) * ldp + h * 128 + tid;
            qs[tt * 128 + tid] = silu_f(bf2f(pr[0])) * QK_SCALE; gs[tt * 128 + tid] = lbc + (1.f - lbc) * sigmoid_f(bf2f(pr[2048])); }
        __syncthreads();
#pragma unroll 1
        for (int tt = 0; tt < 16; ++tt) {
            const float v = bf2f(P[(row0 + tt) * ldp + 4096 + h * 128 + tid]); float o = 0.f;
#pragma unroll
            for (int i = 0; i < 128; i += 4) { const pg8::f32x4 g4 = *(const LAS pg8::f32x4*)&gs[tt * 128 + i], q4 = *(const LAS pg8::f32x4*)&qs[tt * 128 + i];
                S[i] = fmaf(g4.x, S[i] - v, v); o = fmaf(q4.x, S[i], o); S[i + 1] = fmaf(g4.y, S[i + 1] - v, v); o = fmaf(q4.y, S[i + 1], o);
                S[i + 2] = fmaf(g4.z, S[i + 2] - v, v); o = fmaf(q4.z, S[i + 2], o); S[i + 3] = fmaf(g4.w, S[i + 3] - v, v); o = fmaf(q4.w, S[i + 3], o); }
            ob[tt * 128 + tid] = o;
        }
        __syncthreads();
        for (int j = 0; j < 8; ++j) { const int tt = wv * 8 + j; float s = ob[tt * 128 + lane] * ob[tt * 128 + lane] + ob[tt * 128 + lane + 64] * ob[tt * 128 + lane + 64]; s = wave_sum(s);
            if (lane < 2) F.ssq[((row0 + tt) * 16 + h) * 2 + lane] = lane == 0 ? s : 0.f; }
        for (int tt = 0; tt < 16; ++tt) P[(row0 + tt) * ldp + 4096 + h * 128 + tid] = f2bf(ob[tt * 128 + tid]);
        __syncthreads();
    }
}

struct Args { const float* in[12]; float* out; unsigned char* ws; };
template <int L> __device__ __forceinline__ void mixer_phase(Frame& F, const XcdBarrier& bar) {
    if (L == 0) { naive_index_topk(F); xcd_barrier(bar); naive_attn<0>(F, n1pad(0), A_K, A_V, 0); }
    if (L == 1) naive_attn<1>(F, n1pad(1), 2048, 4096, 128);
    if (L == 2) naive_ret(F);
    if (L == 3) naive_hgrn(F);
}
template <int L> __device__ __forceinline__ void layer_phases(Frame& F, const XcdBarrier& bar) {
    constexpr int N1 = n1pad(L);
    {
        pg8::Gemm g{F.U, F.WIN, MTOK, N1, D_MODEL, D_MODEL}; pg8::StaticOrder S; S.init(MTOK, N1, F.G, (int)blockIdx.x);
        EpiProj<L> E{F.P, N1, F.cos128, F.sin128, F.cos64, F.sin64};
        pg8::gemm_phase<EpiProj<L>, pg8::StaticOrder, true, true>(F.lds, g, S, E);
    }
    xcd_barrier(bar);
    mixer_phase<L>(F, bar);
    xcd_barrier(bar);
    {
        pg8::Gemm g{F.U, F.WIN + (size_t)N1 * D_MODEL, MTOK, D_INNER, D_MODEL, D_MODEL}; pg8::StaticOrder S; S.init(MTOK, D_INNER, F.G, (int)blockIdx.x);
        EpiGate<L> E{F.P + ocol(L), N1, F.ssq};
        pg8::gemm_phase<EpiGate<L>, pg8::StaticOrder, true, true>(F.lds, g, S, E);
    }
    xcd_barrier(bar);
    {
        pg8::Gemm g{F.P + ocol(L), F.WOUT, MTOK, D_MODEL, D_INNER, N1}; pg8::StaticOrder S; S.init(MTOK, D_MODEL, F.G, (int)blockIdx.x);
        EpiAddF32 E{F.H, D_MODEL};
        pg8::gemm_phase<EpiAddF32, pg8::StaticOrder, true, true>(F.lds, g, S, E);
    }
    xcd_barrier(bar);
    if (L < 3) { norm_rows(F, F.H, F.norm_g + (L + 1) * D_MODEL, nullptr); conv_weights<(L < 3 ? L + 1 : 3)>(F); xcd_barrier(bar); }
    else final_rows(F);
}
__global__ void __launch_bounds__(NWAVES * 64, 2) mega_fwd(Args args) {
    extern __shared__ __attribute__((aligned(16))) unsigned char lds_raw[];
    Frame F;
    F.lds = (LAS unsigned char*)lds_raw; F.MISC = (volatile LAS unsigned*)(F.lds + MISC_OFF);
    F.tid = threadIdx.x; F.lane = F.tid & 63; F.wave = __builtin_amdgcn_readfirstlane(F.tid >> 6); F.G = gridDim.x;
    unsigned char* ws = args.ws;
    F.ctl = (unsigned*)(ws + WS_CTL);
    F.x = args.in[0]; F.norm_g = args.in[1]; F.final_g = args.in[2];
    F.w_in[0] = args.in[3]; F.w_out[0] = args.in[4]; F.w_in[1] = args.in[5]; F.w_out[1] = args.in[6]; F.w_in[2] = args.in[7]; F.w_out[2] = args.in[8]; F.w_in[3] = args.in[9]; F.w_out[3] = args.in[10];
    F.lb_logits = args.in[11]; F.H = args.out;
    F.cos128 = (float*)(ws + WS_TAB); F.sin128 = F.cos128 + 2048 * 64; F.cos64 = F.sin128 + 2048 * 64; F.sin64 = F.cos64 + 2048 * 32; F.lb = F.sin64 + 2048 * 32;
    F.ssq = (float*)(ws + WS_SSQ); F.mask = (unsigned*)(ws + WS_MASK);
    F.WIN = (bf16*)(ws + WS_WIN); F.WOUT = (bf16*)(ws + WS_WOUT); F.U = (bf16*)(ws + WS_U); F.P = (bf16*)(ws + WS_P);
    for (int u = F.tid; u < (LDS_BYTES - RING_BYTES) / 4; u += NWAVES * 64) ((LAS unsigned*)(F.lds + RING_BYTES))[u] = 0u;
    __syncthreads();
    const XcdBarrier bar = xcd_barrier_post(F.ctl + CW_BAR, F.MISC + 8);
    make_tables(F); norm_rows(F, F.x, F.norm_g, F.H); conv_weights<0>(F);
    xcd_barrier(bar);
    layer_phases<0>(F, bar);
    layer_phases<1>(F, bar);
    layer_phases<2>(F, bar);
    layer_phases<3>(F, bar);
}

extern "C" void kernel_launch(void* const* d_in, const int* in_sizes, int n_in, void* d_out, int out_size, void* d_ws, size_t ws_size, hipStream_t stream) {
    static int grid = 0;
    if (grid == 0) {
        int dev = 0, cus = 0;
        if (hipGetDevice(&dev) != hipSuccess || hipDeviceGetAttribute(&cus, hipDeviceAttributeMultiprocessorCount, dev) != hipSuccess) { grid = -1; return; }
        if (hipFuncSetAttribute((const void*)mega_fwd, hipFuncAttributeMaxDynamicSharedMemorySize, LDS_BYTES) != hipSuccess) { grid = -1; return; }
        int per_cu = 0; (void)hipOccupancyMaxActiveBlocksPerMultiprocessor(&per_cu, (const void*)mega_fwd, NWAVES * 64, LDS_BYTES); (void)hipGetLastError();
        grid = cus;
        if (ws_size < WS_END || n_in != 12) { fprintf(stderr, "kernel_launch: unexpected workspace / inputs\n"); grid = -1; return; }
    }
    if (grid < 0) return;
    (void)hipMemsetAsync((char*)d_ws + WS_CTL, 0, CTL_ZERO_BYTES, stream);
    Args a; for (int i = 0; i < 12; ++i) a.in[i] = (const float*)d_in[i];
    a.out = (float*)d_out; a.ws = (unsigned char*)d_ws;
    hipLaunchKernelGGL(mega_fwd, dim3(grid), dim3(NWAVES * 64), LDS_BYTES, stream, a);
}
```

```cpp
#include <hip/hip_runtime.h>
#include <cstdio>
#include <cstdint>
#define GAS __attribute__((address_space(1)))
#define LAS __attribute__((address_space(3)))
namespace pg8 {
#define PG8_LAS __attribute__((address_space(3)))
typedef unsigned short bf16_t;
typedef short bf16x8 __attribute__((ext_vector_type(8)));
typedef float f32x4 __attribute__((ext_vector_type(4)));
typedef unsigned u32x4 __attribute__((ext_vector_type(4)));
constexpr int BM = 256, BK = 64, HALF = 128, HTB = HALF * BK * 2  , STAGE_BYTES = 8 * HTB, NXCD = 8, WGM = 8;

__host__ __device__ __forceinline__ int lds_byte(int r, int c) { const int st = (r >> 4) * 2 + (c >> 5), rr = r & 15, cc = c & 31, ob = rr * 64 + cc * 2; return st * 1024 + (ob ^ (((ob >> 9) & 1) << 5)); }
__host__ __device__ __forceinline__ void stage_rc(int b, int& R, int& C) { const int st = b / 1024, sb = b % 1024, swz = sb ^ (((sb >> 9) & 1) << 5); R = (st >> 1) * 16 + swz / 64; C = (st & 1) * 32 + (swz % 64) / 2; }
__host__ __device__ __forceinline__ int perm32(int rho) { const int n = rho >> 4, i = rho & 15; return 8 * (i >> 2) + 4 * n + (i & 3); }

struct Unit { int pm, pn; };
struct Gemm { const bf16_t* A; const bf16_t* Bt; int M, N, K, lda; };

struct StaticOrder {
    int nM, nN, nwg, G, c;
    __host__ __device__ void init(int M, int N, int G_, int c_) { nM = M / BM; nN = N / BM; nwg = nM * nN; G = G_; c = c_; }
    __host__ __device__ bool next(int i, Unit& u) const {
        const long L = (long)i * G + c; if (L >= nwg) return false;
        int wgid = (int)L; { const int q = nwg / NXCD, r = nwg % NXCD, xcd = wgid % NXCD, off = wgid / NXCD; wgid = (xcd < r ? xcd * (q + 1) : r * (q + 1) + (xcd - r) * q) + off; }
        const int nig = WGM * nN, gid = wgid / nig, fm = gid * WGM, gsz = (nM - fm) < WGM ? (nM - fm) : WGM;
        u.pm = fm + ((wgid % nig) % gsz); u.pn = (wgid % nig) / gsz; return true;
    }
    __device__ __forceinline__ void a_ready(const Unit&) const {}
    __device__ __forceinline__ void done(const Unit&) const {}
};

__device__ __forceinline__ unsigned cvt_pk_bf16(float lo, float hi) { unsigned r; asm volatile("v_cvt_pk_bf16_f32 %0, %1, %2" : "=v"(r) : "v"(lo), "v"(hi)); return r; }
typedef float f32x2 __attribute__((ext_vector_type(2)));
template <class Epi, class Sched, bool ALIGN_EPI = false, bool SP2 = false>
__device__ __forceinline__ void gemm_phase(PG8_LAS unsigned char* lds, const Gemm g, const Sched& S, const Epi& E) {
    int tid_o = threadIdx.x; asm volatile("" : "+v"(tid_o));
    const int tid = tid_o, wid = __builtin_amdgcn_readfirstlane(tid >> 6), lane = tid & 63, wr = wid >> 2, wc = wid & 3, fr = lane & 15, fq = lane >> 4;
    const int K = g.K, nt = K / BK;
    unsigned voffA[2], voffB[2];
#pragma unroll
    for (int i = 0; i < 2; ++i) { int R, C; stage_rc(tid * 16 + i * 8192, R, C); const int Rb = Epi::PERM ? ((R & ~31) + perm32(R & 31)) : R;
        voffA[i] = (unsigned)(R * g.lda + C) * 2u; voffB[i] = (unsigned)(Rb * K + C) * 2u; }
    const size_t kstep = (size_t)(BK * 2);
    const size_t hstepA = (size_t)HALF * g.lda * 2, hstepB = (size_t)HALF * K * 2;
    const size_t tstepA = 2 * hstepA, tstepB = 2 * hstepB;
    const unsigned ldsw = (unsigned)wid * 1024u;
    const int aoff = lds_byte(wr * 64 + fr, fq * 8), boff = lds_byte(wc * 32 + fr, fq * 8);
#define PG8_SA(b, h) (((b) * 2 + (h)) * HTB)
#define PG8_SB(b, h) ((4 + (b) * 2 + (h)) * HTB)
#define PG8_STAGE(bufoff, gbase, voff) do { _Pragma("unroll") for (int _i = 0; _i < 2; ++_i) \
        __builtin_amdgcn_global_load_lds((const unsigned*)((const char*)(gbase) + (voff)[_i]), (PG8_LAS unsigned*)(lds + (bufoff) + ldsw + _i * 8192), 16, 0, 0); } while (0)
#define PG8_LDA(dst, b, h) do { _Pragma("unroll") for (int m = 0; m < 4; ++m) _Pragma("unroll") for (int k = 0; k < 2; ++k) dst[m][k] = *(const PG8_LAS bf16x8*)(lds + PG8_SA(b, h) + aoff + m * 2048 + k * 1024); } while (0)
#define PG8_LDB(dst, b, h) do { _Pragma("unroll") for (int n = 0; n < 2; ++n) _Pragma("unroll") for (int k = 0; k < 2; ++k) dst[n][k] = *(const PG8_LAS bf16x8*)(lds + PG8_SB(b, h) + boff + n * 2048 + k * 1024); } while (0)
#define PG8_MMA(ai, bj, At, Bt) do { __builtin_amdgcn_s_setprio(1); _Pragma("unroll") for (int m = 0; m < 4; ++m) _Pragma("unroll") for (int n = 0; n < 2; ++n) _Pragma("unroll") for (int k = 0; k < 2; ++k) \
        acc[ai][bj][m][n] = __builtin_amdgcn_mfma_f32_16x16x32_bf16(Bt[n][k], At[m][k], acc[ai][bj][m][n], 0, 0, 0); __builtin_amdgcn_s_setprio(0); } while (0)
#define PG8_WAIT_V(n) asm volatile("s_waitcnt vmcnt(" #n ")" ::: "memory")
#define PG8_WAIT_L(n) asm volatile("s_waitcnt lgkmcnt(" #n ")" ::: "memory")
#define PG8_BAR __builtin_amdgcn_s_barrier()
#define PG8_SCHED __builtin_amdgcn_sched_barrier(0)
    Unit cur, nxt; int ui = 0;
    if (!S.next(0, cur)) return;
    f32x4 acc[2][2][4][2];
#pragma unroll
    for (int a = 0; a < 2; ++a)
#pragma unroll
        for (int b = 0; b < 2; ++b)
#pragma unroll
            for (int m = 0; m < 4; ++m)
#pragma unroll
                for (int n = 0; n < 2; ++n) acc[a][b][m][n] = (f32x4){0.f, 0.f, 0.f, 0.f};
    bf16x8 At[4][2], B0[2][2], B1[2][2];
    const char* cA = (const char*)g.A + (size_t)cur.pm * tstepA; const char* cB = (const char*)g.Bt + (size_t)cur.pn * tstepB;
    S.a_ready(cur);
    if constexpr (SP2) {
        PG8_STAGE(PG8_SB(0, 0), cB, voffB); PG8_STAGE(PG8_SB(0, 1), cB + hstepB, voffB); PG8_STAGE(PG8_SA(0, 0), cA, voffA); PG8_STAGE(PG8_SA(0, 1), cA + hstepA, voffA);
        if (wr == 1) PG8_BAR;
        PG8_WAIT_V(2); PG8_BAR;
        PG8_STAGE(PG8_SB(1, 0), cB + kstep, voffB); PG8_STAGE(PG8_SA(1, 0), cA + kstep, voffA); PG8_STAGE(PG8_SB(1, 1), cB + hstepB + kstep, voffB);
        PG8_WAIT_V(6); PG8_BAR;
    } else {
        PG8_STAGE(PG8_SB(0, 0), cB, voffB); PG8_STAGE(PG8_SA(0, 0), cA, voffA); PG8_STAGE(PG8_SB(0, 1), cB + hstepB, voffB); PG8_STAGE(PG8_SA(0, 1), cA + hstepA, voffA);
        if (wr == 1) PG8_BAR;
        PG8_WAIT_V(4); PG8_BAR;
        PG8_STAGE(PG8_SB(1, 0), cB + kstep, voffB); PG8_STAGE(PG8_SA(1, 0), cA + kstep, voffA); PG8_STAGE(PG8_SB(1, 1), cB + hstepB + kstep, voffB);
        PG8_WAIT_V(6); PG8_BAR;
    }
    for (;;) {
        const bool has_next = S.next(ui + 1, nxt);
        const char* nA = has_next ? (const char*)g.A + (size_t)nxt.pm * tstepA : cA; const char* nB = has_next ? (const char*)g.Bt + (size_t)nxt.pn * tstepB : cB;
        for (int t = 0; t < nt; t += 2) {
            const bool last = (t == nt - 2);
            const char* a1 = cA + (size_t)(t + 1) * kstep;
            const char* a2 = last ? nA : cA + (size_t)(t + 2) * kstep; const char* b2 = last ? nB : cB + (size_t)(t + 2) * kstep;
            const char* a3 = a2 + kstep; const char* b3 = b2 + kstep;
            if (last && has_next) S.a_ready(nxt);
            if constexpr (SP2) {
            PG8_LDB(B0, 0, 0); PG8_LDB(B1, 0, 1); PG8_SCHED; PG8_LDA(At, 0, 0); PG8_STAGE(PG8_SA(1, 1), a1 + hstepA, voffA);
            PG8_WAIT_V(8); PG8_WAIT_L(0); PG8_BAR; PG8_MMA(0, 0, At, B0); PG8_MMA(0, 1, At, B1); PG8_BAR; PG8_SCHED;
            PG8_LDA(At, 0, 1); PG8_STAGE(PG8_SB(0, 0), b2, voffB); PG8_STAGE(PG8_SB(0, 1), b2 + hstepB, voffB); PG8_STAGE(PG8_SA(0, 0), a2, voffA);
            PG8_WAIT_V(8); PG8_WAIT_L(0); PG8_BAR; PG8_MMA(1, 0, At, B0); PG8_MMA(1, 1, At, B1); PG8_BAR; PG8_SCHED;
            PG8_LDB(B0, 1, 0); PG8_LDB(B1, 1, 1); PG8_SCHED; PG8_LDA(At, 1, 0); PG8_STAGE(PG8_SA(0, 1), a2 + hstepA, voffA);
            PG8_WAIT_V(8); PG8_WAIT_L(0); PG8_BAR; PG8_MMA(0, 0, At, B0); PG8_MMA(0, 1, At, B1); PG8_BAR; PG8_SCHED;
            PG8_LDA(At, 1, 1); PG8_STAGE(PG8_SB(1, 0), b3, voffB); PG8_STAGE(PG8_SB(1, 1), b3 + hstepB, voffB); PG8_STAGE(PG8_SA(1, 0), a3, voffA);
            PG8_WAIT_V(8); PG8_WAIT_L(0); PG8_BAR; PG8_MMA(1, 0, At, B0); PG8_MMA(1, 1, At, B1); PG8_BAR; PG8_SCHED;
            } else {
            PG8_LDB(B0, 0, 0); PG8_SCHED; PG8_LDA(At, 0, 0); PG8_STAGE(PG8_SA(1, 1), a1 + hstepA, voffA);
            PG8_WAIT_L(8); PG8_BAR; PG8_WAIT_L(0); PG8_MMA(0, 0, At, B0); PG8_BAR; PG8_SCHED;
            PG8_LDB(B1, 0, 1); PG8_STAGE(PG8_SB(0, 0), b2, voffB);
            PG8_BAR; PG8_WAIT_L(0); PG8_MMA(0, 1, At, B1); PG8_BAR;
            PG8_LDA(At, 0, 1); PG8_STAGE(PG8_SA(0, 0), a2, voffA);
            PG8_BAR; PG8_WAIT_L(0); PG8_MMA(1, 0, At, B0); PG8_BAR; PG8_SCHED;
            PG8_STAGE(PG8_SB(0, 1), b2 + hstepB, voffB);
            PG8_WAIT_V(6); PG8_BAR; PG8_MMA(1, 1, At, B1); PG8_BAR;
            PG8_LDB(B0, 1, 0); PG8_SCHED; PG8_LDA(At, 1, 0); PG8_STAGE(PG8_SA(0, 1), a2 + hstepA, voffA);
            PG8_WAIT_L(8); PG8_BAR; PG8_WAIT_L(0); PG8_MMA(0, 0, At, B0); PG8_BAR; PG8_SCHED;
            PG8_LDB(B1, 1, 1); PG8_STAGE(PG8_SB(1, 0), b3, voffB);
            PG8_BAR; PG8_WAIT_L(0); PG8_MMA(0, 1, At, B1); PG8_BAR;
            PG8_LDA(At, 1, 1); PG8_STAGE(PG8_SA(1, 0), a3, voffA);
            PG8_BAR; PG8_WAIT_L(0); PG8_MMA(1, 0, At, B0); PG8_BAR; PG8_SCHED;
            PG8_STAGE(PG8_SB(1, 1), b3 + hstepB, voffB);
            PG8_WAIT_V(6); PG8_BAR; PG8_MMA(1, 1, At, B1); PG8_BAR;
            }
        }
        if constexpr (ALIGN_EPI) { if (wr == 0) PG8_BAR; }
        if constexpr (!Epi::AFTER_DRAIN) { E(acc, cur, wr, wc, fr, fq); S.done(cur); }
        if (!has_next) break;
#pragma unroll
        for (int a = 0; a < 2; ++a)
#pragma unroll
            for (int b = 0; b < 2; ++b)
#pragma unroll
                for (int m = 0; m < 4; ++m)
#pragma unroll
                    for (int n = 0; n < 2; ++n) acc[a][b][m][n] = (f32x4){0.f, 0.f, 0.f, 0.f};
        cur = nxt; cA = nA; cB = nB; ++ui;
        if constexpr (ALIGN_EPI) { if (wr == 1) PG8_BAR; }
    }
    PG8_WAIT_V(0);
    if constexpr (!ALIGN_EPI) { if (wr == 0) PG8_BAR; }
    PG8_BAR;
    if constexpr (Epi::AFTER_DRAIN) { E.fused(acc, cur, wr, wc, fr, fq, lds, wid, lane); S.done(cur); }
#undef PG8_SA
#undef PG8_SB
#undef PG8_STAGE
#undef PG8_LDA
#undef PG8_LDB
#undef PG8_MMA
#undef PG8_WAIT_V
#undef PG8_WAIT_L
#undef PG8_BAR
#undef PG8_SCHED
}
}
#define XB_TMO      128
#define XB_XCNT(j)  (256  + 64 * (j))
#define XB_XSUB(j)  (1280 + 64 * (j))
#define XB_XGEN(j)  (2304 + 64 * (j))
#define XB_TOP      3328
#define XB_TOPGEN   3392
#define XCD_BAR_WORDS 3456
#define XB_SPIN_CAP (1u << 18)

__device__ __forceinline__ unsigned xb_ld(unsigned* p)              { return __hip_atomic_load(p, __ATOMIC_RELAXED, __HIP_MEMORY_SCOPE_AGENT); }
__device__ __forceinline__ unsigned xb_add(unsigned* p, unsigned v) { return __hip_atomic_fetch_add(p, v, __ATOMIC_RELAXED, __HIP_MEMORY_SCOPE_AGENT); }
__device__ __forceinline__ unsigned xb_xcc_id() { return (unsigned)__builtin_amdgcn_s_getreg((3 << 11) | 20) & 0xFu; }
#define XB_SPIN(cond, bar) do { unsigned _sp = 0; while (cond) { __builtin_amdgcn_s_sleep(1); \
    if ((++_sp & 255u) == 0u) { if (xb_ld(&(bar)[XB_TMO])) break; if (_sp > XB_SPIN_CAP) { atomicAdd(&(bar)[XB_TMO], 1u); break; } } } } while (0)

struct XcdBarrier {
    unsigned* bar; unsigned x;
    volatile LAS unsigned* st;
};

__device__ __forceinline__ XcdBarrier xcd_barrier_post(unsigned* bar, volatile LAS unsigned* st) {
    XcdBarrier b; b.bar = bar; b.x = xb_xcc_id(); b.st = st;
    if (threadIdx.x == 0) (void)xb_add(&bar[XB_XCNT(b.x)], 1u);
    return b;
}
__device__ __forceinline__ void xcd_barrier_complete(unsigned* bar, unsigned x, unsigned& nloc, unsigned& nx) {
    const unsigned G = gridDim.x * gridDim.y * gridDim.z;
    unsigned sum, cnt, mine, sp = 0u;
    for (;;) {
        sum = 0u; cnt = 0u; mine = 0u;
#pragma unroll
        for (unsigned j = 0; j < 16; ++j) { const unsigned c = xb_ld(&bar[XB_XCNT(j)]); sum += c; cnt += (c > 0u) ? 1u : 0u; mine = (j == x) ? c : mine; }
        if (sum == G) break;
        __builtin_amdgcn_s_sleep(1);
        if ((++sp & 255u) == 0u) { if (xb_ld(&bar[XB_TMO])) break; if (sp > XB_SPIN_CAP) { atomicAdd(&bar[XB_TMO], 1u); break; } }
    }
    nloc = mine > 0u ? mine : 1u; nx = cnt > 0u ? cnt : 1u;
}

__device__ __forceinline__ void xcd_barrier(const XcdBarrier& b) {
    asm volatile("s_waitcnt vmcnt(0)" ::: "memory");
    __syncthreads();
    if (threadIdx.x == 0) {
        unsigned* bar = b.bar;
        __builtin_amdgcn_s_waitcnt(0);
        unsigned nloc = b.st[0], nx = b.st[1];
        if (nloc == 0u) { xcd_barrier_complete(bar, b.x, nloc, nx); b.st[0] = nloc; b.st[1] = nx; }
        const unsigned old = xb_add(&bar[XB_XSUB(b.x)], 1u);
        const unsigned gen = old / nloc;
        if (old + 1u == (gen + 1u) * nloc) {
            __builtin_amdgcn_fence(__ATOMIC_RELEASE, "agent");
            asm volatile("s_waitcnt vmcnt(0)" ::: "memory");
            const unsigned og = xb_add(&bar[XB_TOP], 1u);
            const unsigned tg = og / nx;
            if (og + 1u == (tg + 1u) * nx) xb_add(&bar[XB_TOPGEN], 1u);
            else XB_SPIN(xb_ld(&bar[XB_TOPGEN]) == tg, bar);
            __builtin_amdgcn_fence(__ATOMIC_ACQUIRE, "agent");
            xb_add(&bar[XB_XGEN(b.x)], 1u);
            asm volatile("s_waitcnt vmcnt(0)" ::: "memory");
        } else {
            XB_SPIN(xb_ld(&bar[XB_XGEN(b.x)]) == gen, bar);
            __builtin_amdgcn_fence(__ATOMIC_ACQUIRE, "agent");
            asm volatile("s_waitcnt vmcnt(0)" ::: "memory");
        }
    }
    __syncthreads();
}

typedef unsigned short bf16;
typedef GAS unsigned gu32;
constexpr int D_MODEL = 1024, SEQ = 2048, D_INNER = 2048, MTOK = 16384, NWAVES = 8;
constexpr float QK_SCALE = 0.08838834764831845f;
constexpr size_t MiB = 1u << 20;
constexpr size_t WS_CTL = 0, CTL_ZERO_BYTES = 64 * 1024, WS_TAB = 1 * MiB, WS_SSQ = 3 * MiB, WS_MASK = 5 * MiB, WS_WIN = 10 * MiB, WS_WOUT = 26 * MiB, WS_U = 30 * MiB, WS_P = 62 * MiB, WS_END = 254 * MiB;
constexpr int CW_BAR = 1024;
constexpr int RING_BYTES = 131072, MISC_OFF = RING_BYTES + 320, LDS_BYTES = 147456;
__host__ __device__ constexpr int n1pad(int L) { return L == 0 ? 3584 : (L == 1 ? 6144 : (L == 2 ? 4096 : 6144)); }
__host__ __device__ constexpr int n1real(int L) { return L == 0 ? 3408 : (L == 1 ? 6144 : (L == 2 ? 4096 : 6144)); }
__host__ __device__ constexpr int nsrc(int L) { return L == 0 ? 5456 : (L == 1 ? 8192 : (L == 2 ? 6144 : 8192)); }
__host__ __device__ constexpr int ocol(int L) { return L == 0 ? 0 : (L == 1 ? 0 : (L == 2 ? 2048 : 4096)); }
constexpr int A_K = 2048, A_V = 2176, A_IQ = 2304, A_IK = 3328, A_IW = 3392;

__device__ __forceinline__ float bf2f(bf16 v) { return __uint_as_float(((unsigned)v) << 16); }
__device__ __forceinline__ bf16 f2bf(float f) { unsigned u = __float_as_uint(f); return (bf16)((u + 0x7fffu + ((u >> 16) & 1u)) >> 16); }
__device__ __forceinline__ unsigned pk2(float lo, float hi) { return (unsigned)f2bf(lo) | ((unsigned)f2bf(hi) << 16); }
template <int M> __device__ __forceinline__ float swz_xor(float v) { return __int_as_float(__builtin_amdgcn_ds_swizzle(__float_as_int(v), (M << 10) | 0x1f)); }
template <int M> __device__ __forceinline__ int swz_xor_i(int v) { return __builtin_amdgcn_ds_swizzle(v, (M << 10) | 0x1f); }
__device__ __forceinline__ float wave_sum(float v) {
    v += swz_xor<1>(v); v += swz_xor<2>(v); v += swz_xor<4>(v); v += swz_xor<8>(v); v += swz_xor<16>(v);
    const auto rr = __builtin_amdgcn_permlane32_swap(__float_as_uint(v), __float_as_uint(v), false, false);
    return __uint_as_float(rr[0]) + __uint_as_float(rr[1]);
}
__device__ __forceinline__ float wave_max(float v) {
    v = fmaxf(v, swz_xor<1>(v)); v = fmaxf(v, swz_xor<2>(v)); v = fmaxf(v, swz_xor<4>(v)); v = fmaxf(v, swz_xor<8>(v)); v = fmaxf(v, swz_xor<16>(v));
    const auto rr = __builtin_amdgcn_permlane32_swap(__float_as_uint(v), __float_as_uint(v), false, false);
    return fmaxf(__uint_as_float(rr[0]), __uint_as_float(rr[1]));
}
__device__ __forceinline__ float silu_f(float z) { return z * __builtin_amdgcn_rcpf(1.f + __expf(-z)); }
__device__ __forceinline__ float sigmoid_f(float z) { return __builtin_amdgcn_rcpf(1.f + __expf(-z)); }
#define LDS_WAIT() asm volatile("s_waitcnt lgkmcnt(0)" ::: "memory")
#define PHASE_IDS() int tid_o_ = threadIdx.x; asm volatile("" : "+v"(tid_o_)); const int tid = tid_o_, lane = tid & 63, wave = __builtin_amdgcn_readfirstlane(tid >> 6); (void)lane; (void)wave

struct Frame {
    LAS unsigned char* lds; unsigned char* lds_gen; volatile LAS unsigned* MISC; unsigned* ctl;
    int G;
    const float* x; const float* norm_g; const float* final_g; const float* w_in[4]; const float* w_out[4]; const float* lb_logits;
    float* H;
    float *cos128, *sin128, *cos64, *sin64, *lb, *ssq; unsigned* mask;
    bf16 *WIN, *WOUT, *U, *P;
};

template <int L> __device__ __forceinline__ int proj_mode(int g32) {
    if (L == 0) return g32 < 68 ? 1 : (g32 < 72 ? 0 : (g32 < 106 ? 2 : 0));
    if (L == 1) return g32 < 128 ? 1 : 0;
    if (L == 2) return g32 < 32 ? 1 : (g32 < 64 ? 3 : 0);
    return 0;
}
template <int L> struct EpiProj {
    static constexpr bool PERM = true, AFTER_DRAIN = false;
    bf16* P; int ldp; const float *c128, *s128, *c64, *s64;
    __device__ __forceinline__ void operator()(const pg8::f32x4 (&acc)[2][2][4][2], const pg8::Unit& u, int wr, int wc, int fr, int fq) const {
        const int row0 = u.pm * 256 + wr * 64 + fr, colb = u.pn * 256 + wc * 32 + 8 * fq;
#pragma unroll
        for (int bj = 0; bj < 2; ++bj) {
            const int col = colb + bj * 128; const int mode = proj_mode<L>(__builtin_amdgcn_readfirstlane(col >> 5));
#pragma unroll
            for (int ai = 0; ai < 2; ++ai)
#pragma unroll
                for (int m = 0; m < 4; ++m) {
                    const int row = row0 + ai * 128 + m * 16, pos = row & (SEQ - 1);
                    pg8::f32x4 v0 = acc[ai][bj][m][0], v1 = acc[ai][bj][m][1];
                    if (mode == 1 || mode == 3) { const int i0 = ((col & 127) >> 3) * 4;
                        const pg8::f32x4 c = *(const pg8::f32x4*)(c128 + pos * 64 + i0), s = *(const pg8::f32x4*)(s128 + pos * 64 + i0);
                        const pg8::f32x4 o1 = v0 * c - v1 * s, o2 = v0 * s + v1 * c; v0 = o1; v1 = o2;
                        if (mode == 3) { v0 = v0 * QK_SCALE; v1 = v1 * QK_SCALE; } }
                    else if (mode == 2) { const int i0 = ((col & 63) >> 3) * 4;
                        const pg8::f32x4 c = *(const pg8::f32x4*)(c64 + pos * 32 + i0), s = *(const pg8::f32x4*)(s64 + pos * 32 + i0);
                        const pg8::f32x4 o1 = v0 * c - v1 * s, o2 = v0 * s + v1 * c; v0 = o1; v1 = o2; }
                    pg8::u32x4 w; w.x = pg8::cvt_pk_bf16(v0[0], v0[1]); w.y = pg8::cvt_pk_bf16(v0[2], v0[3]); w.z = pg8::cvt_pk_bf16(v1[0], v1[1]); w.w = pg8::cvt_pk_bf16(v1[2], v1[3]);
                    *(pg8::u32x4*)(P + (size_t)row * ldp + col) = w;
                }
        }
    }
};
template <int L> struct EpiGate {
    static constexpr bool PERM = true, AFTER_DRAIN = false;
    bf16* O; int ldo; const float* ssq;
    __device__ __forceinline__ void operator()(const pg8::f32x4 (&acc)[2][2][4][2], const pg8::Unit& u, int wr, int wc, int fr, int fq) const {
        const int row0 = u.pm * 256 + wr * 64 + fr, colb = u.pn * 256 + wc * 32 + 8 * fq;
#pragma unroll
        for (int ai = 0; ai < 2; ++ai)
#pragma unroll
            for (int m = 0; m < 4; ++m) {
                const int row = row0 + ai * 128 + m * 16;
#pragma unroll
                for (int bj = 0; bj < 2; ++bj) {
                    const int col = colb + bj * 128; float rs = 1.f;
                    if (L == 2) { const pg8::f32x4 q = *(const pg8::f32x4*)(ssq + ((size_t)row * 8 + (col >> 8)) * 4); rs = rsqrtf(((q[0] + q[1]) + (q[2] + q[3])) * (1.f / 256.f) + 1e-6f); }
                    if (L == 3) { const float2 q = *(const float2*)(ssq + ((size_t)row * 16 + (col >> 7)) * 2); rs = rsqrtf((q.x + q.y) * (1.f / 128.f) + 1e-6f); }
                    bf16* p = O + (size_t)row * ldo + col; const pg8::u32x4 r = *(const pg8::u32x4*)p;
                    const pg8::f32x4 z0 = acc[ai][bj][m][0], z1 = acc[ai][bj][m][1];
                    float o[8]; o[0] = __uint_as_float(r.x << 16); o[1] = __uint_as_float(r.x & 0xffff0000u); o[2] = __uint_as_float(r.y << 16); o[3] = __uint_as_float(r.y & 0xffff0000u);
                    o[4] = __uint_as_float(r.z << 16); o[5] = __uint_as_float(r.z & 0xffff0000u); o[6] = __uint_as_float(r.w << 16); o[7] = __uint_as_float(r.w & 0xffff0000u);
#pragma unroll
                    for (int j = 0; j < 4; ++j) { o[j] = o[j] * rs * silu_f(z0[j]); o[4 + j] = o[4 + j] * rs * silu_f(z1[j]); }
                    pg8::u32x4 w; w.x = pg8::cvt_pk_bf16(o[0], o[1]); w.y = pg8::cvt_pk_bf16(o[2], o[3]); w.z = pg8::cvt_pk_bf16(o[4], o[5]); w.w = pg8::cvt_pk_bf16(o[6], o[7]);
                    *(pg8::u32x4*)p = w;
                }
            }
    }
};
struct EpiAddF32 {
    static constexpr bool PERM = false, AFTER_DRAIN = false;
    float* C; int ldc;
    __device__ __forceinline__ void operator()(const pg8::f32x4 (&acc)[2][2][4][2], const pg8::Unit& u, int wr, int wc, int fr, int fq) const {
        const int row0 = u.pm * 256 + wr * 64 + fr, col0 = u.pn * 256 + wc * 32 + 4 * fq;
#pragma unroll
        for (int ai = 0; ai < 2; ++ai)
#pragma unroll
            for (int m = 0; m < 4; ++m) { float* rowp = C + (size_t)(row0 + ai * 128 + m * 16) * ldc + col0;
#pragma unroll
                for (int bj = 0; bj < 2; ++bj)
#pragma unroll
                    for (int n = 0; n < 2; ++n) { pg8::f32x4* p = (pg8::f32x4*)(rowp + bj * 128 + n * 16); *p = *p + acc[ai][bj][m][n]; } }
    }
};

template <int L> __device__ __forceinline__ int srccol(int n) {
    if (n >= n1pad(L)) return n1real(L) + (n - n1pad(L));
    if (n >= n1real(L)) return -1;
    const int mode = proj_mode<L>(n >> 5);
    if (mode == 1 || mode == 3) { const int w = n & 127; return (n & ~127) + 64 * ((w >> 2) & 1) + 4 * (w >> 3) + (w & 3); }
    if (mode == 2) { const int r = n - A_IQ, w = r & 63; return A_IQ + (r & ~63) + 32 * ((w >> 2) & 1) + 4 * (w >> 3) + (w & 3); }
    return n;
}
template <int L  > __device__ __forceinline__ void conv_item(const float* W, int Nsrc, bf16* WT, int Kdim, int nblk, int item, LAS float* scr, int lane) {
    const int kb = item / nblk, nb = item % nblk, k0 = 64 * kb, n0 = 32 * nb;
    int src = n0 + (lane & 31); if (L >= 0) src = srccol<(L < 0 ? 0 : L)>(src);
#pragma unroll 8
    for (int i = 0; i < 32; ++i) { const int kk = 2 * i + (lane >> 5); scr[kk * 33 + (lane & 31)] = (src >= 0) ? W[(size_t)(k0 + kk) * Nsrc + src] : 0.f; }
    LDS_WAIT();
    const int c = lane & 7;
#pragma unroll
    for (int j = 0; j < 4; ++j) { const int n = (lane >> 3) + 8 * j; const LAS float* s = scr + (8 * c) * 33 + n;
        pg8::u32x4 o; o.x = pk2(s[0 * 33], s[1 * 33]); o.y = pk2(s[2 * 33], s[3 * 33]); o.z = pk2(s[4 * 33], s[5 * 33]); o.w = pk2(s[6 * 33], s[7 * 33]);
        *(pg8::u32x4*)(WT + (size_t)(n0 + n) * Kdim + k0 + 8 * c) = o; }
    LDS_WAIT();
}
template <int L> __device__ __forceinline__ void conv_weights(Frame& F) {
    PHASE_IDS();
    LAS float* scr = (LAS float*)(F.lds + wave * 16384);
    const int gw = blockIdx.x * NWAVES + wave, NGW = F.G * NWAVES;
    constexpr int NB_IN = (n1pad(L) + 2048) / 32, I_IN = NB_IN * (1024 / 64), NB_OUT = 1024 / 32, I_OUT = NB_OUT * (2048 / 64);
    for (int it = gw; it < I_IN + I_OUT; it += NGW) {
        if (it < I_IN) conv_item<L>(F.w_in[L], nsrc(L), F.WIN, 1024, NB_IN, it, scr, lane);
        else conv_item<-1>(F.w_out[L], 1024, F.WOUT, 2048, NB_OUT, it - I_IN, scr, lane);
    }
}
__device__ __forceinline__ void norm_rows(Frame& F, const float* src, const float* g, float* copy_to) {
    PHASE_IDS();
    const int gw = blockIdx.x * NWAVES + wave, NGW = F.G * NWAVES;
    for (int row = gw; row < MTOK; row += NGW) {
        const float4* xr = (const float4*)(src + (size_t)row * D_MODEL) + lane;
        float4 v[4]; float s = 0.f;
#pragma unroll
        for (int j = 0; j < 4; ++j) { v[j] = xr[64 * j]; s += v[j].x * v[j].x + v[j].y * v[j].y + v[j].z * v[j].z + v[j].w * v[j].w; }
        const float r = rsqrtf(wave_sum(s) * (1.f / D_MODEL) + 1e-6f);
#pragma unroll
        for (int j = 0; j < 4; ++j) {
            const float4 gg = ((const float4*)g)[lane + 64 * j];
            if (copy_to) ((float4*)(copy_to + (size_t)row * D_MODEL))[lane + 64 * j] = v[j];
            uint2 o; o.x = pk2(v[j].x * r * gg.x, v[j].y * r * gg.y); o.y = pk2(v[j].z * r * gg.z, v[j].w * r * gg.w);
            *(uint2*)(F.U + (size_t)row * D_MODEL + (lane + 64 * j) * 4) = o;
        }
    }
}
__device__ __forceinline__ void final_rows(Frame& F) {
    PHASE_IDS();
    const int gw = blockIdx.x * NWAVES + wave, NGW = F.G * NWAVES;
    for (int row = gw; row < MTOK; row += NGW) {
        float4* xr = (float4*)(F.H + (size_t)row * D_MODEL) + lane;
        float4 v[4]; float s = 0.f;
#pragma unroll
        for (int j = 0; j < 4; ++j) { v[j] = xr[64 * j]; s += v[j].x * v[j].x + v[j].y * v[j].y + v[j].z * v[j].z + v[j].w * v[j].w; }
        const float r = rsqrtf(wave_sum(s) * (1.f / D_MODEL) + 1e-6f);
#pragma unroll
        for (int j = 0; j < 4; ++j) { const float4 gg = ((const float4*)F.final_g)[lane + 64 * j]; xr[64 * j] = make_float4(v[j].x * r * gg.x, v[j].y * r * gg.y, v[j].z * r * gg.z, v[j].w * r * gg.w); }
    }
}
__device__ __forceinline__ void make_tables(Frame& F) {
    PHASE_IDS();
    const int gt = blockIdx.x * 512 + tid, NT = F.G * 512;
    for (int i = gt; i < 2048 * 64; i += NT) {
        { const int pos = i >> 6, f = i & 63; const float freq = exp2f(-((float)(2 * f) / 128.f) * 13.287712379549449f);
          double rev = (double)pos * (double)freq * 0.15915494309189535; rev -= floor(rev);
          F.cos128[i] = __builtin_amdgcn_cosf((float)rev); F.sin128[i] = __builtin_amdgcn_sinf((float)rev); }
        if (i < 2048 * 32) { const int pos = i >> 5, f = i & 31; const float freq = exp2f(-((float)(2 * f) / 64.f) * 13.287712379549449f);
          double rev = (double)pos * (double)freq * 0.15915494309189535; rev -= floor(rev);
          F.cos64[i] = __builtin_amdgcn_cosf((float)rev); F.sin64[i] = __builtin_amdgcn_sinf((float)rev); }
        if (i < 2048) { const float l0 = F.lb_logits[i], l1 = F.lb_logits[2048 + i], l2 = F.lb_logits[4096 + i], l3 = F.lb_logits[6144 + i];
          const float m = fmaxf(fmaxf(l0, l1), fmaxf(l2, l3)); const float e0 = __expf(l0 - m), e1 = __expf(l1 - m), e2 = __expf(l2 - m), e3 = __expf(l3 - m);
          F.lb[i] = (e1 + e2 + e3) / (e0 + e1 + e2 + e3); }
    }
}
namespace att {
constexpr int D = 128;
constexpr float THR = 8.f;
constexpr bool WSKIP = false;
constexpr float SCALE = 0.08838834764831845f;
constexpr int NW = 8, QBLK = 32, KVBLK = 64, QB = NW * QBLK;
constexpr int SHM_V = KVBLK * D * 2, SHM_K = KVBLK * D * 2;
constexpr int LDS_BYTES = 2 * SHM_V + 2 * SHM_K + NW * 64 * 4;
typedef short bf16x8 __attribute__((ext_vector_type(8)));
typedef short s16x4 __attribute__((ext_vector_type(4)));
typedef float f32x16 __attribute__((ext_vector_type(16)));
typedef float f32x4 __attribute__((ext_vector_type(4)));
typedef unsigned u32x4 __attribute__((ext_vector_type(4)));
template <class A, class Bt> struct same_t { static constexpr bool v = false; };
template <class A> struct same_t<A, A> { static constexpr bool v = true; };
#define KSWZ(row, colB) ((row) * 256 + ((colB) ^ (((row) & 7) << 4)))
#define SBAR() __builtin_amdgcn_sched_barrier(0)
__device__ __forceinline__ int v_st(int k, int c) { const int kk = (k & ~0xC) | ((k & 4) << 1) | ((k & 8) >> 1); return ((kk >> 3) * 4 + (c >> 5)) * 512 + ((kk & 7) * 32 + (c & 31)) * 2; }
__device__ __forceinline__ int v_rd_base(int lane) { return ((lane & 3) << 3) | (((lane >> 2) & 3) << 6) | (((lane >> 4) & 1) << 5) | (((lane >> 5) & 1) << 8); }
constexpr int v_rd_off(int d0, int ks, int half) { return d0 * 512 + ks * 4096 + half * 2048; }
__device__ __forceinline__ int crow(int r, int hi) { return (r & 3) + 8 * (r >> 2) + 4 * hi; }
__device__ __forceinline__ unsigned cvtpk(float lo, float hi) {
    unsigned r; asm volatile("v_cvt_pk_bf16_f32 %0, %1, %2" : "=v"(r) : "v"(lo), "v"(hi)); return r;
}
__device__ __forceinline__ bf16x8 pack8(f32x4 a, f32x4 b) {
    u32x4 w = {cvtpk(a[0], a[1]), cvtpk(a[2], a[3]), cvtpk(b[0], b[1]), cvtpk(b[2], b[3])};
    return *reinterpret_cast<bf16x8*>(&w);
}
template <class T> __device__ __forceinline__ bf16x8 load8(const T* p) {
    if constexpr (same_t<T, float>::v) { return pack8(*(const f32x4*)p, *(const f32x4*)(p + 4)); }
    else { return *reinterpret_cast<const bf16x8*>(p); }
}
__device__ __forceinline__ void mask_bits(f32x16& p0, f32x16& p1, unsigned w0, unsigned w1) {
    const float NEG = -__builtin_inff();
#pragma unroll
    for (int r = 0; r < 16; ++r) { const int c = (r & 3) + 8 * (r >> 2); if (!((w0 >> c) & 1u)) p0[r] = NEG; if (!((w1 >> c) & 1u)) p1[r] = NEG; }
}
__device__ __forceinline__ float wmult(float s, int d) {
    const unsigned ud = (unsigned)d; const int cnt = (ud <= 128u ? 1 : 0) + ((((d & 3) == 0) && ud <= 512u) ? 1 : 0) + ((((d & 15) == 0) && d >= 0) ? 1 : 0);
    const float add = cnt >= 3 ? 12.4293792f : (cnt == 2 ? 7.84206515f : 0.f);
    return cnt == 0 ? -__builtin_inff() : s + add;
}
__device__ __forceinline__ void mask_mult(f32x16& p0, f32x16& p1, int dq) {
#pragma unroll
    for (int r = 0; r < 16; ++r) { const int c = (r & 3) + 8 * (r >> 2); p0[r] = wmult(p0[r], dq - c); p1[r] = wmult(p1[r], dq - c - 32); }
}
__device__ __forceinline__ void mask_far(f32x16& p0, f32x16& p1, int dq) {
    const float NEG = -__builtin_inff(); const int dm = dq & 15;
#pragma unroll
    for (int r = 0; r < 16; ++r) { const int c = ((r & 3) + 8 * (r >> 2)) & 15; if (dm != c) { p0[r] = NEG; p1[r] = NEG; } }
}
__device__ __forceinline__ void partialSM(f32x16& p0, f32x16& p1, float& m_reg, float& mn, float& alpha) {
    float pmax = p0[0]; for (int r = 1; r < 16; ++r) pmax = fmaxf(pmax, p0[r]); for (int r = 0; r < 16; ++r) pmax = fmaxf(pmax, p1[r]);
    { auto rr = __builtin_amdgcn_permlane32_swap(__float_as_uint(pmax), __float_as_uint(pmax), false, false);
      pmax = fmaxf(__uint_as_float(rr[0]), __uint_as_float(rr[1])); }
    constexpr float C2 = 1.4426950408889634f * SCALE;
    if (__builtin_expect(__all((pmax - m_reg) * SCALE <= THR), 1)) { mn = m_reg; alpha = 1.f; }
    else { mn = fmaxf(m_reg, pmax); alpha = __builtin_amdgcn_exp2f((m_reg - mn) * C2); m_reg = mn; }
    const float mnL = -mn * C2;
    for (int r = 0; r < 16; ++r) p0[r] = fmaf(p0[r], C2, mnL); for (int r = 0; r < 16; ++r) p1[r] = fmaf(p1[r], C2, mnL);
    for (int r = 0; r < 16; ++r) p0[r] = __builtin_amdgcn_exp2f(p0[r]);
}
__device__ __forceinline__ void finishSM(f32x16& p0, f32x16& p1, float alpha, float& l_reg, bf16x8& pa0, bf16x8& pa1, bf16x8& pa2, bf16x8& pa3) {
    for (int r = 0; r < 16; ++r) p1[r] = __builtin_amdgcn_exp2f(p1[r]);
    float ps = 0; for (int r = 0; r < 16; ++r) ps += p0[r]; for (int r = 0; r < 16; ++r) ps += p1[r];
    { auto rr = __builtin_amdgcn_permlane32_swap(__float_as_uint(ps), __float_as_uint(ps), false, false);
      ps = __uint_as_float(rr[0]) + __uint_as_float(rr[1]); }
    l_reg = l_reg * alpha + ps;
#define PK4(P, B_, OUT) do { unsigned a0 = cvtpk(P[B_+0], P[B_+1]), a1 = cvtpk(P[B_+2], P[B_+3]);                          \
        unsigned b0 = cvtpk(P[B_+4], P[B_+5]), b1 = cvtpk(P[B_+6], P[B_+7]);                                             \
        auto r0 = __builtin_amdgcn_permlane32_swap(a0, b0, false, false); auto r1 = __builtin_amdgcn_permlane32_swap(a1, b1, false, false); \
        u32x4 w = {r0[0], r1[0], r0[1], r1[1]}; OUT = *reinterpret_cast<bf16x8*>(&w); } while (0)
    PK4(p0, 0, pa0); PK4(p0, 8, pa1); PK4(p1, 0, pa2); PK4(p1, 8, pa3);
#undef PK4
}
template <int KB, bool SK>
__device__ __forceinline__ void qkt(f32x16& p0, f32x16& p1, const char* K_lds, int r32, int hi, const bf16x8* qr, bool act) {
    if (SK && !act) { const float NEG = -__builtin_inff();
#pragma unroll
        for (int r = 0; r < 16; ++r) { p0[r] = NEG; p1[r] = NEG; } return; }
    p0 = f32x16{}; p1 = f32x16{};
    const char* kb[4];
#pragma unroll
    for (int dd = 0; dd < 4; ++dd) kb[dd] = K_lds + KB * SHM_K + KSWZ(r32, (dd * 16 + hi * 8) * 2);
#pragma unroll
    for (int d0 = 0; d0 < 8; ++d0) { const char* a = kb[d0 & 3] + (d0 >> 2) * 128;
        bf16x8 b0 = *reinterpret_cast<const bf16x8*>(a);
        bf16x8 b1 = *reinterpret_cast<const bf16x8*>(a + 32 * 256);
        p0 = __builtin_amdgcn_mfma_f32_32x32x16_bf16(b0, qr[d0], p0, 0, 0, 0);
        p1 = __builtin_amdgcn_mfma_f32_32x32x16_bf16(b1, qr[d0], p1, 0, 0, 0); }
}
template <int VB, bool SK>
__device__ __forceinline__ void pv_tile(f32x16* o, int vb0, bf16x8 pa0, bf16x8 pa1, bf16x8 pa2, bf16x8 pa3, bool act) {
    if (SK && !act) return;
#define TRRD(dst, off) asm volatile("ds_read_b64_tr_b16 %0, %1 offset:%2" : "=&v"(dst) : "v"(vb0), "i"(off) : "memory")
#define PV_D0(d0) do { s16x4 l0, l1, l2, l3, h0, h1, h2, h3; constexpr int b_ = VB * SHM_V + v_rd_off(d0, 0, 0);     \
        TRRD(l0, b_); TRRD(h0, b_ + 2048); TRRD(l1, b_ + 4096); TRRD(h1, b_ + 6144); TRRD(l2, b_ + 8192); TRRD(h2, b_ + 10240); TRRD(l3, b_ + 12288); TRRD(h3, b_ + 14336); \
        asm volatile("s_waitcnt lgkmcnt(0)" ::: "memory"); SBAR();                 \
        o[d0] = __builtin_amdgcn_mfma_f32_32x32x16_bf16(pa0, (bf16x8){l0[0], l0[1], l0[2], l0[3], h0[0], h0[1], h0[2], h0[3]}, o[d0], 0, 0, 0);   \
        o[d0] = __builtin_amdgcn_mfma_f32_32x32x16_bf16(pa1, (bf16x8){l1[0], l1[1], l1[2], l1[3], h1[0], h1[1], h1[2], h1[3]}, o[d0], 0, 0, 0);   \
        o[d0] = __builtin_amdgcn_mfma_f32_32x32x16_bf16(pa2, (bf16x8){l2[0], l2[1], l2[2], l2[3], h2[0], h2[1], h2[2], h2[3]}, o[d0], 0, 0, 0);   \
        o[d0] = __builtin_amdgcn_mfma_f32_32x32x16_bf16(pa3, (bf16x8){l3[0], l3[1], l3[2], l3[3], h3[0], h3[1], h3[2], h3[3]}, o[d0], 0, 0, 0); } while (0)
    PV_D0(0); PV_D0(1); PV_D0(2); PV_D0(3);
#undef PV_D0
#undef TRRD
}
template <class TIn, class TOut> struct BlockRef { const TIn* Q; const TIn* K; const TIn* V; TOut* O; const unsigned* M; int P0; };
template <class TIn> struct Seam {
    bf16x8 qr[8];
    bf16x8 st_v0, st_v1, st_k0, st_k1; f32x4 sf0, sf1, sf2, sf3;
    f32x4 tq[16];
};
__device__ __forceinline__ int swa_jlo(int P0, int W) { const int lowk = P0 - W + 1; return lowk > 0 ? lowk / KVBLK : 0; }
#define ROW(p, k0, rr) ((p) + (size_t)((k0) + (rr)) * RSK + sc)
#define VMW() asm volatile("s_waitcnt vmcnt(0)" ::: "memory")
#define VMWN(n) asm volatile("s_waitcnt vmcnt(%0)" :: "i"(n) : "memory")
#define SLOAD_H(Kp, Vp, k0) do { S.st_v0 = load8<TIn>(ROW(Vp, k0, sr)); S.st_v1 = load8<TIn>(ROW(Vp, k0, 32 + sr));              \
                         S.st_k0 = load8<TIn>(ROW(Kp, k0, sr)); S.st_k1 = load8<TIn>(ROW(Kp, k0, 32 + sr)); } while (0)
#define SWRITE_HK(bf) do { *(bf16x8*)(K_lds + (bf) * SHM_K + kws) = S.st_k0; *(bf16x8*)(K_lds + (bf) * SHM_K + kws + 32 * 256) = S.st_k1; } while (0)
#define SWRITE_HV(bf) do { *(bf16x8*)(V_lds + (bf) * SHM_V + vst0) = S.st_v0; *(bf16x8*)(V_lds + (bf) * SHM_V + vst1) = S.st_v1; } while (0)
#define SWRITE_H(bf) do { SWRITE_HV(bf); SWRITE_HK(bf); } while (0)
#define SLOAD_F(p, k0) do { S.sf0 = *(const f32x4*)ROW(p, k0, sr); S.sf1 = *(const f32x4*)(ROW(p, k0, sr) + 4);                \
                            S.sf2 = *(const f32x4*)ROW(p, k0, 32 + sr); S.sf3 = *(const f32x4*)(ROW(p, k0, 32 + sr) + 4); } while (0)
#define SWRITE_KF(bf) do { *(bf16x8*)(K_lds + (bf) * SHM_K + kws) = pack8(S.sf0, S.sf1); *(bf16x8*)(K_lds + (bf) * SHM_K + kws + 32 * 256) = pack8(S.sf2, S.sf3); } while (0)
#define SWRITE_VF(bf) do { *(bf16x8*)(V_lds + (bf) * SHM_V + vst0) = pack8(S.sf0, S.sf1); *(bf16x8*)(V_lds + (bf) * SHM_V + vst1) = pack8(S.sf2, S.sf3); } while (0)
template <class TIn, class TOut, int RSQ, int RSK, int MK>
__device__ __forceinline__ void causal_swa_prime(const BlockRef<TIn, TOut>& cur, int W, char* lds, Seam<TIn>& S) {
    constexpr bool F32 = same_t<TIn, float>::v;
    int tid_o = threadIdx.x; asm volatile("" : "+v"(tid_o)); const int tid = tid_o, wid = __builtin_amdgcn_readfirstlane(tid >> 6), lane = tid & 63, r32 = lane & 31, hi = lane >> 5;
    const int sr = tid >> 4, sc = (tid & 15) * 8, kws = KSWZ(sr, sc * 2); char* K_lds = lds + 2 * SHM_V;
    const int kb0 = swa_jlo(cur.P0, W) * KVBLK;
    for (int d0 = 0; d0 < 8; ++d0) S.qr[d0] = load8<TIn>(cur.Q + (size_t)(wid * QBLK + r32) * RSQ + d0 * 16 + hi * 8);
    if constexpr (F32) { SLOAD_F((const float*)cur.K, kb0); VMW(); SWRITE_KF(0); SBAR(); SLOAD_F((const float*)cur.V, kb0); }
    else { SLOAD_H(cur.K, cur.V, kb0); VMW(); SWRITE_HK(0); }
    __syncthreads();
}
template <class TIn, class TOut, int RSQ, int RSK, int MK>
__device__ __forceinline__ void causal_swa_block(const BlockRef<TIn, TOut>& cur, const BlockRef<TIn, TOut>& nxt, int skv, int W, char* lds, Seam<TIn>& S) {
    constexpr bool F32 = same_t<TIn, float>::v;
    int tid_o = threadIdx.x; asm volatile("" : "+v"(tid_o)); const int tid = tid_o, wid = __builtin_amdgcn_readfirstlane(tid >> 6), lane = tid & 63, r32 = lane & 31, hi = lane >> 5;
    const int j_lo = swa_jlo(cur.P0, W);
    int j_hi = (cur.P0 + QB - 1) / KVBLK + 1; if (j_hi > skv / KVBLK) j_hi = skv / KVBLK;
    const int NT = j_hi - j_lo;
    const int kbn = swa_jlo(nxt.P0, W) * KVBLK;
    const int qlo = cur.P0 + wid * QBLK, qm = qlo + r32 - 4 * hi;
    const unsigned* mrow = (MK == 0) ? cur.M + (size_t)(wid * QBLK + r32) * 64 : nullptr; uint2 mw = make_uint2(0u, 0u); if constexpr (MK == 0) mw = *(const uint2*)(mrow + 2 * j_lo);
    char* V_lds = lds; char* K_lds = lds + 2 * SHM_V;
    float* ws = (float*)(lds + 2 * SHM_V + 2 * SHM_K) + wid * 64; float* li_l = ws, * al_l = ws + 32;
    float m_reg = -1e30f, l_reg = 0; f32x16 o[4] = {};
    const int sr = tid >> 4, sc = (tid & 15) * 8, vst0 = v_st(sr, sc), vst1 = v_st(32 + sr, sc), kws = KSWZ(sr, sc * 2);
    const int vb0 = (int)(uintptr_t)V_lds + v_rd_base(lane);
    const TIn* Kh = cur.K; const TIn* Vh = cur.V;
#define RESC(a) do { if (__any((a) < 1.f)) { if (hi == 0) al_l[r32] = (a); asm volatile("s_waitcnt lgkmcnt(0)" ::: "memory");              \
                     for (int d_ = 0; d_ < 4; ++d_) for (int r = 0; r < 16; ++r) o[d_][r] *= al_l[crow(r, hi)]; } } while (0)
#define KBASE(t) ((j_lo + (t)) * KVBLK)
#define ACT(t) (KBASE(t) <= qlo + QBLK - 1 && KBASE(t) + KVBLK - 1 >= qlo - W + 1)
#define MASKT(P0_, P1_, t) do { const int kb_ = KBASE(t); \
        if constexpr (MK == 1) { if (kb_ + KVBLK - 1 + 512 < qlo) mask_far(P0_, P1_, qm - kb_); else mask_mult(P0_, P1_, qm - kb_); } \
        else { mask_bits(P0_, P1_, mw.x >> (4 * hi), mw.y >> (4 * hi)); const int tn_ = ((t) + 1 < NT) ? (t) + 1 : (t); mw = *(const uint2*)(mrow + 2 * (j_lo + tn_)); } } while (0)
    constexpr int NQL = F32 ? 16 : 8;
    constexpr bool SK = WSKIP && !F32;
#define SEAM_K0() do { VMWN(NQL); if constexpr (F32) { SWRITE_KF(0); SBAR(); SLOAD_F((const float*)nxt.V, kbn); } else { SWRITE_HK(0); } SBAR(); } while (0)
    f32x16 pA0, pA1, pB0, pB1; float mnA, mnB, alA, alB; bf16x8 pa0, pa1, pa2, pa3;
    if constexpr (F32) { VMW(); SWRITE_VF(0); SBAR(); } else { SWRITE_HV(0); SBAR(); }
    if (NT > 1) { if constexpr (F32) SLOAD_F((const float*)Kh, KBASE(1)); else SLOAD_H(Kh, Vh, KBASE(1)); }
    SBAR(); qkt<0, SK>(pA0, pA1, K_lds, r32, hi, S.qr, ACT(0));
    if constexpr (F32) { if (NT > 1) { VMW(); SWRITE_KF(1); SBAR(); SLOAD_F((const float*)Vh, KBASE(1)); } }
    MASKT(pA0, pA1, 0); partialSM(pA0, pA1, m_reg, mnA, alA);
    if (NT > 1) { VMW(); if constexpr (F32) { SWRITE_VF(1); SBAR(); if (NT > 2) SLOAD_F((const float*)Kh, KBASE(2)); } else SWRITE_H(1); }
    __syncthreads();
#define HALF_STEP(PX0, PX1, mnX, alX, PY0, PY1, alY, t, KB, VB, SB) do {                                                      \
        SBAR(); qkt<KB, SK>(PX0, PX1, K_lds, r32, hi, S.qr, ACT(t));                                             \
        finishSM(PY0, PY1, alY, l_reg, pa0, pa1, pa2, pa3); SBAR();                                                           \
        if ((t) + 1 < NT) { if constexpr (F32) { VMW(); SWRITE_KF(SB); SBAR(); SLOAD_F((const float*)Vh, KBASE((t) + 1)); }  \
                            else { SLOAD_H(Kh, Vh, KBASE((t) + 1)); } SBAR(); }                                               \
        pv_tile<VB, SK>(o, vb0, pa0, pa1, pa2, pa3, ACT((t) - 1)); MASKT(PX0, PX1, (t)); partialSM(PX0, PX1, m_reg, mnX, alX);                                        \
        __syncthreads();                                                                                                      \
        if ((t) + 1 < NT) { VMW(); if constexpr (F32) { SWRITE_VF(SB); SBAR(); if ((t) + 2 < NT) SLOAD_F((const float*)Kh, KBASE((t) + 2)); } \
                            else { SWRITE_H(SB); } }                                                                          \
        RESC(alX); __syncthreads(); } while (0)
    for (int t = 1; t + 1 < NT; t += 2) {
        HALF_STEP(pB0, pB1, mnB, alB, pA0, pA1, alA, t, 1, 0, 0);
        HALF_STEP(pA0, pA1, mnA, alA, pB0, pB1, alB, t + 1, 0, 1, 1);
    }
    const bool even = (NT & 1) == 0;
    if (even) { SBAR(); qkt<1, SK>(pB0, pB1, K_lds, r32, hi, S.qr, ACT(NT - 1)); SBAR(); }
#define QROW(e) (nxt.Q + (size_t)(wid * QBLK + r32) * RSQ + ((e) >> 1) * 16 + hi * 8 + ((e) & 1) * 4)
    if constexpr (F32) { SLOAD_F((const float*)nxt.K, kbn); SBAR();
#pragma unroll
        for (int e = 0; e < 8; ++e) S.tq[e] = *(const f32x4*)QROW(e); }
    else { SLOAD_H(nxt.K, nxt.V, kbn); SBAR();
#pragma unroll
        for (int d0 = 0; d0 < 8; ++d0) S.qr[d0] = load8<TIn>(nxt.Q + (size_t)(wid * QBLK + r32) * RSQ + d0 * 16 + hi * 8); }
    SBAR();
    finishSM(pA0, pA1, alA, l_reg, pa0, pa1, pa2, pa3); SBAR();
    if constexpr (F32) {
#pragma unroll
        for (int e = 8; e < 16; ++e) S.tq[e] = *(const f32x4*)QROW(e); SBAR(); }
#undef QROW
    pv_tile<0, SK>(o, vb0, pa0, pa1, pa2, pa3, ACT(even ? NT - 2 : NT - 1));
    if (even) { MASKT(pB0, pB1, NT - 1); partialSM(pB0, pB1, m_reg, mnB, alB); __syncthreads(); RESC(alB);
        finishSM(pB0, pB1, alB, l_reg, pa0, pa1, pa2, pa3); SBAR(); pv_tile<1, SK>(o, vb0, pa0, pa1, pa2, pa3, ACT(NT - 1)); }
    SBAR(); SEAM_K0();
    if (hi == 0) li_l[r32] = l_reg; asm volatile("s_waitcnt lgkmcnt(0)" ::: "memory");
    float rli[16];
#pragma unroll
    for (int r = 0; r < 16; ++r) rli[r] = __builtin_amdgcn_rcpf(li_l[crow(r, hi)]);
    TOut* Ow = cur.O + (size_t)(wid * QBLK) * RSQ;
#pragma unroll
    for (int r = 0; r < 16; ++r) { const int orow = crow(r, hi);
#pragma unroll
        for (int d0 = 0; d0 < 4; ++d0) { const float v = o[d0][r] * rli[r];
            if constexpr (same_t<TOut, float>::v) { Ow[(size_t)orow * RSQ + d0 * 32 + r32] = v; }
            else { const float vn = __int_as_float(__builtin_amdgcn_ds_swizzle(__float_as_int(v), (1 << 10) | 0x1f));
                   if ((r32 & 1) == 0) *(unsigned*)(Ow + (size_t)orow * RSQ + d0 * 32 + r32) = cvtpk(v, vn); } } }
    if constexpr (F32) {
#pragma unroll
        for (int d0 = 0; d0 < 8; ++d0) S.qr[d0] = pack8(S.tq[2 * d0], S.tq[2 * d0 + 1]); }
    __syncthreads();
#undef RESC
#undef KBASE
#undef ACT
#undef MASKT
#undef SEAM_K0
#undef HALF_STEP
}
#undef ROW
#undef VMW
#undef VMWN
#undef SLOAD_H
#undef SWRITE_HK
#undef SWRITE_HV
#undef SWRITE_H
#undef SLOAD_F
#undef SWRITE_KF
#undef SWRITE_VF
}

__device__ __forceinline__ unsigned fkey(float f) { const unsigned u = __float_as_uint(f + 0.0f); return (u & 0x80000000u) ? ~u : (u | 0x80000000u); }

__device__ __forceinline__ void naive_index_topk(Frame& F) {
    PHASE_IDS();
    const bf16* P = F.P; constexpr int ldp = n1pad(0);
    LAS float* iq = (LAS float*)F.lds; LAS float* iw = iq + 1024; LAS float* sc = iw + 16; LAS unsigned* mw = (LAS unsigned*)(sc + 2048); LAS unsigned* cnt = mw + 64;
    for (int row = blockIdx.x; row < MTOK; row += F.G) {
        const int t = row & (SEQ - 1), rb = row - t;
        for (int i = tid; i < 1024; i += 512) iq[i] = bf2f(P[(size_t)row * ldp + A_IQ + i]);
        if (tid < 16) iw[tid] = bf2f(P[(size_t)row * ldp + A_IW + tid]) * (1.f / 32.f);
        if (tid < 64) mw[tid] = 0u;
        __syncthreads();
        for (int s = tid; s <= t; s += 512) {
            const uint4* kp = (const uint4*)(P + (size_t)(rb + s) * ldp + A_IK);
            float kk[64];
#pragma unroll
            for (int c = 0; c < 8; ++c) { const uint4 r = kp[c]; const unsigned w[4] = {r.x, r.y, r.z, r.w};
#pragma unroll
                for (int j = 0; j < 4; ++j) { kk[c * 8 + 2 * j] = __uint_as_float(w[j] << 16); kk[c * 8 + 2 * j + 1] = __uint_as_float(w[j] & 0xffff0000u); } }
            float score = 0.f;
            for (int h = 0; h < 16; ++h) { float d = 0.f;
#pragma unroll
                for (int j = 0; j < 64; ++j) d = fmaf(iq[h * 64 + j], kk[j], d);
                score += fmaxf(d, 0.f) * iw[h]; }
            sc[s] = score;
        }
        __syncthreads();
        if (t + 1 <= 256) { for (int s = tid; s <= t; s += 512) atomicOr((unsigned*)&mw[s >> 5], 1u << (s & 31)); }
        else {
            unsigned myk[4];
#pragma unroll
            for (int j = 0; j < 4; ++j) { const int s = tid + 512 * j; myk[j] = (s <= t) ? fkey(sc[s]) : 0u; }
            unsigned prefix = 0u;
            for (int bit = 31; bit >= 0; --bit) {
                const unsigned cand = prefix | (1u << bit); unsigned c = 0;
#pragma unroll
                for (int j = 0; j < 4; ++j) c += (myk[j] >= cand) ? 1u : 0u;
                if (tid == 0) *cnt = 0u;
                __syncthreads(); if (c) atomicAdd((unsigned*)cnt, c); __syncthreads();
                const unsigned total = *cnt; __syncthreads();
                if (total >= 256u) prefix = cand;
            }
            unsigned cg = 0, ce = 0;
#pragma unroll
            for (int j = 0; j < 4; ++j) { cg += (myk[j] > prefix) ? 1u : 0u; ce += (myk[j] == prefix) ? 1u : 0u; }
            if (tid == 0) *cnt = 0u;
            __syncthreads(); atomicAdd((unsigned*)cnt, cg | (ce << 16)); __syncthreads();
            const unsigned tot = *cnt; const int n_gt = (int)(tot & 0xffffu), n_eq = (int)(tot >> 16); const int need = 256 - n_gt;
#pragma unroll
            for (int j = 0; j < 4; ++j) { const int s = tid + 512 * j; if (myk[j] > prefix || (myk[j] == prefix && n_eq == need)) atomicOr((unsigned*)&mw[s >> 5], 1u << (s & 31)); }
            if (n_eq != need && tid == 0) { int left = need; for (int s = 0; s <= t && left > 0; ++s) if (fkey(sc[s]) == prefix) { atomicOr((unsigned*)&mw[s >> 5], 1u << (s & 31)); --left; } }
        }
        __syncthreads();
        if (tid < 64) F.mask[(size_t)row * 64 + tid] = mw[tid];
        __syncthreads();
    }
}

template <int MODE> __device__ __forceinline__ void naive_attn(Frame& F, int ldp, int koff, int voff, int kvhs) {
    PHASE_IDS();
    bf16* P = F.P; const int wv = wave;
    LAS int* keys = (LAS int*)F.lds; LAS float* qs = (LAS float*)(keys + 400); LAS float* sc = qs + 2048; LAS float* linv = sc + 16 * 400; LAS int* pre = (LAS int*)(linv + 16); LAS int* nk_s = pre + 64;
    for (int row = blockIdx.x; row < MTOK; row += F.G) {
        const int t = row & (SEQ - 1), rb = row - t;
        for (int i = tid; i < 2048; i += 512) qs[i] = bf2f(P[(size_t)row * ldp + i]);
        if (MODE == 0) {
            unsigned w = 0; if (tid < 64) { w = F.mask[(size_t)row * 64 + tid]; pre[tid] = __popc(w); }
            __syncthreads();
            if (tid == 0) { int run = 0; for (int i = 0; i < 64; ++i) { const int x = pre[i]; pre[i] = run; run += x; } *nk_s = run; }
            __syncthreads();
            if (tid < 64) { int pos = pre[tid]; while (w) { const int b = __ffs(w) - 1; keys[pos++] = tid * 32 + b; w &= w - 1; } }
        } else {
            if (tid < 387) { const int cfg = tid / 129, j = tid % 129, dil = cfg == 0 ? 1 : (cfg == 1 ? 4 : 16); const int s = t - j * dil; keys[tid] = s >= 0 ? s : -1; }
            if (tid == 0) *nk_s = 387;
        }
        __syncthreads();
        const int nk = *nk_s;
        if (tid < nk) {
            const int e = tid, s = keys[e];
#pragma unroll 1
            for (int h = 0; h < 16; ++h) {
                float d = -__builtin_inff();
                if (s >= 0) { const uint4* kp = (const uint4*)(P + (size_t)(rb + s) * ldp + koff + h * kvhs); d = 0.f;
#pragma unroll
                    for (int c = 0; c < 16; ++c) { const uint4 r = kp[c]; const unsigned w[4] = {r.x, r.y, r.z, r.w}; const LAS float* qp = qs + h * 128 + c * 8;
#pragma unroll
                        for (int j = 0; j < 4; ++j) { d = fmaf(qp[2 * j], __uint_as_float(w[j] << 16), d); d = fmaf(qp[2 * j + 1], __uint_as_float(w[j] & 0xffff0000u), d); } }
                    d *= QK_SCALE; }
                sc[h * 400 + e] = d;
            }
        }
        __syncthreads();
        for (int hh = 0; hh < 2; ++hh) { const int h = wv * 2 + hh; float m = -__builtin_inff();
            for (int e = lane; e < nk; e += 64) m = fmaxf(m, sc[h * 400 + e]);
            m = wave_max(m); float sum = 0.f;
            for (int e = lane; e < nk; e += 64) { const float p = __expf(sc[h * 400 + e] - m); sc[h * 400 + e] = p; sum += p; }
            sum = wave_sum(sum); if (lane == 0) linv[h] = 1.f / sum; }
        __syncthreads();
        const int d = tid & 127, hg = tid >> 7; float acc[4] = {0.f, 0.f, 0.f, 0.f};
        for (int e = 0; e < nk; ++e) { const int s = keys[e]; if (s < 0) continue; const bf16* vp = P + (size_t)(rb + s) * ldp + voff + d;
#pragma unroll
            for (int j = 0; j < 4; ++j) { const int h = hg * 4 + j; acc[j] = fmaf(sc[h * 400 + e], bf2f(vp[h * kvhs]), acc[j]); } }
#pragma unroll
        for (int j = 0; j < 4; ++j) { const int h = hg * 4 + j; P[(size_t)row * ldp + h * 128 + d] = f2bf(acc[j] * linv[h]); }
        __syncthreads();
    }
}

__device__ __forceinline__ void naive_ret(Frame& F) {
    if (blockIdx.x >= 32) return;
    bf16* P = F.P; constexpr int ldp = n1pad(2);
    int tid_o_ = threadIdx.x; asm volatile("" : "+v"(tid_o_));
    const int grp = tid_o_ >> 8, tid = tid_o_ & 255, lane = tid & 63, wv = tid >> 6, item = blockIdx.x * 2 + grp, bl = item >> 3, h = item & 7;
    const float gamma = 1.f - exp2f(-5.f - (float)h);
    LAS float* base = (LAS float*)(F.lds + grp * 40960);
    LAS float* qs = base; LAS float* ks = qs + 16 * 128; LAS float* ob = ks + 16 * 128; LAS float* sq = ob + 16 * 256;
    float S[128];
#pragma unroll
    for (int i = 0; i < 128; ++i) S[i] = 0.f;
    for (int t0 = 0; t0 < SEQ; t0 += 16) {
        const size_t row0 = (size_t)bl * SEQ + t0;
        for (int i = tid; i < 16 * 128; i += 256) { const int tt = i >> 7, c = i & 127; const bf16* pr = P + (row0 + tt) * ldp + h * 128 + c; qs[i] = bf2f(pr[0]); ks[i] = bf2f(pr[1024]); }
        __syncthreads();
#pragma unroll 1
        for (int tt = 0; tt < 16; ++tt) {
            const float v = bf2f(P[(row0 + tt) * ldp + 2048 + h * 256 + tid]); float o = 0.f;
#pragma unroll
            for (int i = 0; i < 128; i += 4) { const pg8::f32x4 k4 = *(const LAS pg8::f32x4*)&ks[tt * 128 + i], q4 = *(const LAS pg8::f32x4*)&qs[tt * 128 + i];
                S[i] = fmaf(gamma, S[i], k4.x * v); o = fmaf(q4.x, S[i], o); S[i + 1] = fmaf(gamma, S[i + 1], k4.y * v); o = fmaf(q4.y, S[i + 1], o);
                S[i + 2] = fmaf(gamma, S[i + 2], k4.z * v); o = fmaf(q4.z, S[i + 2], o); S[i + 3] = fmaf(gamma, S[i + 3], k4.w * v); o = fmaf(q4.w, S[i + 3], o); }
            ob[tt * 256 + tid] = o;
        }
        __syncthreads();
        for (int j = 0; j < 4; ++j) { const int tt = wv * 4 + j; float s = 0.f; for (int c = lane; c < 256; c += 64) s += ob[tt * 256 + c] * ob[tt * 256 + c]; s = wave_sum(s);
            if (lane < 4) F.ssq[((row0 + tt) * 8 + h) * 4 + lane] = lane == 0 ? s : 0.f; }
        for (int tt = 0; tt < 16; ++tt) P[(row0 + tt) * ldp + 2048 + h * 256 + tid] = f2bf(ob[tt * 256 + tid]);
        __syncthreads();
    }
}

__device__ __forceinline__ void naive_hgrn(Frame& F) {
    if (blockIdx.x >= 32) return;
    bf16* P = F.P; constexpr int ldp = n1pad(3);
    int tid_o_ = threadIdx.x; asm volatile("" : "+v"(tid_o_));
    const int grp = tid_o_ >> 7, tid = tid_o_ & 127, lane = tid & 63, wv = tid >> 6, item = blockIdx.x * 4 + grp, bl = item >> 4, h = item & 15;
    LAS float* base = (LAS float*)(F.lds + grp * 28672);
    LAS float* qs = base; LAS float* gs = qs + 16 * 128; LAS float* ob = gs + 16 * 128;
    const float lbc = F.lb[h * 128 + tid];
    float S[128];
#pragma unroll
    for (int i = 0; i < 128; ++i) S[i] = 0.f;
    for (int t0 = 0; t0 < SEQ; t0 += 16) {
        const size_t row0 = (size_t)bl * SEQ + t0;
        for (int tt = 0; tt < 16; ++tt) { const bf16* pr = P + (row0 + tt) * ldp + h * 128 + tid;
            qs[tt * 128 + tid] = silu_f(bf2f(pr[0])) * QK_SCALE; gs[tt * 128 + tid] = lbc + (1.f - lbc) * sigmoid_f(bf2f(pr[2048])); }
        __syncthreads();
#pragma unroll 1
        for (int tt = 0; tt < 16; ++tt) {
            const float v = bf2f(P[(row0 + tt) * ldp + 4096 + h * 128 + tid]); float o = 0.f;
#pragma unroll
            for (int i = 0; i < 128; i += 4) { const pg8::f32x4 g4 = *(const LAS pg8::f32x4*)&gs[tt * 128 + i], q4 = *(const LAS pg8::f32x4*)&qs[tt * 128 + i];
                S[i] = fmaf(g4.x, S[i] - v, v); o = fmaf(q4.x, S[i], o); S[i + 1] = fmaf(g4.y, S[i + 1] - v, v); o = fmaf(q4.y, S[i + 1], o);
                S[i + 2] = fmaf(g4.z, S[i + 2] - v, v); o = fmaf(q4.z, S[i + 2], o); S[i + 3] = fmaf(g4.w, S[i + 3] - v, v); o = fmaf(q4.w, S[i + 3], o); }
            ob[tt * 128 + tid] = o;
        }
        __syncthreads();
        for (int j = 0; j < 8; ++j) { const int tt = wv * 8 + j; float s = ob[tt * 128 + lane] * ob[tt * 128 + lane] + ob[tt * 128 + lane + 64] * ob[tt * 128 + lane + 64]; s = wave_sum(s);
            if (lane < 2) F.ssq[((row0 + tt) * 16 + h) * 2 + lane] = lane == 0 ? s : 0.f; }
        for (int tt = 0; tt < 16; ++tt) P[(row0 + tt) * ldp + 4096 + h * 128 + tid] = f2bf(ob[tt * 128 + tid]);
        __syncthreads();
    }
}

typedef short ix_bf16x8 __attribute__((ext_vector_type(8)));
typedef float ix_f32x16 __attribute__((ext_vector_type(16)));
__device__ __forceinline__ int half_sum(int v) {
    v += swz_xor_i<1>(v); v += swz_xor_i<2>(v); v += swz_xor_i<4>(v); v += swz_xor_i<8>(v); v += swz_xor_i<16>(v);
    return v;
}
__device__ __forceinline__ void index_topk_phase(Frame& F) {
    PHASE_IDS();
    const bf16* P = F.P; constexpr int ldp = n1pad(0), ROWB = 144, BUFB = 256 * ROWB;
    const int c = lane & 31, hi = lane >> 5;
#pragma unroll 1
    for (int uu = 0; uu < 4; ++uu) {
        const int unit = (uu & 1) ? (1023 - (uu >> 1) * 256 - (int)blockIdx.x) : ((uu >> 1) * 256 + (int)blockIdx.x);
        const int row0 = unit * 16, rb = row0 & ~(SEQ - 1), tu = row0 & (SEQ - 1);
        const int t0 = tu + 2 * wave, tq = t0 + hi;
        const int nchunk = (tu + 15) / 256 + 1, jmax = (t0 + 1) >> 5;
        ix_bf16x8 afr[4];
        { const bf16* ap = P + (size_t)(row0 + 2 * wave + (c >> 4)) * ldp + A_IQ + (c & 15) * 64 + 8 * hi;
#pragma unroll
          for (int s = 0; s < 4; ++s) afr[s] = *(const ix_bf16x8*)(ap + 16 * s); }
        float w0[8], w1[8];
        { const bf16* wp = P + (size_t)(row0 + 2 * wave) * ldp + A_IW;
#pragma unroll
          for (int j = 0; j < 8; ++j) { const int hd = (j & 3) + 8 * (j >> 2) + 4 * hi; w0[j] = bf2f(wp[hd]) * (1.f / 32.f); w1[j] = bf2f(wp[ldp + hd]) * (1.f / 32.f); } }
        unsigned uk[64];
#pragma unroll
        for (int j = 0; j < 64; ++j) uk[j] = 0u;
        pg8::u32x4 st[4];
        { const bf16* gp = P + (size_t)rb * ldp + A_IK;
#pragma unroll
          for (int i = 0; i < 4; ++i) { const int p = tid + 512 * i; st[i] = *(const pg8::u32x4*)(gp + (size_t)(p >> 3) * ldp + (p & 7) * 8); }
#pragma unroll
          for (int i = 0; i < 4; ++i) { const int p = tid + 512 * i; *(LAS pg8::u32x4*)(F.lds + (p >> 3) * ROWB + (p & 7) * 16) = st[i]; } }
        __syncthreads();
#pragma unroll
        for (int ch = 0; ch < 8; ++ch) {
            if (ch < nchunk) {
                const bool more = ch + 1 < nchunk;
                if (more) { const bf16* gp = P + (size_t)(rb + 256 * (ch + 1)) * ldp + A_IK;
#pragma unroll
                    for (int i = 0; i < 4; ++i) { const int p = tid + 512 * i; st[i] = *(const pg8::u32x4*)(gp + (size_t)(p >> 3) * ldp + (p & 7) * 8); } }
                const LAS unsigned char* buf = F.lds + (ch & 1) * BUFB + c * ROWB + 16 * hi;
#pragma unroll
                for (int jj = 0; jj < 8; ++jj) {
                    const int j = 8 * ch + jj;
                    if (j <= jmax) {
                        ix_f32x16 acc = {};
#pragma unroll
                        for (int s = 0; s < 4; ++s) { const ix_bf16x8 bfr = *(const LAS ix_bf16x8*)(buf + jj * 32 * ROWB + 32 * s); acc = __builtin_amdgcn_mfma_f32_32x32x16_bf16(afr[s], bfr, acc, 0, 0, 0); }
                        float s0 = 0.f, s1 = 0.f;
#pragma unroll
                        for (int x = 0; x < 8; ++x) { s0 = fmaf(fmaxf(acc[x], 0.f), w0[x], s0); s1 = fmaf(fmaxf(acc[8 + x], 0.f), w1[x], s1); }
                        const auto rr = __builtin_amdgcn_permlane32_swap(__float_as_uint(s0), __float_as_uint(s1), false, false);
                        const float tot = __uint_as_float(rr[0]) + __uint_as_float(rr[1]);
                        uk[j] = (32 * j + c <= tq) ? fkey(tot) : 0u;
                    }
                }
                if (more) {
#pragma unroll
                    for (int i = 0; i < 4; ++i) { const int p = tid + 512 * i; *(LAS pg8::u32x4*)(F.lds + ((ch + 1) & 1) * BUFB + (p >> 3) * ROWB + (p & 7) * 16) = st[i]; } }
                __syncthreads();
            }
        }
        unsigned thr = 0u;
        if (t0 >= 256) {
#pragma unroll 1
            for (int bit = 31; bit >= 0; --bit) {
                const unsigned cand = thr | (1u << bit); int cnt = 0;
#pragma unroll
                for (int g = 0; g < 8; ++g) if (8 * g <= jmax) {
#pragma unroll
                    for (int x = 0; x < 8; ++x) cnt += (uk[8 * g + x] >= cand) ? 1 : 0; }
                if (half_sum(cnt) >= 256) thr = cand;
            }
        }
        int ngt = 0, neq = 0;
#pragma unroll
        for (int j = 0; j < 64; ++j) { ngt += (uk[j] > thr) ? 1 : 0; neq += (uk[j] == thr) ? 1 : 0; }
        ngt = half_sum(ngt); neq = half_sum(neq);
        const int need = 256 - ngt; const bool ties = (thr != 0u) && (neq != need);
        unsigned long long okm = ~0ull;
        if (__any(ties)) { okm = 0ull; int run = 0;
#pragma unroll
            for (int j = 0; j < 64; ++j) { const unsigned long long m = __ballot(uk[j] == thr); const unsigned mh = hi ? (unsigned)(m >> 32) : (unsigned)m;
                const int below = __popc(mh & ((1u << c) - 1u)); if (!ties || run + below < need) okm |= 1ull << j; run += __popc(mh); } }
        unsigned mw0 = 0u, mw1 = 0u;
#pragma unroll
        for (int j = 0; j < 64; ++j) { const bool sel = (uk[j] > thr) || (thr != 0u && uk[j] == thr && ((okm >> j) & 1ull));
            const unsigned long long m = __ballot(sel);
            mw0 = (lane == j) ? (unsigned)m : mw0; mw1 = (lane == j) ? (unsigned)(m >> 32) : mw1; }
        unsigned* mp = F.mask + (size_t)(row0 + 2 * wave) * 64 + lane;
        mp[0] = mw0; mp[64] = mw1;
    }
}

struct AttItem { int bh, qb0, qb1; };
__device__ __forceinline__ AttItem att_decode(int Lc, int Gq  ) {
    AttItem it; const int xcd = Lc & 7, k = Lc >> 3, per = Gq * 4, gi = k / per, r = k - gi * per;
    it.bh = (gi * 8 + xcd) * Gq + r / 4; const int x = r & 3; it.qb0 = x; it.qb1 = 7 - x; return it;
}
template <int L> __device__ __forceinline__ att::BlockRef<bf16, bf16> att_ref(const AttItem& it, int pass, bf16* P, const unsigned* mask) {
    constexpr int LDP = n1pad(L), KOFF = (L == 0) ? A_K : 2048, VOFF = (L == 0) ? A_V : 4096, KVHS = (L == 0) ? 0 : 128;
    const int qb = pass ? it.qb1 : it.qb0, b = it.bh >> 4, h = it.bh & 15;
    att::BlockRef<bf16, bf16> r;
    r.Q = P + (size_t)(b * SEQ + qb * 256) * LDP + h * 128; r.O = P + (size_t)(b * SEQ + qb * 256) * LDP + h * 128;
    r.K = P + (size_t)(b * SEQ) * LDP + KOFF + h * KVHS; r.V = P + (size_t)(b * SEQ) * LDP + VOFF + h * KVHS;
    r.M = mask + (size_t)(b * SEQ + qb * 256) * 64; r.P0 = qb * 256;
    return r;
}
template <int L> __device__ __forceinline__ void attn_phase(bf16* P, const unsigned* mask, char* lds, int G) {
    constexpr int LDP = n1pad(L), MK = (L == 0) ? 0 : 1, GQ = (L == 0) ? 16 : 1, TOTAL = 512, W = 1 << 28;
    int Lc = blockIdx.x; if (Lc >= TOTAL) return;
    AttItem it = att_decode(Lc, GQ); int pass = 0;
    att::BlockRef<bf16, bf16> cur = att_ref<L>(it, 0, P, mask);
    att::Seam<bf16> S;
    att::causal_swa_prime<bf16, bf16, LDP, LDP, MK>(cur, W, lds, S);
    for (;;) {
        const bool more_pass = pass == 0, more_item = Lc + G < TOTAL, last = !more_pass && !more_item;
        AttItem itn = it; int passn = pass + 1, Ln = Lc;
        if (!more_pass) { passn = 0; Ln = more_item ? Lc + G : Lc; itn = att_decode(Ln, GQ); }
        const att::BlockRef<bf16, bf16> nxt = last ? cur : att_ref<L>(itn, passn, P, mask);
        att::causal_swa_block<bf16, bf16, LDP, LDP, MK>(cur, nxt, SEQ, W, lds, S);
        if (last) break;
        cur = nxt; it = itn; pass = passn; Lc = Ln;
    }
}

struct Args { const float* in[12]; float* out; unsigned char* ws; };
template <int L> __device__ __forceinline__ void mixer_phase(Frame& F, const XcdBarrier& bar) {
    if (L == 0) { index_topk_phase(F); xcd_barrier(bar); attn_phase<0>(F.P, F.mask, (char*)F.lds_gen, F.G); }
    if (L == 1) attn_phase<1>(F.P, F.mask, (char*)F.lds_gen, F.G);
    if (L == 2) naive_ret(F);
    if (L == 3) naive_hgrn(F);
}
template <int L> __device__ __forceinline__ void layer_phases(Frame& F, const XcdBarrier& bar) {
    constexpr int N1 = n1pad(L);
    {
        pg8::Gemm g{F.U, F.WIN, MTOK, N1, D_MODEL, D_MODEL}; pg8::StaticOrder S; S.init(MTOK, N1, F.G, (int)blockIdx.x);
        EpiProj<L> E{F.P, N1, F.cos128, F.sin128, F.cos64, F.sin64};
        pg8::gemm_phase<EpiProj<L>, pg8::StaticOrder, true, true>(F.lds, g, S, E);
    }
    xcd_barrier(bar);
    mixer_phase<L>(F, bar);
    xcd_barrier(bar);
    {
        pg8::Gemm g{F.U, F.WIN + (size_t)N1 * D_MODEL, MTOK, D_INNER, D_MODEL, D_MODEL}; pg8::StaticOrder S; S.init(MTOK, D_INNER, F.G, (int)blockIdx.x);
        EpiGate<L> E{F.P + ocol(L), N1, F.ssq};
        pg8::gemm_phase<EpiGate<L>, pg8::StaticOrder, true, true>(F.lds, g, S, E);
    }
    xcd_barrier(bar);
    {
        pg8::Gemm g{F.P + ocol(L), F.WOUT, MTOK, D_MODEL, D_INNER, N1}; pg8::StaticOrder S; S.init(MTOK, D_MODEL, F.G, (int)blockIdx.x);
        EpiAddF32 E{F.H, D_MODEL};
        pg8::gemm_phase<EpiAddF32, pg8::StaticOrder, true, true>(F.lds, g, S, E);
    }
    xcd_barrier(bar);
    if (L < 3) { norm_rows(F, F.H, F.norm_g + (L + 1) * D_MODEL, nullptr); conv_weights<(L < 3 ? L + 1 : 3)>(F); xcd_barrier(bar); }
    else final_rows(F);
}
__global__ void __launch_bounds__(NWAVES * 64, 2) mega_fwd(Args args) {
    extern __shared__ __attribute__((aligned(16))) unsigned char lds_raw[];
    Frame F;
    F.lds = (LAS unsigned char*)lds_raw; F.lds_gen = lds_raw; F.MISC = (volatile LAS unsigned*)(F.lds + MISC_OFF);
    F.G = gridDim.x;
    unsigned char* ws = args.ws;
    F.ctl = (unsigned*)(ws + WS_CTL);
    F.x = args.in[0]; F.norm_g = args.in[1]; F.final_g = args.in[2];
    F.w_in[0] = args.in[3]; F.w_out[0] = args.in[4]; F.w_in[1] = args.in[5]; F.w_out[1] = args.in[6]; F.w_in[2] = args.in[7]; F.w_out[2] = args.in[8]; F.w_in[3] = args.in[9]; F.w_out[3] = args.in[10];
    F.lb_logits = args.in[11]; F.H = args.out;
    F.cos128 = (float*)(ws + WS_TAB); F.sin128 = F.cos128 + 2048 * 64; F.cos64 = F.sin128 + 2048 * 64; F.sin64 = F.cos64 + 2048 * 32; F.lb = F.sin64 + 2048 * 32;
    F.ssq = (float*)(ws + WS_SSQ); F.mask = (unsigned*)(ws + WS_MASK);
    F.WIN = (bf16*)(ws + WS_WIN); F.WOUT = (bf16*)(ws + WS_WOUT); F.U = (bf16*)(ws + WS_U); F.P = (bf16*)(ws + WS_P);
    for (int u = threadIdx.x; u < (LDS_BYTES - RING_BYTES) / 4; u += NWAVES * 64) ((LAS unsigned*)(F.lds + RING_BYTES))[u] = 0u;
    __syncthreads();
    const XcdBarrier bar = xcd_barrier_post(F.ctl + CW_BAR, F.MISC + 8);
    make_tables(F); norm_rows(F, F.x, F.norm_g, F.H); conv_weights<0>(F);
    xcd_barrier(bar);
    layer_phases<0>(F, bar);
    layer_phases<1>(F, bar);
    layer_phases<2>(F, bar);
    layer_phases<3>(F, bar);
}

extern "C" void kernel_launch(void* const* d_in, const int* in_sizes, int n_in, void* d_out, int out_size, void* d_ws, size_t ws_size, hipStream_t stream) {
    static int grid = 0;
    if (grid == 0) {
        int dev = 0, cus = 0;
        if (hipGetDevice(&dev) != hipSuccess || hipDeviceGetAttribute(&cus, hipDeviceAttributeMultiprocessorCount, dev) != hipSuccess) { grid = -1; return; }
        if (hipFuncSetAttribute((const void*)mega_fwd, hipFuncAttributeMaxDynamicSharedMemorySize, LDS_BYTES) != hipSuccess) { grid = -1; return; }
        int per_cu = 0; (void)hipOccupancyMaxActiveBlocksPerMultiprocessor(&per_cu, (const void*)mega_fwd, NWAVES * 64, LDS_BYTES); (void)hipGetLastError();
        if (cus < 256) { fprintf(stderr, "kernel_launch: needs 256 CUs\n"); grid = -1; return; }
        grid = 256;
        if (ws_size < WS_END || n_in != 12) { fprintf(stderr, "kernel_launch: unexpected workspace / inputs\n"); grid = -1; return; }
    }
    if (grid < 0) return;
    (void)hipMemsetAsync((char*)d_ws + WS_CTL, 0, CTL_ZERO_BYTES, stream);
    Args a; for (int i = 0; i < 12; ++i) a.in[i] = (const float*)d_in[i];
    a.out = (float*)d_out; a.ws = (unsigned char*)d_ws;
    hipLaunchKernelGGL(mega_fwd, dim3(grid), dim3(NWAVES * 64), LDS_BYTES, stream, a);
}
```

```cpp
#include <hip/hip_runtime.h>
#include <cstdio>
#include <cstdint>
#define GAS __attribute__((address_space(1)))
#define LAS __attribute__((address_space(3)))
namespace pg8 {
#define PG8_LAS __attribute__((address_space(3)))
typedef unsigned short bf16_t;
typedef short bf16x8 __attribute__((ext_vector_type(8)));
typedef float f32x4 __attribute__((ext_vector_type(4)));
typedef unsigned u32x4 __attribute__((ext_vector_type(4)));
constexpr int BM = 256, BK = 64, HALF = 128, HTB = HALF * BK * 2  , STAGE_BYTES = 8 * HTB, NXCD = 8, WGM = 8;

__host__ __device__ __forceinline__ int lds_byte(int r, int c) { const int st = (r >> 4) * 2 + (c >> 5), rr = r & 15, cc = c & 31, ob = rr * 64 + cc * 2; return st * 1024 + (ob ^ (((ob >> 9) & 1) << 5)); }
__host__ __device__ __forceinline__ void stage_rc(int b, int& R, int& C) { const int st = b / 1024, sb = b % 1024, swz = sb ^ (((sb >> 9) & 1) << 5); R = (st >> 1) * 16 + swz / 64; C = (st & 1) * 32 + (swz % 64) / 2; }
__host__ __device__ __forceinline__ int perm32(int rho) { const int n = rho >> 4, i = rho & 15; return 8 * (i >> 2) + 4 * n + (i & 3); }

struct Unit { int pm, pn; };
struct Gemm { const bf16_t* A; const bf16_t* Bt; int M, N, K, lda; };

struct StaticOrder {
    int nM, nN, nwg, G, c;
    __host__ __device__ void init(int M, int N, int G_, int c_) { nM = M / BM; nN = N / BM; nwg = nM * nN; G = G_; c = c_; }
    __host__ __device__ bool next(int i, Unit& u) const {
        const long L = (long)i * G + c; if (L >= nwg) return false;
        int wgid = (int)L; { const int q = nwg / NXCD, r = nwg % NXCD, xcd = wgid % NXCD, off = wgid / NXCD; wgid = (xcd < r ? xcd * (q + 1) : r * (q + 1) + (xcd - r) * q) + off; }
        const int nig = WGM * nN, gid = wgid / nig, fm = gid * WGM, gsz = (nM - fm) < WGM ? (nM - fm) : WGM;
        u.pm = fm + ((wgid % nig) % gsz); u.pn = (wgid % nig) / gsz; return true;
    }
    __device__ __forceinline__ void a_ready(const Unit&) const {}
    __device__ __forceinline__ void done(const Unit&) const {}
};

__device__ __forceinline__ unsigned cvt_pk_bf16(float lo, float hi) { unsigned r; asm volatile("v_cvt_pk_bf16_f32 %0, %1, %2" : "=v"(r) : "v"(lo), "v"(hi)); return r; }
typedef float f32x2 __attribute__((ext_vector_type(2)));
template <class Epi, class Sched, bool ALIGN_EPI = false, bool SP2 = false>
__device__ __forceinline__ void gemm_phase(PG8_LAS unsigned char* lds, const Gemm g, const Sched& S, const Epi& E) {
    int tid_o = threadIdx.x; asm volatile("" : "+v"(tid_o));
    const int tid = tid_o, wid = __builtin_amdgcn_readfirstlane(tid >> 6), lane = tid & 63, wr = wid >> 2, wc = wid & 3, fr = lane & 15, fq = lane >> 4;
    const int K = g.K, nt = K / BK;
    unsigned voffA[2], voffB[2];
#pragma unroll
    for (int i = 0; i < 2; ++i) { int R, C; stage_rc(tid * 16 + i * 8192, R, C); const int Rb = Epi::PERM ? ((R & ~31) + perm32(R & 31)) : R;
        voffA[i] = (unsigned)(R * g.lda + C) * 2u; voffB[i] = (unsigned)(Rb * K + C) * 2u; }
    const size_t kstep = (size_t)(BK * 2);
    const size_t hstepA = (size_t)HALF * g.lda * 2, hstepB = (size_t)HALF * K * 2;
    const size_t tstepA = 2 * hstepA, tstepB = 2 * hstepB;
    const unsigned ldsw = (unsigned)wid * 1024u;
    const int aoff = lds_byte(wr * 64 + fr, fq * 8), boff = lds_byte(wc * 32 + fr, fq * 8);
#define PG8_SA(b, h) (((b) * 2 + (h)) * HTB)
#define PG8_SB(b, h) ((4 + (b) * 2 + (h)) * HTB)
#define PG8_STAGE(bufoff, gbase, voff) do { _Pragma("unroll") for (int _i = 0; _i < 2; ++_i) \
        __builtin_amdgcn_global_load_lds((const unsigned*)((const char*)(gbase) + (voff)[_i]), (PG8_LAS unsigned*)(lds + (bufoff) + ldsw + _i * 8192), 16, 0, 0); } while (0)
#define PG8_LDA(dst, b, h) do { _Pragma("unroll") for (int m = 0; m < 4; ++m) _Pragma("unroll") for (int k = 0; k < 2; ++k) dst[m][k] = *(const PG8_LAS bf16x8*)(lds + PG8_SA(b, h) + aoff + m * 2048 + k * 1024); } while (0)
#define PG8_LDB(dst, b, h) do { _Pragma("unroll") for (int n = 0; n < 2; ++n) _Pragma("unroll") for (int k = 0; k < 2; ++k) dst[n][k] = *(const PG8_LAS bf16x8*)(lds + PG8_SB(b, h) + boff + n * 2048 + k * 1024); } while (0)
#define PG8_MMA(ai, bj, At, Bt) do { __builtin_amdgcn_s_setprio(1); _Pragma("unroll") for (int m = 0; m < 4; ++m) _Pragma("unroll") for (int n = 0; n < 2; ++n) _Pragma("unroll") for (int k = 0; k < 2; ++k) \
        acc[ai][bj][m][n] = __builtin_amdgcn_mfma_f32_16x16x32_bf16(Bt[n][k], At[m][k], acc[ai][bj][m][n], 0, 0, 0); __builtin_amdgcn_s_setprio(0); } while (0)
#define PG8_WAIT_V(n) asm volatile("s_waitcnt vmcnt(" #n ")" ::: "memory")
#define PG8_WAIT_L(n) asm volatile("s_waitcnt lgkmcnt(" #n ")" ::: "memory")
#define PG8_BAR __builtin_amdgcn_s_barrier()
#define PG8_SCHED __builtin_amdgcn_sched_barrier(0)
    Unit cur, nxt; int ui = 0;
    if (!S.next(0, cur)) return;
    f32x4 acc[2][2][4][2];
#pragma unroll
    for (int a = 0; a < 2; ++a)
#pragma unroll
        for (int b = 0; b < 2; ++b)
#pragma unroll
            for (int m = 0; m < 4; ++m)
#pragma unroll
                for (int n = 0; n < 2; ++n) acc[a][b][m][n] = (f32x4){0.f, 0.f, 0.f, 0.f};
    bf16x8 At[4][2], B0[2][2], B1[2][2];
    const char* cA = (const char*)g.A + (size_t)cur.pm * tstepA; const char* cB = (const char*)g.Bt + (size_t)cur.pn * tstepB;
    S.a_ready(cur);
    if constexpr (SP2) {
        PG8_STAGE(PG8_SB(0, 0), cB, voffB); PG8_STAGE(PG8_SB(0, 1), cB + hstepB, voffB); PG8_STAGE(PG8_SA(0, 0), cA, voffA); PG8_STAGE(PG8_SA(0, 1), cA + hstepA, voffA);
        if (wr == 1) PG8_BAR;
        PG8_WAIT_V(2); PG8_BAR;
        PG8_STAGE(PG8_SB(1, 0), cB + kstep, voffB); PG8_STAGE(PG8_SA(1, 0), cA + kstep, voffA); PG8_STAGE(PG8_SB(1, 1), cB + hstepB + kstep, voffB);
        PG8_WAIT_V(6); PG8_BAR;
    } else {
        PG8_STAGE(PG8_SB(0, 0), cB, voffB); PG8_STAGE(PG8_SA(0, 0), cA, voffA); PG8_STAGE(PG8_SB(0, 1), cB + hstepB, voffB); PG8_STAGE(PG8_SA(0, 1), cA + hstepA, voffA);
        if (wr == 1) PG8_BAR;
        PG8_WAIT_V(4); PG8_BAR;
        PG8_STAGE(PG8_SB(1, 0), cB + kstep, voffB); PG8_STAGE(PG8_SA(1, 0), cA + kstep, voffA); PG8_STAGE(PG8_SB(1, 1), cB + hstepB + kstep, voffB);
        PG8_WAIT_V(6); PG8_BAR;
    }
    for (;;) {
        const bool has_next = S.next(ui + 1, nxt);
        const char* nA = has_next ? (const char*)g.A + (size_t)nxt.pm * tstepA : cA; const char* nB = has_next ? (const char*)g.Bt + (size_t)nxt.pn * tstepB : cB;
        for (int t = 0; t < nt; t += 2) {
            const bool last = (t == nt - 2);
            const char* a1 = cA + (size_t)(t + 1) * kstep;
            const char* a2 = last ? nA : cA + (size_t)(t + 2) * kstep; const char* b2 = last ? nB : cB + (size_t)(t + 2) * kstep;
            const char* a3 = a2 + kstep; const char* b3 = b2 + kstep;
            if (last && has_next) S.a_ready(nxt);
            if constexpr (SP2) {
            PG8_LDB(B0, 0, 0); PG8_LDB(B1, 0, 1); PG8_SCHED; PG8_LDA(At, 0, 0); PG8_STAGE(PG8_SA(1, 1), a1 + hstepA, voffA);
            PG8_WAIT_V(8); PG8_WAIT_L(0); PG8_BAR; PG8_MMA(0, 0, At, B0); PG8_MMA(0, 1, At, B1); PG8_BAR; PG8_SCHED;
            PG8_LDA(At, 0, 1); PG8_STAGE(PG8_SB(0, 0), b2, voffB); PG8_STAGE(PG8_SB(0, 1), b2 + hstepB, voffB); PG8_STAGE(PG8_SA(0, 0), a2, voffA);
            PG8_WAIT_V(8); PG8_WAIT_L(0); PG8_BAR; PG8_MMA(1, 0, At, B0); PG8_MMA(1, 1, At, B1); PG8_BAR; PG8_SCHED;
            PG8_LDB(B0, 1, 0); PG8_LDB(B1, 1, 1); PG8_SCHED; PG8_LDA(At, 1, 0); PG8_STAGE(PG8_SA(0, 1), a2 + hstepA, voffA);
            PG8_WAIT_V(8); PG8_WAIT_L(0); PG8_BAR; PG8_MMA(0, 0, At, B0); PG8_MMA(0, 1, At, B1); PG8_BAR; PG8_SCHED;
            PG8_LDA(At, 1, 1); PG8_STAGE(PG8_SB(1, 0), b3, voffB); PG8_STAGE(PG8_SB(1, 1), b3 + hstepB, voffB); PG8_STAGE(PG8_SA(1, 0), a3, voffA);
            PG8_WAIT_V(8); PG8_WAIT_L(0); PG8_BAR; PG8_MMA(1, 0, At, B0); PG8_MMA(1, 1, At, B1); PG8_BAR; PG8_SCHED;
            } else {
            PG8_LDB(B0, 0, 0); PG8_SCHED; PG8_LDA(At, 0, 0); PG8_STAGE(PG8_SA(1, 1), a1 + hstepA, voffA);
            PG8_WAIT_L(8); PG8_BAR; PG8_WAIT_L(0); PG8_MMA(0, 0, At, B0); PG8_BAR; PG8_SCHED;
            PG8_LDB(B1, 0, 1); PG8_STAGE(PG8_SB(0, 0), b2, voffB);
            PG8_BAR; PG8_WAIT_L(0); PG8_MMA(0, 1, At, B1); PG8_BAR;
            PG8_LDA(At, 0, 1); PG8_STAGE(PG8_SA(0, 0), a2, voffA);
            PG8_BAR; PG8_WAIT_L(0); PG8_MMA(1, 0, At, B0); PG8_BAR; PG8_SCHED;
            PG8_STAGE(PG8_SB(0, 1), b2 + hstepB, voffB);
            PG8_WAIT_V(6); PG8_BAR; PG8_MMA(1, 1, At, B1); PG8_BAR;
            PG8_LDB(B0, 1, 0); PG8_SCHED; PG8_LDA(At, 1, 0); PG8_STAGE(PG8_SA(0, 1), a2 + hstepA, voffA);
            PG8_WAIT_L(8); PG8_BAR; PG8_WAIT_L(0); PG8_MMA(0, 0, At, B0); PG8_BAR; PG8_SCHED;
            PG8_LDB(B1, 1, 1); PG8_STAGE(PG8_SB(1, 0), b3, voffB);
            PG8_BAR; PG8_WAIT_L(0); PG8_MMA(0, 1, At, B1); PG8_BAR;
            PG8_LDA(At, 1, 1); PG8_STAGE(PG8_SA(1, 0), a3, voffA);
            PG8_BAR; PG8_WAIT_L(0); PG8_MMA(1, 0, At, B0); PG8_BAR; PG8_SCHED;
            PG8_STAGE(PG8_SB(1, 1), b3 + hstepB, voffB);
            PG8_WAIT_V(6); PG8_BAR; PG8_MMA(1, 1, At, B1); PG8_BAR;
            }
        }
        if constexpr (ALIGN_EPI) { if (wr == 0) PG8_BAR; }
        if constexpr (!Epi::AFTER_DRAIN) { E(acc, cur, wr, wc, fr, fq); S.done(cur); }
        if (!has_next) break;
#pragma unroll
        for (int a = 0; a < 2; ++a)
#pragma unroll
            for (int b = 0; b < 2; ++b)
#pragma unroll
                for (int m = 0; m < 4; ++m)
#pragma unroll
                    for (int n = 0; n < 2; ++n) acc[a][b][m][n] = (f32x4){0.f, 0.f, 0.f, 0.f};
        cur = nxt; cA = nA; cB = nB; ++ui;
        if constexpr (ALIGN_EPI) { if (wr == 1) PG8_BAR; }
    }
    PG8_WAIT_V(0);
    if constexpr (!ALIGN_EPI) { if (wr == 0) PG8_BAR; }
    PG8_BAR;
    if constexpr (Epi::AFTER_DRAIN) { E.fused(acc, cur, wr, wc, fr, fq, lds, wid, lane); S.done(cur); }
#undef PG8_SA
#undef PG8_SB
#undef PG8_STAGE
#undef PG8_LDA
#undef PG8_LDB
#undef PG8_MMA
#undef PG8_WAIT_V
#undef PG8_WAIT_L
#undef PG8_BAR
#undef PG8_SCHED
}
}
#define XB_TMO      128
#define XB_XCNT(j)  (256  + 64 * (j))
#define XB_XSUB(j)  (1280 + 64 * (j))
#define XB_XGEN(j)  (2304 + 64 * (j))
#define XB_TOP      3328
#define XB_TOPGEN   3392
#define XCD_BAR_WORDS 3456
#define XB_SPIN_CAP (1u << 18)

__device__ __forceinline__ unsigned xb_ld(unsigned* p)              { return __hip_atomic_load(p, __ATOMIC_RELAXED, __HIP_MEMORY_SCOPE_AGENT); }
__device__ __forceinline__ unsigned xb_add(unsigned* p, unsigned v) { return __hip_atomic_fetch_add(p, v, __ATOMIC_RELAXED, __HIP_MEMORY_SCOPE_AGENT); }
__device__ __forceinline__ unsigned xb_xcc_id() { return (unsigned)__builtin_amdgcn_s_getreg((3 << 11) | 20) & 0xFu; }
#define XB_SPIN(cond, bar) do { unsigned _sp = 0; while (cond) { __builtin_amdgcn_s_sleep(1); \
    if ((++_sp & 255u) == 0u) { if (xb_ld(&(bar)[XB_TMO])) break; if (_sp > XB_SPIN_CAP) { atomicAdd(&(bar)[XB_TMO], 1u); break; } } } } while (0)

struct XcdBarrier {
    unsigned* bar; unsigned x;
    volatile LAS unsigned* st;
};

__device__ __forceinline__ XcdBarrier xcd_barrier_post(unsigned* bar, volatile LAS unsigned* st) {
    XcdBarrier b; b.bar = bar; b.x = xb_xcc_id(); b.st = st;
    if (threadIdx.x == 0) (void)xb_add(&bar[XB_XCNT(b.x)], 1u);
    return b;
}
__device__ __forceinline__ void xcd_barrier_complete(unsigned* bar, unsigned x, unsigned& nloc, unsigned& nx) {
    const unsigned G = gridDim.x * gridDim.y * gridDim.z;
    unsigned sum, cnt, mine, sp = 0u;
    for (;;) {
        sum = 0u; cnt = 0u; mine = 0u;
#pragma unroll
        for (unsigned j = 0; j < 16; ++j) { const unsigned c = xb_ld(&bar[XB_XCNT(j)]); sum += c; cnt += (c > 0u) ? 1u : 0u; mine = (j == x) ? c : mine; }
        if (sum == G) break;
        __builtin_amdgcn_s_sleep(1);
        if ((++sp & 255u) == 0u) { if (xb_ld(&bar[XB_TMO])) break; if (sp > XB_SPIN_CAP) { atomicAdd(&bar[XB_TMO], 1u); break; } }
    }
    nloc = mine > 0u ? mine : 1u; nx = cnt > 0u ? cnt : 1u;
}

__device__ __forceinline__ void xcd_barrier(const XcdBarrier& b) {
    asm volatile("s_waitcnt vmcnt(0)" ::: "memory");
    __syncthreads();
    if (threadIdx.x == 0) {
        unsigned* bar = b.bar;
        __builtin_amdgcn_s_waitcnt(0);
        unsigned nloc = b.st[0], nx = b.st[1];
        if (nloc == 0u) { xcd_barrier_complete(bar, b.x, nloc, nx); b.st[0] = nloc; b.st[1] = nx; }
        const unsigned old = xb_add(&bar[XB_XSUB(b.x)], 1u);
        const unsigned gen = old / nloc;
        if (old + 1u == (gen + 1u) * nloc) {
            __builtin_amdgcn_fence(__ATOMIC_RELEASE, "agent");
            asm volatile("s_waitcnt vmcnt(0)" ::: "memory");
            const unsigned og = xb_add(&bar[XB_TOP], 1u);
            const unsigned tg = og / nx;
            if (og + 1u == (tg + 1u) * nx) xb_add(&bar[XB_TOPGEN], 1u);
            else XB_SPIN(xb_ld(&bar[XB_TOPGEN]) == tg, bar);
            __builtin_amdgcn_fence(__ATOMIC_ACQUIRE, "agent");
            xb_add(&bar[XB_XGEN(b.x)], 1u);
            asm volatile("s_waitcnt vmcnt(0)" ::: "memory");
        } else {
            XB_SPIN(xb_ld(&bar[XB_XGEN(b.x)]) == gen, bar);
            __builtin_amdgcn_fence(__ATOMIC_ACQUIRE, "agent");
            asm volatile("s_waitcnt vmcnt(0)" ::: "memory");
        }
    }
    __syncthreads();
}

typedef unsigned short bf16;
typedef GAS unsigned gu32;
constexpr int D_MODEL = 1024, SEQ = 2048, D_INNER = 2048, MTOK = 16384, NWAVES = 8;
constexpr float QK_SCALE = 0.08838834764831845f;
constexpr size_t MiB = 1u << 20;
constexpr size_t WS_CTL = 0, CTL_ZERO_BYTES = 64 * 1024, WS_TAB = 1 * MiB, WS_SSQ = 3 * MiB, WS_MASK = 7 * MiB, WS_WIN = 12 * MiB, WS_WOUT = 28 * MiB, WS_U = 32 * MiB, WS_P = 64 * MiB, WS_END = 256 * MiB;
constexpr int CW_BAR = 1024;
constexpr int RING_BYTES = 131072, MISC_OFF = RING_BYTES + 320, LDS_BYTES = 147456;
__host__ __device__ constexpr int n1pad(int L) { return L == 0 ? 3584 : (L == 1 ? 6144 : (L == 2 ? 4096 : 6144)); }
__host__ __device__ constexpr int n1real(int L) { return L == 0 ? 3408 : (L == 1 ? 6144 : (L == 2 ? 4096 : 6144)); }
__host__ __device__ constexpr int nsrc(int L) { return L == 0 ? 5456 : (L == 1 ? 8192 : (L == 2 ? 6144 : 8192)); }
__host__ __device__ constexpr int ocol(int L) { return L == 0 ? 0 : (L == 1 ? 0 : (L == 2 ? 2048 : 4096)); }
constexpr int A_K = 2048, A_V = 2176, A_IQ = 2304, A_IK = 3328, A_IW = 3392;

__device__ __forceinline__ float bf2f(bf16 v) { return __uint_as_float(((unsigned)v) << 16); }
__device__ __forceinline__ bf16 f2bf(float f) { unsigned u = __float_as_uint(f); return (bf16)((u + 0x7fffu + ((u >> 16) & 1u)) >> 16); }
__device__ __forceinline__ unsigned pk2(float lo, float hi) { return (unsigned)f2bf(lo) | ((unsigned)f2bf(hi) << 16); }
template <int M> __device__ __forceinline__ float swz_xor(float v) { return __int_as_float(__builtin_amdgcn_ds_swizzle(__float_as_int(v), (M << 10) | 0x1f)); }
template <int M> __device__ __forceinline__ int swz_xor_i(int v) { return __builtin_amdgcn_ds_swizzle(v, (M << 10) | 0x1f); }
__device__ __forceinline__ float wave_sum(float v) {
    v += swz_xor<1>(v); v += swz_xor<2>(v); v += swz_xor<4>(v); v += swz_xor<8>(v); v += swz_xor<16>(v);
    const auto rr = __builtin_amdgcn_permlane32_swap(__float_as_uint(v), __float_as_uint(v), false, false);
    return __uint_as_float(rr[0]) + __uint_as_float(rr[1]);
}
__device__ __forceinline__ float wave_max(float v) {
    v = fmaxf(v, swz_xor<1>(v)); v = fmaxf(v, swz_xor<2>(v)); v = fmaxf(v, swz_xor<4>(v)); v = fmaxf(v, swz_xor<8>(v)); v = fmaxf(v, swz_xor<16>(v));
    const auto rr = __builtin_amdgcn_permlane32_swap(__float_as_uint(v), __float_as_uint(v), false, false);
    return fmaxf(__uint_as_float(rr[0]), __uint_as_float(rr[1]));
}
__device__ __forceinline__ float silu_f(float z) { return z * __builtin_amdgcn_rcpf(1.f + __expf(-z)); }
__device__ __forceinline__ float sigmoid_f(float z) { return __builtin_amdgcn_rcpf(1.f + __expf(-z)); }
#define LDS_WAIT() asm volatile("s_waitcnt lgkmcnt(0)" ::: "memory")
#define PHASE_IDS() int tid_o_ = threadIdx.x; asm volatile("" : "+v"(tid_o_)); const int tid = tid_o_, lane = tid & 63, wave = __builtin_amdgcn_readfirstlane(tid >> 6); (void)lane; (void)wave

struct Frame {
    LAS unsigned char* lds; unsigned char* lds_gen; volatile LAS unsigned* MISC; unsigned* ctl;
    int G;
    const float* x; const float* norm_g; const float* final_g; const float* w_in[4]; const float* w_out[4]; const float* lb_logits;
    float* H;
    float *cos128, *sin128, *cos64, *sin64, *lb, *ssq; unsigned* mask;
    bf16 *WIN, *WOUT, *U, *P;
};

template <int L> __device__ __forceinline__ int proj_mode(int g32) {
    if (L == 0) return g32 < 68 ? 1 : (g32 < 72 ? 0 : (g32 < 106 ? 2 : 0));
    if (L == 1) return g32 < 128 ? 1 : 0;
    if (L == 2) return g32 < 32 ? 1 : (g32 < 64 ? 3 : 0);
    return g32 < 64 ? 4 : (g32 < 128 ? 5 : 0);
}
template <int L> struct EpiProj {
    static constexpr bool PERM = true, AFTER_DRAIN = false;
    bf16* P; int ldp; const float *c128, *s128, *c64, *s64, *lb;
    __device__ __forceinline__ void operator()(const pg8::f32x4 (&acc)[2][2][4][2], const pg8::Unit& u, int wr, int wc, int fr, int fq) const {
        const int row0 = u.pm * 256 + wr * 64 + fr, colb = u.pn * 256 + wc * 32 + 8 * fq;
#pragma unroll
        for (int bj = 0; bj < 2; ++bj) {
            const int col = colb + bj * 128; const int mode = proj_mode<L>(__builtin_amdgcn_readfirstlane(col >> 5));
#pragma unroll
            for (int ai = 0; ai < 2; ++ai)
#pragma unroll
                for (int m = 0; m < 4; ++m) {
                    const int row = row0 + ai * 128 + m * 16, pos = row & (SEQ - 1);
                    pg8::f32x4 v0 = acc[ai][bj][m][0], v1 = acc[ai][bj][m][1];
                    if (mode == 1 || mode == 3) { const int i0 = ((col & 127) >> 3) * 4;
                        const pg8::f32x4 c = *(const pg8::f32x4*)(c128 + pos * 64 + i0), s = *(const pg8::f32x4*)(s128 + pos * 64 + i0);
                        const pg8::f32x4 o1 = v0 * c - v1 * s, o2 = v0 * s + v1 * c; v0 = o1; v1 = o2;
                        if (mode == 3) { v0 = v0 * QK_SCALE; v1 = v1 * QK_SCALE; } }
                    else if (mode == 2) { const int i0 = ((col & 63) >> 3) * 4;
                        const pg8::f32x4 c = *(const pg8::f32x4*)(c64 + pos * 32 + i0), s = *(const pg8::f32x4*)(s64 + pos * 32 + i0);
                        const pg8::f32x4 o1 = v0 * c - v1 * s, o2 = v0 * s + v1 * c; v0 = o1; v1 = o2; }
                    else if (mode == 4) {
#pragma unroll
                        for (int j = 0; j < 4; ++j) { v0[j] = silu_f(v0[j]) * QK_SCALE; v1[j] = silu_f(v1[j]) * QK_SCALE; } }
                    else if (mode == 5) { const pg8::f32x4 l0 = *(const pg8::f32x4*)(lb + col - 2048), l1 = *(const pg8::f32x4*)(lb + col - 2048 + 4);
#pragma unroll
                        for (int j = 0; j < 4; ++j) { v0[j] = __logf(l0[j] + (1.f - l0[j]) * sigmoid_f(v0[j])); v1[j] = __logf(l1[j] + (1.f - l1[j]) * sigmoid_f(v1[j])); } }
                    pg8::u32x4 w; w.x = pg8::cvt_pk_bf16(v0[0], v0[1]); w.y = pg8::cvt_pk_bf16(v0[2], v0[3]); w.z = pg8::cvt_pk_bf16(v1[0], v1[1]); w.w = pg8::cvt_pk_bf16(v1[2], v1[3]);
                    *(pg8::u32x4*)(P + (size_t)row * ldp + col) = w;
                }
        }
    }
};
template <int L> struct EpiGate {
    static constexpr bool PERM = true, AFTER_DRAIN = false;
    bf16* O; int ldo; const float* ssq;
    __device__ __forceinline__ void operator()(const pg8::f32x4 (&acc)[2][2][4][2], const pg8::Unit& u, int wr, int wc, int fr, int fq) const {
        const int row0 = u.pm * 256 + wr * 64 + fr, colb = u.pn * 256 + wc * 32 + 8 * fq;
#pragma unroll
        for (int ai = 0; ai < 2; ++ai)
#pragma unroll
            for (int m = 0; m < 4; ++m) {
                const int row = row0 + ai * 128 + m * 16;
#pragma unroll
                for (int bj = 0; bj < 2; ++bj) {
                    const int col = colb + bj * 128; float rs = 1.f;
                    if (L == 2) { const pg8::f32x4 q = *(const pg8::f32x4*)(ssq + ((size_t)row * 8 + (col >> 8)) * 8), q2 = *(const pg8::f32x4*)(ssq + ((size_t)row * 8 + (col >> 8)) * 8 + 4);
                        rs = rsqrtf((((q[0] + q[1]) + (q[2] + q[3])) + ((q2[0] + q2[1]) + (q2[2] + q2[3]))) * (1.f / 256.f) + 1e-6f); }
                    if (L == 3) { const pg8::f32x4 q = *(const pg8::f32x4*)(ssq + ((size_t)row * 16 + (col >> 7)) * 4); rs = rsqrtf(((q[0] + q[1]) + (q[2] + q[3])) * (1.f / 128.f) + 1e-6f); }
                    bf16* p = O + (size_t)row * ldo + col; const pg8::u32x4 r = *(const pg8::u32x4*)p;
                    const pg8::f32x4 z0 = acc[ai][bj][m][0], z1 = acc[ai][bj][m][1];
                    float o[8]; o[0] = __uint_as_float(r.x << 16); o[1] = __uint_as_float(r.x & 0xffff0000u); o[2] = __uint_as_float(r.y << 16); o[3] = __uint_as_float(r.y & 0xffff0000u);
                    o[4] = __uint_as_float(r.z << 16); o[5] = __uint_as_float(r.z & 0xffff0000u); o[6] = __uint_as_float(r.w << 16); o[7] = __uint_as_float(r.w & 0xffff0000u);
#pragma unroll
                    for (int j = 0; j < 4; ++j) { o[j] = o[j] * rs * silu_f(z0[j]); o[4 + j] = o[4 + j] * rs * silu_f(z1[j]); }
                    pg8::u32x4 w; w.x = pg8::cvt_pk_bf16(o[0], o[1]); w.y = pg8::cvt_pk_bf16(o[2], o[3]); w.z = pg8::cvt_pk_bf16(o[4], o[5]); w.w = pg8::cvt_pk_bf16(o[6], o[7]);
                    *(pg8::u32x4*)p = w;
                }
            }
    }
};
struct EpiAddF32 {
    static constexpr bool PERM = false, AFTER_DRAIN = false;
    float* C; int ldc;
    __device__ __forceinline__ void operator()(const pg8::f32x4 (&acc)[2][2][4][2], const pg8::Unit& u, int wr, int wc, int fr, int fq) const {
        const int row0 = u.pm * 256 + wr * 64 + fr, col0 = u.pn * 256 + wc * 32 + 4 * fq;
#pragma unroll
        for (int ai = 0; ai < 2; ++ai)
#pragma unroll
            for (int m = 0; m < 4; ++m) { float* rowp = C + (size_t)(row0 + ai * 128 + m * 16) * ldc + col0;
#pragma unroll
                for (int bj = 0; bj < 2; ++bj)
#pragma unroll
                    for (int n = 0; n < 2; ++n) { pg8::f32x4* p = (pg8::f32x4*)(rowp + bj * 128 + n * 16); *p = *p + acc[ai][bj][m][n]; } }
    }
};

template <int L> __device__ __forceinline__ int srccol(int n) {
    if (n >= n1pad(L)) return n1real(L) + (n - n1pad(L));
    if (n >= n1real(L)) return -1;
    const int mode = proj_mode<L>(n >> 5);
    if (mode == 1 || mode == 3) { const int w = n & 127; return (n & ~127) + 64 * ((w >> 2) & 1) + 4 * (w >> 3) + (w & 3); }
    if (mode == 2) { const int r = n - A_IQ, w = r & 63; return A_IQ + (r & ~63) + 32 * ((w >> 2) & 1) + 4 * (w >> 3) + (w & 3); }
    return n;
}
template <int L  > __device__ __forceinline__ void conv_item(const float* W, int Nsrc, bf16* WT, int Kdim, int nblk, int item, LAS float* scr, int lane) {
    const int kb = item / nblk, nb = item % nblk, k0 = 64 * kb, n0 = 32 * nb;
    int src = n0 + (lane & 31); if (L >= 0) src = srccol<(L < 0 ? 0 : L)>(src);
#pragma unroll 8
    for (int i = 0; i < 32; ++i) { const int kk = 2 * i + (lane >> 5); scr[kk * 33 + (lane & 31)] = (src >= 0) ? W[(size_t)(k0 + kk) * Nsrc + src] : 0.f; }
    LDS_WAIT();
    const int c = lane & 7;
#pragma unroll
    for (int j = 0; j < 4; ++j) { const int n = (lane >> 3) + 8 * j; const LAS float* s = scr + (8 * c) * 33 + n;
        pg8::u32x4 o; o.x = pk2(s[0 * 33], s[1 * 33]); o.y = pk2(s[2 * 33], s[3 * 33]); o.z = pk2(s[4 * 33], s[5 * 33]); o.w = pk2(s[6 * 33], s[7 * 33]);
        *(pg8::u32x4*)(WT + (size_t)(n0 + n) * Kdim + k0 + 8 * c) = o; }
    LDS_WAIT();
}
template <int L> __device__ __forceinline__ void conv_weights(Frame& F) {
    PHASE_IDS();
    LAS float* scr = (LAS float*)(F.lds + wave * 16384);
    const int gw = blockIdx.x * NWAVES + wave, NGW = F.G * NWAVES;
    constexpr int NB_IN = (n1pad(L) + 2048) / 32, I_IN = NB_IN * (1024 / 64), NB_OUT = 1024 / 32, I_OUT = NB_OUT * (2048 / 64);
    for (int it = gw; it < I_IN + I_OUT; it += NGW) {
        if (it < I_IN) conv_item<L>(F.w_in[L], nsrc(L), F.WIN, 1024, NB_IN, it, scr, lane);
        else conv_item<-1>(F.w_out[L], 1024, F.WOUT, 2048, NB_OUT, it - I_IN, scr, lane);
    }
}
__device__ __forceinline__ void norm_rows(Frame& F, const float* src, const float* g, float* copy_to) {
    PHASE_IDS();
    const int gw = blockIdx.x * NWAVES + wave, NGW = F.G * NWAVES;
    for (int row = gw; row < MTOK; row += NGW) {
        const float4* xr = (const float4*)(src + (size_t)row * D_MODEL) + lane;
        float4 v[4]; float s = 0.f;
#pragma unroll
        for (int j = 0; j < 4; ++j) { v[j] = xr[64 * j]; s += v[j].x * v[j].x + v[j].y * v[j].y + v[j].z * v[j].z + v[j].w * v[j].w; }
        const float r = rsqrtf(wave_sum(s) * (1.f / D_MODEL) + 1e-6f);
#pragma unroll
        for (int j = 0; j < 4; ++j) {
            const float4 gg = ((const float4*)g)[lane + 64 * j];
            if (copy_to) ((float4*)(copy_to + (size_t)row * D_MODEL))[lane + 64 * j] = v[j];
            uint2 o; o.x = pk2(v[j].x * r * gg.x, v[j].y * r * gg.y); o.y = pk2(v[j].z * r * gg.z, v[j].w * r * gg.w);
            *(uint2*)(F.U + (size_t)row * D_MODEL + (lane + 64 * j) * 4) = o;
        }
    }
}
__device__ __forceinline__ void final_rows(Frame& F) {
    PHASE_IDS();
    const int gw = blockIdx.x * NWAVES + wave, NGW = F.G * NWAVES;
    for (int row = gw; row < MTOK; row += NGW) {
        float4* xr = (float4*)(F.H + (size_t)row * D_MODEL) + lane;
        float4 v[4]; float s = 0.f;
#pragma unroll
        for (int j = 0; j < 4; ++j) { v[j] = xr[64 * j]; s += v[j].x * v[j].x + v[j].y * v[j].y + v[j].z * v[j].z + v[j].w * v[j].w; }
        const float r = rsqrtf(wave_sum(s) * (1.f / D_MODEL) + 1e-6f);
#pragma unroll
        for (int j = 0; j < 4; ++j) { const float4 gg = ((const float4*)F.final_g)[lane + 64 * j]; xr[64 * j] = make_float4(v[j].x * r * gg.x, v[j].y * r * gg.y, v[j].z * r * gg.z, v[j].w * r * gg.w); }
    }
}
__device__ __forceinline__ void make_tables(Frame& F) {
    PHASE_IDS();
    const int gt = blockIdx.x * 512 + tid, NT = F.G * 512;
    for (int i = gt; i < 2048 * 64; i += NT) {
        { const int pos = i >> 6, f = i & 63; const float freq = exp2f(-((float)(2 * f) / 128.f) * 13.287712379549449f);
          double rev = (double)pos * (double)freq * 0.15915494309189535; rev -= floor(rev);
          F.cos128[i] = __builtin_amdgcn_cosf((float)rev); F.sin128[i] = __builtin_amdgcn_sinf((float)rev); }
        if (i < 2048 * 32) { const int pos = i >> 5, f = i & 31; const float freq = exp2f(-((float)(2 * f) / 64.f) * 13.287712379549449f);
          double rev = (double)pos * (double)freq * 0.15915494309189535; rev -= floor(rev);
          F.cos64[i] = __builtin_amdgcn_cosf((float)rev); F.sin64[i] = __builtin_amdgcn_sinf((float)rev); }
        if (i < 2048) { const float l0 = F.lb_logits[i], l1 = F.lb_logits[2048 + i], l2 = F.lb_logits[4096 + i], l3 = F.lb_logits[6144 + i];
          const float m = fmaxf(fmaxf(l0, l1), fmaxf(l2, l3)); const float e0 = __expf(l0 - m), e1 = __expf(l1 - m), e2 = __expf(l2 - m), e3 = __expf(l3 - m);
          F.lb[i] = (e1 + e2 + e3) / (e0 + e1 + e2 + e3); }
    }
}
namespace att {
constexpr int D = 128;
constexpr float THR = 8.f;
constexpr bool WSKIP = false;
constexpr float SCALE = 0.08838834764831845f;
constexpr int NW = 8, QBLK = 32, KVBLK = 64, QB = NW * QBLK;
constexpr int SHM_V = KVBLK * D * 2, SHM_K = KVBLK * D * 2;
constexpr int LDS_BYTES = 2 * SHM_V + 2 * SHM_K + NW * 64 * 4;
typedef short bf16x8 __attribute__((ext_vector_type(8)));
typedef short s16x4 __attribute__((ext_vector_type(4)));
typedef float f32x16 __attribute__((ext_vector_type(16)));
typedef float f32x4 __attribute__((ext_vector_type(4)));
typedef unsigned u32x4 __attribute__((ext_vector_type(4)));
template <class A, class Bt> struct same_t { static constexpr bool v = false; };
template <class A> struct same_t<A, A> { static constexpr bool v = true; };
#define KSWZ(row, colB) ((row) * 256 + ((colB) ^ (((row) & 7) << 4)))
#define SBAR() __builtin_amdgcn_sched_barrier(0)
__device__ __forceinline__ int v_st(int k, int c) { const int kk = (k & ~0xC) | ((k & 4) << 1) | ((k & 8) >> 1); return ((kk >> 3) * 4 + (c >> 5)) * 512 + ((kk & 7) * 32 + (c & 31)) * 2; }
__device__ __forceinline__ int v_rd_base(int lane) { return ((lane & 3) << 3) | (((lane >> 2) & 3) << 6) | (((lane >> 4) & 1) << 5) | (((lane >> 5) & 1) << 8); }
constexpr int v_rd_off(int d0, int ks, int half) { return d0 * 512 + ks * 4096 + half * 2048; }
__device__ __forceinline__ int crow(int r, int hi) { return (r & 3) + 8 * (r >> 2) + 4 * hi; }
__device__ __forceinline__ unsigned cvtpk(float lo, float hi) {
    unsigned r; asm volatile("v_cvt_pk_bf16_f32 %0, %1, %2" : "=v"(r) : "v"(lo), "v"(hi)); return r;
}
__device__ __forceinline__ bf16x8 pack8(f32x4 a, f32x4 b) {
    u32x4 w = {cvtpk(a[0], a[1]), cvtpk(a[2], a[3]), cvtpk(b[0], b[1]), cvtpk(b[2], b[3])};
    return *reinterpret_cast<bf16x8*>(&w);
}
template <class T> __device__ __forceinline__ bf16x8 load8(const T* p) {
    if constexpr (same_t<T, float>::v) { return pack8(*(const f32x4*)p, *(const f32x4*)(p + 4)); }
    else { return *reinterpret_cast<const bf16x8*>(p); }
}
__device__ __forceinline__ void mask_bits(f32x16& p0, f32x16& p1, unsigned w0, unsigned w1) {
    const float NEG = -__builtin_inff();
#pragma unroll
    for (int r = 0; r < 16; ++r) { const int c = (r & 3) + 8 * (r >> 2); if (!((w0 >> c) & 1u)) p0[r] = NEG; if (!((w1 >> c) & 1u)) p1[r] = NEG; }
}
__device__ __forceinline__ float wmult(float s, int d) {
    const unsigned ud = (unsigned)d; const int cnt = (ud <= 128u ? 1 : 0) + ((((d & 3) == 0) && ud <= 512u) ? 1 : 0) + ((((d & 15) == 0) && d >= 0) ? 1 : 0);
    const float add = cnt >= 3 ? 12.4293792f : (cnt == 2 ? 7.84206515f : 0.f);
    return cnt == 0 ? -__builtin_inff() : s + add;
}
__device__ __forceinline__ void mask_mult(f32x16& p0, f32x16& p1, int dq) {
#pragma unroll
    for (int r = 0; r < 16; ++r) { const int c = (r & 3) + 8 * (r >> 2); p0[r] = wmult(p0[r], dq - c); p1[r] = wmult(p1[r], dq - c - 32); }
}
__device__ __forceinline__ void mask_far(f32x16& p0, f32x16& p1, int dq) {
    const float NEG = -__builtin_inff(); const int dm = dq & 15;
#pragma unroll
    for (int r = 0; r < 16; ++r) { const int c = ((r & 3) + 8 * (r >> 2)) & 15; if (dm != c) { p0[r] = NEG; p1[r] = NEG; } }
}
__device__ __forceinline__ void partialSM(f32x16& p0, f32x16& p1, float& m_reg, float& mn, float& alpha) {
    float pmax = p0[0]; for (int r = 1; r < 16; ++r) pmax = fmaxf(pmax, p0[r]); for (int r = 0; r < 16; ++r) pmax = fmaxf(pmax, p1[r]);
    { auto rr = __builtin_amdgcn_permlane32_swap(__float_as_uint(pmax), __float_as_uint(pmax), false, false);
      pmax = fmaxf(__uint_as_float(rr[0]), __uint_as_float(rr[1])); }
    constexpr float C2 = 1.4426950408889634f * SCALE;
    if (__builtin_expect(__all((pmax - m_reg) * SCALE <= THR), 1)) { mn = m_reg; alpha = 1.f; }
    else { mn = fmaxf(m_reg, pmax); alpha = __builtin_amdgcn_exp2f((m_reg - mn) * C2); m_reg = mn; }
    const float mnL = -mn * C2;
    for (int r = 0; r < 16; ++r) p0[r] = fmaf(p0[r], C2, mnL); for (int r = 0; r < 16; ++r) p1[r] = fmaf(p1[r], C2, mnL);
    for (int r = 0; r < 16; ++r) p0[r] = __builtin_amdgcn_exp2f(p0[r]);
}
__device__ __forceinline__ void finishSM(f32x16& p0, f32x16& p1, float alpha, float& l_reg, bf16x8& pa0, bf16x8& pa1, bf16x8& pa2, bf16x8& pa3) {
    for (int r = 0; r < 16; ++r) p1[r] = __builtin_amdgcn_exp2f(p1[r]);
    float ps = 0; for (int r = 0; r < 16; ++r) ps += p0[r]; for (int r = 0; r < 16; ++r) ps += p1[r];
    { auto rr = __builtin_amdgcn_permlane32_swap(__float_as_uint(ps), __float_as_uint(ps), false, false);
      ps = __uint_as_float(rr[0]) + __uint_as_float(rr[1]); }
    l_reg = l_reg * alpha + ps;
#define PK4(P, B_, OUT) do { unsigned a0 = cvtpk(P[B_+0], P[B_+1]), a1 = cvtpk(P[B_+2], P[B_+3]);                          \
        unsigned b0 = cvtpk(P[B_+4], P[B_+5]), b1 = cvtpk(P[B_+6], P[B_+7]);                                             \
        auto r0 = __builtin_amdgcn_permlane32_swap(a0, b0, false, false); auto r1 = __builtin_amdgcn_permlane32_swap(a1, b1, false, false); \
        u32x4 w = {r0[0], r1[0], r0[1], r1[1]}; OUT = *reinterpret_cast<bf16x8*>(&w); } while (0)
    PK4(p0, 0, pa0); PK4(p0, 8, pa1); PK4(p1, 0, pa2); PK4(p1, 8, pa3);
#undef PK4
}
template <int KB, bool SK>
__device__ __forceinline__ void qkt(f32x16& p0, f32x16& p1, const char* K_lds, int r32, int hi, const bf16x8* qr, bool act) {
    if (SK && !act) { const float NEG = -__builtin_inff();
#pragma unroll
        for (int r = 0; r < 16; ++r) { p0[r] = NEG; p1[r] = NEG; } return; }
    p0 = f32x16{}; p1 = f32x16{};
    const char* kb[4];
#pragma unroll
    for (int dd = 0; dd < 4; ++dd) kb[dd] = K_lds + KB * SHM_K + KSWZ(r32, (dd * 16 + hi * 8) * 2);
#pragma unroll
    for (int d0 = 0; d0 < 8; ++d0) { const char* a = kb[d0 & 3] + (d0 >> 2) * 128;
        bf16x8 b0 = *reinterpret_cast<const bf16x8*>(a);
        bf16x8 b1 = *reinterpret_cast<const bf16x8*>(a + 32 * 256);
        p0 = __builtin_amdgcn_mfma_f32_32x32x16_bf16(b0, qr[d0], p0, 0, 0, 0);
        p1 = __builtin_amdgcn_mfma_f32_32x32x16_bf16(b1, qr[d0], p1, 0, 0, 0); }
}
template <int VB, bool SK>
__device__ __forceinline__ void pv_tile(f32x16* o, int vb0, bf16x8 pa0, bf16x8 pa1, bf16x8 pa2, bf16x8 pa3, bool act) {
    if (SK && !act) return;
#define TRRD(dst, off) asm volatile("ds_read_b64_tr_b16 %0, %1 offset:%2" : "=&v"(dst) : "v"(vb0), "i"(off) : "memory")
#define PV_D0(d0) do { s16x4 l0, l1, l2, l3, h0, h1, h2, h3; constexpr int b_ = VB * SHM_V + v_rd_off(d0, 0, 0);     \
        TRRD(l0, b_); TRRD(h0, b_ + 2048); TRRD(l1, b_ + 4096); TRRD(h1, b_ + 6144); TRRD(l2, b_ + 8192); TRRD(h2, b_ + 10240); TRRD(l3, b_ + 12288); TRRD(h3, b_ + 14336); \
        asm volatile("s_waitcnt lgkmcnt(0)" ::: "memory"); SBAR();                 \
        o[d0] = __builtin_amdgcn_mfma_f32_32x32x16_bf16(pa0, (bf16x8){l0[0], l0[1], l0[2], l0[3], h0[0], h0[1], h0[2], h0[3]}, o[d0], 0, 0, 0);   \
        o[d0] = __builtin_amdgcn_mfma_f32_32x32x16_bf16(pa1, (bf16x8){l1[0], l1[1], l1[2], l1[3], h1[0], h1[1], h1[2], h1[3]}, o[d0], 0, 0, 0);   \
        o[d0] = __builtin_amdgcn_mfma_f32_32x32x16_bf16(pa2, (bf16x8){l2[0], l2[1], l2[2], l2[3], h2[0], h2[1], h2[2], h2[3]}, o[d0], 0, 0, 0);   \
        o[d0] = __builtin_amdgcn_mfma_f32_32x32x16_bf16(pa3, (bf16x8){l3[0], l3[1], l3[2], l3[3], h3[0], h3[1], h3[2], h3[3]}, o[d0], 0, 0, 0); } while (0)
    PV_D0(0); PV_D0(1); PV_D0(2); PV_D0(3);
#undef PV_D0
#undef TRRD
}
template <class TIn, class TOut> struct BlockRef { const TIn* Q; const TIn* K; const TIn* V; TOut* O; const unsigned* M; int P0; };
template <class TIn> struct Seam {
    bf16x8 qr[8];
    bf16x8 st_v0, st_v1, st_k0, st_k1; f32x4 sf0, sf1, sf2, sf3;
    f32x4 tq[16];
};
__device__ __forceinline__ int swa_jlo(int P0, int W) { const int lowk = P0 - W + 1; return lowk > 0 ? lowk / KVBLK : 0; }
#define ROW(p, k0, rr) ((p) + (size_t)((k0) + (rr)) * RSK + sc)
#define VMW() asm volatile("s_waitcnt vmcnt(0)" ::: "memory")
#define VMWN(n) asm volatile("s_waitcnt vmcnt(%0)" :: "i"(n) : "memory")
#define SLOAD_H(Kp, Vp, k0) do { S.st_v0 = load8<TIn>(ROW(Vp, k0, sr)); S.st_v1 = load8<TIn>(ROW(Vp, k0, 32 + sr));              \
                         S.st_k0 = load8<TIn>(ROW(Kp, k0, sr)); S.st_k1 = load8<TIn>(ROW(Kp, k0, 32 + sr)); } while (0)
#define SWRITE_HK(bf) do { *(bf16x8*)(K_lds + (bf) * SHM_K + kws) = S.st_k0; *(bf16x8*)(K_lds + (bf) * SHM_K + kws + 32 * 256) = S.st_k1; } while (0)
#define SWRITE_HV(bf) do { *(bf16x8*)(V_lds + (bf) * SHM_V + vst0) = S.st_v0; *(bf16x8*)(V_lds + (bf) * SHM_V + vst1) = S.st_v1; } while (0)
#define SWRITE_H(bf) do { SWRITE_HV(bf); SWRITE_HK(bf); } while (0)
#define SLOAD_F(p, k0) do { S.sf0 = *(const f32x4*)ROW(p, k0, sr); S.sf1 = *(const f32x4*)(ROW(p, k0, sr) + 4);                \
                            S.sf2 = *(const f32x4*)ROW(p, k0, 32 + sr); S.sf3 = *(const f32x4*)(ROW(p, k0, 32 + sr) + 4); } while (0)
#define SWRITE_KF(bf) do { *(bf16x8*)(K_lds + (bf) * SHM_K + kws) = pack8(S.sf0, S.sf1); *(bf16x8*)(K_lds + (bf) * SHM_K + kws + 32 * 256) = pack8(S.sf2, S.sf3); } while (0)
#define SWRITE_VF(bf) do { *(bf16x8*)(V_lds + (bf) * SHM_V + vst0) = pack8(S.sf0, S.sf1); *(bf16x8*)(V_lds + (bf) * SHM_V + vst1) = pack8(S.sf2, S.sf3); } while (0)
template <class TIn, class TOut, int RSQ, int RSK, int MK>
__device__ __forceinline__ void causal_swa_prime(const BlockRef<TIn, TOut>& cur, int W, char* lds, Seam<TIn>& S) {
    constexpr bool F32 = same_t<TIn, float>::v;
    int tid_o = threadIdx.x; asm volatile("" : "+v"(tid_o)); const int tid = tid_o, wid = __builtin_amdgcn_readfirstlane(tid >> 6), lane = tid & 63, r32 = lane & 31, hi = lane >> 5;
    const int sr = tid >> 4, sc = (tid & 15) * 8, kws = KSWZ(sr, sc * 2); char* K_lds = lds + 2 * SHM_V;
    const int kb0 = swa_jlo(cur.P0, W) * KVBLK;
    for (int d0 = 0; d0 < 8; ++d0) S.qr[d0] = load8<TIn>(cur.Q + (size_t)(wid * QBLK + r32) * RSQ + d0 * 16 + hi * 8);
    if constexpr (F32) { SLOAD_F((const float*)cur.K, kb0); VMW(); SWRITE_KF(0); SBAR(); SLOAD_F((const float*)cur.V, kb0); }
    else { SLOAD_H(cur.K, cur.V, kb0); VMW(); SWRITE_HK(0); }
    __syncthreads();
}
template <class TIn, class TOut, int RSQ, int RSK, int MK>
__device__ __forceinline__ void causal_swa_block(const BlockRef<TIn, TOut>& cur, const BlockRef<TIn, TOut>& nxt, int skv, int W, char* lds, Seam<TIn>& S) {
    constexpr bool F32 = same_t<TIn, float>::v;
    int tid_o = threadIdx.x; asm volatile("" : "+v"(tid_o)); const int tid = tid_o, wid = __builtin_amdgcn_readfirstlane(tid >> 6), lane = tid & 63, r32 = lane & 31, hi = lane >> 5;
    const int j_lo = swa_jlo(cur.P0, W);
    int j_hi = (cur.P0 + QB - 1) / KVBLK + 1; if (j_hi > skv / KVBLK) j_hi = skv / KVBLK;
    const int NT = j_hi - j_lo;
    const int kbn = swa_jlo(nxt.P0, W) * KVBLK;
    const int qlo = cur.P0 + wid * QBLK, qm = qlo + r32 - 4 * hi;
    const unsigned* mrow = (MK == 0) ? cur.M + (size_t)(wid * QBLK + r32) * 64 : nullptr; uint2 mw = make_uint2(0u, 0u); if constexpr (MK == 0) mw = *(const uint2*)(mrow + 2 * j_lo);
    char* V_lds = lds; char* K_lds = lds + 2 * SHM_V;
    float* ws = (float*)(lds + 2 * SHM_V + 2 * SHM_K) + wid * 64; float* li_l = ws, * al_l = ws + 32;
    float m_reg = -1e30f, l_reg = 0; f32x16 o[4] = {};
    const int sr = tid >> 4, sc = (tid & 15) * 8, vst0 = v_st(sr, sc), vst1 = v_st(32 + sr, sc), kws = KSWZ(sr, sc * 2);
    const int vb0 = (int)(uintptr_t)V_lds + v_rd_base(lane);
    const TIn* Kh = cur.K; const TIn* Vh = cur.V;
#define RESC(a) do { if (__any((a) < 1.f)) { if (hi == 0) al_l[r32] = (a); asm volatile("s_waitcnt lgkmcnt(0)" ::: "memory");              \
                     for (int d_ = 0; d_ < 4; ++d_) for (int r = 0; r < 16; ++r) o[d_][r] *= al_l[crow(r, hi)]; } } while (0)
#define KBASE(t) ((j_lo + (t)) * KVBLK)
#define ACT(t) (KBASE(t) <= qlo + QBLK - 1 && KBASE(t) + KVBLK - 1 >= qlo - W + 1)
#define MASKT(P0_, P1_, t) do { const int kb_ = KBASE(t); \
        if constexpr (MK == 1) { if (kb_ + KVBLK - 1 + 512 < qlo) mask_far(P0_, P1_, qm - kb_); else mask_mult(P0_, P1_, qm - kb_); } \
        else { mask_bits(P0_, P1_, mw.x >> (4 * hi), mw.y >> (4 * hi)); const int tn_ = ((t) + 1 < NT) ? (t) + 1 : (t); mw = *(const uint2*)(mrow + 2 * (j_lo + tn_)); } } while (0)
    constexpr int NQL = F32 ? 16 : 8;
    constexpr bool SK = WSKIP && !F32;
#define SEAM_K0() do { VMWN(NQL); if constexpr (F32) { SWRITE_KF(0); SBAR(); SLOAD_F((const float*)nxt.V, kbn); } else { SWRITE_HK(0); } SBAR(); } while (0)
    f32x16 pA0, pA1, pB0, pB1; float mnA, mnB, alA, alB; bf16x8 pa0, pa1, pa2, pa3;
    if constexpr (F32) { VMW(); SWRITE_VF(0); SBAR(); } else { SWRITE_HV(0); SBAR(); }
    if (NT > 1) { if constexpr (F32) SLOAD_F((const float*)Kh, KBASE(1)); else SLOAD_H(Kh, Vh, KBASE(1)); }
    SBAR(); qkt<0, SK>(pA0, pA1, K_lds, r32, hi, S.qr, ACT(0));
    if constexpr (F32) { if (NT > 1) { VMW(); SWRITE_KF(1); SBAR(); SLOAD_F((const float*)Vh, KBASE(1)); } }
    MASKT(pA0, pA1, 0); partialSM(pA0, pA1, m_reg, mnA, alA);
    if (NT > 1) { VMW(); if constexpr (F32) { SWRITE_VF(1); SBAR(); if (NT > 2) SLOAD_F((const float*)Kh, KBASE(2)); } else SWRITE_H(1); }
    __syncthreads();
#define HALF_STEP(PX0, PX1, mnX, alX, PY0, PY1, alY, t, KB, VB, SB) do {                                                      \
        SBAR(); qkt<KB, SK>(PX0, PX1, K_lds, r32, hi, S.qr, ACT(t));                                             \
        finishSM(PY0, PY1, alY, l_reg, pa0, pa1, pa2, pa3); SBAR();                                                           \
        if ((t) + 1 < NT) { if constexpr (F32) { VMW(); SWRITE_KF(SB); SBAR(); SLOAD_F((const float*)Vh, KBASE((t) + 1)); }  \
                            else { SLOAD_H(Kh, Vh, KBASE((t) + 1)); } SBAR(); }                                               \
        pv_tile<VB, SK>(o, vb0, pa0, pa1, pa2, pa3, ACT((t) - 1)); MASKT(PX0, PX1, (t)); partialSM(PX0, PX1, m_reg, mnX, alX);                                        \
        __syncthreads();                                                                                                      \
        if ((t) + 1 < NT) { VMW(); if constexpr (F32) { SWRITE_VF(SB); SBAR(); if ((t) + 2 < NT) SLOAD_F((const float*)Kh, KBASE((t) + 2)); } \
                            else { SWRITE_H(SB); } }                                                                          \
        RESC(alX); __syncthreads(); } while (0)
    for (int t = 1; t + 1 < NT; t += 2) {
        HALF_STEP(pB0, pB1, mnB, alB, pA0, pA1, alA, t, 1, 0, 0);
        HALF_STEP(pA0, pA1, mnA, alA, pB0, pB1, alB, t + 1, 0, 1, 1);
    }
    const bool even = (NT & 1) == 0;
    if (even) { SBAR(); qkt<1, SK>(pB0, pB1, K_lds, r32, hi, S.qr, ACT(NT - 1)); SBAR(); }
#define QROW(e) (nxt.Q + (size_t)(wid * QBLK + r32) * RSQ + ((e) >> 1) * 16 + hi * 8 + ((e) & 1) * 4)
    if constexpr (F32) { SLOAD_F((const float*)nxt.K, kbn); SBAR();
#pragma unroll
        for (int e = 0; e < 8; ++e) S.tq[e] = *(const f32x4*)QROW(e); }
    else { SLOAD_H(nxt.K, nxt.V, kbn); SBAR();
#pragma unroll
        for (int d0 = 0; d0 < 8; ++d0) S.qr[d0] = load8<TIn>(nxt.Q + (size_t)(wid * QBLK + r32) * RSQ + d0 * 16 + hi * 8); }
    SBAR();
    finishSM(pA0, pA1, alA, l_reg, pa0, pa1, pa2, pa3); SBAR();
    if constexpr (F32) {
#pragma unroll
        for (int e = 8; e < 16; ++e) S.tq[e] = *(const f32x4*)QROW(e); SBAR(); }
#undef QROW
    pv_tile<0, SK>(o, vb0, pa0, pa1, pa2, pa3, ACT(even ? NT - 2 : NT - 1));
    if (even) { MASKT(pB0, pB1, NT - 1); partialSM(pB0, pB1, m_reg, mnB, alB); __syncthreads(); RESC(alB);
        finishSM(pB0, pB1, alB, l_reg, pa0, pa1, pa2, pa3); SBAR(); pv_tile<1, SK>(o, vb0, pa0, pa1, pa2, pa3, ACT(NT - 1)); }
    SBAR(); SEAM_K0();
    if (hi == 0) li_l[r32] = l_reg; asm volatile("s_waitcnt lgkmcnt(0)" ::: "memory");
    float rli[16];
#pragma unroll
    for (int r = 0; r < 16; ++r) rli[r] = __builtin_amdgcn_rcpf(li_l[crow(r, hi)]);
    TOut* Ow = cur.O + (size_t)(wid * QBLK) * RSQ;
#pragma unroll
    for (int r = 0; r < 16; ++r) { const int orow = crow(r, hi);
#pragma unroll
        for (int d0 = 0; d0 < 4; ++d0) { const float v = o[d0][r] * rli[r];
            if constexpr (same_t<TOut, float>::v) { Ow[(size_t)orow * RSQ + d0 * 32 + r32] = v; }
            else { const float vn = __int_as_float(__builtin_amdgcn_ds_swizzle(__float_as_int(v), (1 << 10) | 0x1f));
                   if ((r32 & 1) == 0) *(unsigned*)(Ow + (size_t)orow * RSQ + d0 * 32 + r32) = cvtpk(v, vn); } } }
    if constexpr (F32) {
#pragma unroll
        for (int d0 = 0; d0 < 8; ++d0) S.qr[d0] = pack8(S.tq[2 * d0], S.tq[2 * d0 + 1]); }
    __syncthreads();
#undef RESC
#undef KBASE
#undef ACT
#undef MASKT
#undef SEAM_K0
#undef HALF_STEP
}
#undef ROW
#undef VMW
#undef VMWN
#undef SLOAD_H
#undef SWRITE_HK
#undef SWRITE_HV
#undef SWRITE_H
#undef SLOAD_F
#undef SWRITE_KF
#undef SWRITE_VF
}

__device__ __forceinline__ unsigned fkey(float f) { const unsigned u = __float_as_uint(f + 0.0f); return (u & 0x80000000u) ? ~u : (u | 0x80000000u); }

__device__ __forceinline__ void naive_index_topk(Frame& F) {
    PHASE_IDS();
    const bf16* P = F.P; constexpr int ldp = n1pad(0);
    LAS float* iq = (LAS float*)F.lds; LAS float* iw = iq + 1024; LAS float* sc = iw + 16; LAS unsigned* mw = (LAS unsigned*)(sc + 2048); LAS unsigned* cnt = mw + 64;
    for (int row = blockIdx.x; row < MTOK; row += F.G) {
        const int t = row & (SEQ - 1), rb = row - t;
        for (int i = tid; i < 1024; i += 512) iq[i] = bf2f(P[(size_t)row * ldp + A_IQ + i]);
        if (tid < 16) iw[tid] = bf2f(P[(size_t)row * ldp + A_IW + tid]) * (1.f / 32.f);
        if (tid < 64) mw[tid] = 0u;
        __syncthreads();
        for (int s = tid; s <= t; s += 512) {
            const uint4* kp = (const uint4*)(P + (size_t)(rb + s) * ldp + A_IK);
            float kk[64];
#pragma unroll
            for (int c = 0; c < 8; ++c) { const uint4 r = kp[c]; const unsigned w[4] = {r.x, r.y, r.z, r.w};
#pragma unroll
                for (int j = 0; j < 4; ++j) { kk[c * 8 + 2 * j] = __uint_as_float(w[j] << 16); kk[c * 8 + 2 * j + 1] = __uint_as_float(w[j] & 0xffff0000u); } }
            float score = 0.f;
            for (int h = 0; h < 16; ++h) { float d = 0.f;
#pragma unroll
                for (int j = 0; j < 64; ++j) d = fmaf(iq[h * 64 + j], kk[j], d);
                score += fmaxf(d, 0.f) * iw[h]; }
            sc[s] = score;
        }
        __syncthreads();
        if (t + 1 <= 256) { for (int s = tid; s <= t; s += 512) atomicOr((unsigned*)&mw[s >> 5], 1u << (s & 31)); }
        else {
            unsigned myk[4];
#pragma unroll
            for (int j = 0; j < 4; ++j) { const int s = tid + 512 * j; myk[j] = (s <= t) ? fkey(sc[s]) : 0u; }
            unsigned prefix = 0u;
            for (int bit = 31; bit >= 0; --bit) {
                const unsigned cand = prefix | (1u << bit); unsigned c = 0;
#pragma unroll
                for (int j = 0; j < 4; ++j) c += (myk[j] >= cand) ? 1u : 0u;
                if (tid == 0) *cnt = 0u;
                __syncthreads(); if (c) atomicAdd((unsigned*)cnt, c); __syncthreads();
                const unsigned total = *cnt; __syncthreads();
                if (total >= 256u) prefix = cand;
            }
            unsigned cg = 0, ce = 0;
#pragma unroll
            for (int j = 0; j < 4; ++j) { cg += (myk[j] > prefix) ? 1u : 0u; ce += (myk[j] == prefix) ? 1u : 0u; }
            if (tid == 0) *cnt = 0u;
            __syncthreads(); atomicAdd((unsigned*)cnt, cg | (ce << 16)); __syncthreads();
            const unsigned tot = *cnt; const int n_gt = (int)(tot & 0xffffu), n_eq = (int)(tot >> 16); const int need = 256 - n_gt;
#pragma unroll
            for (int j = 0; j < 4; ++j) { const int s = tid + 512 * j; if (myk[j] > prefix || (myk[j] == prefix && n_eq == need)) atomicOr((unsigned*)&mw[s >> 5], 1u << (s & 31)); }
            if (n_eq != need && tid == 0) { int left = need; for (int s = 0; s <= t && left > 0; ++s) if (fkey(sc[s]) == prefix) { atomicOr((unsigned*)&mw[s >> 5], 1u << (s & 31)); --left; } }
        }
        __syncthreads();
        if (tid < 64) F.mask[(size_t)row * 64 + tid] = mw[tid];
        __syncthreads();
    }
}

template <int MODE> __device__ __forceinline__ void naive_attn(Frame& F, int ldp, int koff, int voff, int kvhs) {
    PHASE_IDS();
    bf16* P = F.P; const int wv = wave;
    LAS int* keys = (LAS int*)F.lds; LAS float* qs = (LAS float*)(keys + 400); LAS float* sc = qs + 2048; LAS float* linv = sc + 16 * 400; LAS int* pre = (LAS int*)(linv + 16); LAS int* nk_s = pre + 64;
    for (int row = blockIdx.x; row < MTOK; row += F.G) {
        const int t = row & (SEQ - 1), rb = row - t;
        for (int i = tid; i < 2048; i += 512) qs[i] = bf2f(P[(size_t)row * ldp + i]);
        if (MODE == 0) {
            unsigned w = 0; if (tid < 64) { w = F.mask[(size_t)row * 64 + tid]; pre[tid] = __popc(w); }
            __syncthreads();
            if (tid == 0) { int run = 0; for (int i = 0; i < 64; ++i) { const int x = pre[i]; pre[i] = run; run += x; } *nk_s = run; }
            __syncthreads();
            if (tid < 64) { int pos = pre[tid]; while (w) { const int b = __ffs(w) - 1; keys[pos++] = tid * 32 + b; w &= w - 1; } }
        } else {
            if (tid < 387) { const int cfg = tid / 129, j = tid % 129, dil = cfg == 0 ? 1 : (cfg == 1 ? 4 : 16); const int s = t - j * dil; keys[tid] = s >= 0 ? s : -1; }
            if (tid == 0) *nk_s = 387;
        }
        __syncthreads();
        const int nk = *nk_s;
        if (tid < nk) {
            const int e = tid, s = keys[e];
#pragma unroll 1
            for (int h = 0; h < 16; ++h) {
                float d = -__builtin_inff();
                if (s >= 0) { const uint4* kp = (const uint4*)(P + (size_t)(rb + s) * ldp + koff + h * kvhs); d = 0.f;
#pragma unroll
                    for (int c = 0; c < 16; ++c) { const uint4 r = kp[c]; const unsigned w[4] = {r.x, r.y, r.z, r.w}; const LAS float* qp = qs + h * 128 + c * 8;
#pragma unroll
                        for (int j = 0; j < 4; ++j) { d = fmaf(qp[2 * j], __uint_as_float(w[j] << 16), d); d = fmaf(qp[2 * j + 1], __uint_as_float(w[j] & 0xffff0000u), d); } }
                    d *= QK_SCALE; }
                sc[h * 400 + e] = d;
            }
        }
        __syncthreads();
        for (int hh = 0; hh < 2; ++hh) { const int h = wv * 2 + hh; float m = -__builtin_inff();
            for (int e = lane; e < nk; e += 64) m = fmaxf(m, sc[h * 400 + e]);
            m = wave_max(m); float sum = 0.f;
            for (int e = lane; e < nk; e += 64) { const float p = __expf(sc[h * 400 + e] - m); sc[h * 400 + e] = p; sum += p; }
            sum = wave_sum(sum); if (lane == 0) linv[h] = 1.f / sum; }
        __syncthreads();
        const int d = tid & 127, hg = tid >> 7; float acc[4] = {0.f, 0.f, 0.f, 0.f};
        for (int e = 0; e < nk; ++e) { const int s = keys[e]; if (s < 0) continue; const bf16* vp = P + (size_t)(rb + s) * ldp + voff + d;
#pragma unroll
            for (int j = 0; j < 4; ++j) { const int h = hg * 4 + j; acc[j] = fmaf(sc[h * 400 + e], bf2f(vp[h * kvhs]), acc[j]); } }
#pragma unroll
        for (int j = 0; j < 4; ++j) { const int h = hg * 4 + j; P[(size_t)row * ldp + h * 128 + d] = f2bf(acc[j] * linv[h]); }
        __syncthreads();
    }
}

__device__ __forceinline__ void naive_ret(Frame& F) {
    if (blockIdx.x >= 32) return;
    bf16* P = F.P; constexpr int ldp = n1pad(2);
    int tid_o_ = threadIdx.x; asm volatile("" : "+v"(tid_o_));
    const int grp = tid_o_ >> 8, tid = tid_o_ & 255, lane = tid & 63, wv = tid >> 6, item = blockIdx.x * 2 + grp, bl = item >> 3, h = item & 7;
    const float gamma = 1.f - exp2f(-5.f - (float)h);
    LAS float* base = (LAS float*)(F.lds + grp * 40960);
    LAS float* qs = base; LAS float* ks = qs + 16 * 128; LAS float* ob = ks + 16 * 128; LAS float* sq = ob + 16 * 256;
    float S[128];
#pragma unroll
    for (int i = 0; i < 128; ++i) S[i] = 0.f;
    for (int t0 = 0; t0 < SEQ; t0 += 16) {
        const size_t row0 = (size_t)bl * SEQ + t0;
        for (int i = tid; i < 16 * 128; i += 256) { const int tt = i >> 7, c = i & 127; const bf16* pr = P + (row0 + tt) * ldp + h * 128 + c; qs[i] = bf2f(pr[0]); ks[i] = bf2f(pr[1024]); }
        __syncthreads();
#pragma unroll 1
        for (int tt = 0; tt < 16; ++tt) {
            const float v = bf2f(P[(row0 + tt) * ldp + 2048 + h * 256 + tid]); float o = 0.f;
#pragma unroll
            for (int i = 0; i < 128; i += 4) { const pg8::f32x4 k4 = *(const LAS pg8::f32x4*)&ks[tt * 128 + i], q4 = *(const LAS pg8::f32x4*)&qs[tt * 128 + i];
                S[i] = fmaf(gamma, S[i], k4.x * v); o = fmaf(q4.x, S[i], o); S[i + 1] = fmaf(gamma, S[i + 1], k4.y * v); o = fmaf(q4.y, S[i + 1], o);
                S[i + 2] = fmaf(gamma, S[i + 2], k4.z * v); o = fmaf(q4.z, S[i + 2], o); S[i + 3] = fmaf(gamma, S[i + 3], k4.w * v); o = fmaf(q4.w, S[i + 3], o); }
            ob[tt * 256 + tid] = o;
        }
        __syncthreads();
        for (int j = 0; j < 4; ++j) { const int tt = wv * 4 + j; float s = 0.f; for (int c = lane; c < 256; c += 64) s += ob[tt * 256 + c] * ob[tt * 256 + c]; s = wave_sum(s);
            if (lane < 8) F.ssq[((row0 + tt) * 8 + h) * 8 + lane] = lane == 0 ? s : 0.f; }
        for (int tt = 0; tt < 16; ++tt) P[(row0 + tt) * ldp + 2048 + h * 256 + tid] = f2bf(ob[tt * 256 + tid]);
        __syncthreads();
    }
}

__device__ __forceinline__ void naive_hgrn(Frame& F) {
    if (blockIdx.x >= 32) return;
    bf16* P = F.P; constexpr int ldp = n1pad(3);
    int tid_o_ = threadIdx.x; asm volatile("" : "+v"(tid_o_));
    const int grp = tid_o_ >> 7, tid = tid_o_ & 127, lane = tid & 63, wv = tid >> 6, item = blockIdx.x * 4 + grp, bl = item >> 4, h = item & 15;
    LAS float* base = (LAS float*)(F.lds + grp * 28672);
    LAS float* qs = base; LAS float* gs = qs + 16 * 128; LAS float* ob = gs + 16 * 128;
    float S[128];
#pragma unroll
    for (int i = 0; i < 128; ++i) S[i] = 0.f;
    for (int t0 = 0; t0 < SEQ; t0 += 16) {
        const size_t row0 = (size_t)bl * SEQ + t0;
        for (int tt = 0; tt < 16; ++tt) { const bf16* pr = P + (row0 + tt) * ldp + h * 128 + tid;
            qs[tt * 128 + tid] = bf2f(pr[0]); gs[tt * 128 + tid] = __expf(bf2f(pr[2048])); }
        __syncthreads();
#pragma unroll 1
        for (int tt = 0; tt < 16; ++tt) {
            const float v = bf2f(P[(row0 + tt) * ldp + 4096 + h * 128 + tid]); float o = 0.f;
#pragma unroll
            for (int i = 0; i < 128; i += 4) { const pg8::f32x4 g4 = *(const LAS pg8::f32x4*)&gs[tt * 128 + i], q4 = *(const LAS pg8::f32x4*)&qs[tt * 128 + i];
                S[i] = fmaf(g4.x, S[i] - v, v); o = fmaf(q4.x, S[i], o); S[i + 1] = fmaf(g4.y, S[i + 1] - v, v); o = fmaf(q4.y, S[i + 1], o);
                S[i + 2] = fmaf(g4.z, S[i + 2] - v, v); o = fmaf(q4.z, S[i + 2], o); S[i + 3] = fmaf(g4.w, S[i + 3] - v, v); o = fmaf(q4.w, S[i + 3], o); }
            ob[tt * 128 + tid] = o;
        }
        __syncthreads();
        for (int j = 0; j < 8; ++j) { const int tt = wv * 8 + j; float s = ob[tt * 128 + lane] * ob[tt * 128 + lane] + ob[tt * 128 + lane + 64] * ob[tt * 128 + lane + 64]; s = wave_sum(s);
            if (lane < 4) F.ssq[((row0 + tt) * 16 + h) * 4 + lane] = lane == 0 ? s : 0.f; }
        for (int tt = 0; tt < 16; ++tt) P[(row0 + tt) * ldp + 4096 + h * 128 + tid] = f2bf(ob[tt * 128 + tid]);
        __syncthreads();
    }
}

typedef short ix_bf16x8 __attribute__((ext_vector_type(8)));
typedef float ix_f32x16 __attribute__((ext_vector_type(16)));
__device__ __forceinline__ int half_sum(int v) {
    v += swz_xor_i<1>(v); v += swz_xor_i<2>(v); v += swz_xor_i<4>(v); v += swz_xor_i<8>(v); v += swz_xor_i<16>(v);
    return v;
}
__device__ __forceinline__ void index_topk_phase(Frame& F) {
    PHASE_IDS();
    const bf16* P = F.P; constexpr int ldp = n1pad(0), ROWB = 144, BUFB = 256 * ROWB;
    const int c = lane & 31, hi = lane >> 5;
#pragma unroll 1
    for (int uu = 0; uu < 4; ++uu) {
        const int unit = (uu & 1) ? (1023 - (uu >> 1) * 256 - (int)blockIdx.x) : ((uu >> 1) * 256 + (int)blockIdx.x);
        const int row0 = unit * 16, rb = row0 & ~(SEQ - 1), tu = row0 & (SEQ - 1);
        const int t0 = tu + 2 * wave, tq = t0 + hi;
        const int nchunk = (tu + 15) / 256 + 1, jmax = (t0 + 1) >> 5;
        ix_bf16x8 afr[4];
        { const bf16* ap = P + (size_t)(row0 + 2 * wave + (c >> 4)) * ldp + A_IQ + (c & 15) * 64 + 8 * hi;
#pragma unroll
          for (int s = 0; s < 4; ++s) afr[s] = *(const ix_bf16x8*)(ap + 16 * s); }
        float w0[8], w1[8];
        { const bf16* wp = P + (size_t)(row0 + 2 * wave) * ldp + A_IW;
#pragma unroll
          for (int j = 0; j < 8; ++j) { const int hd = (j & 3) + 8 * (j >> 2) + 4 * hi; w0[j] = bf2f(wp[hd]) * (1.f / 32.f); w1[j] = bf2f(wp[ldp + hd]) * (1.f / 32.f); } }
        unsigned uk[64];
#pragma unroll
        for (int j = 0; j < 64; ++j) uk[j] = 0u;
        pg8::u32x4 st[4];
        { const bf16* gp = P + (size_t)rb * ldp + A_IK;
#pragma unroll
          for (int i = 0; i < 4; ++i) { const int p = tid + 512 * i; st[i] = *(const pg8::u32x4*)(gp + (size_t)(p >> 3) * ldp + (p & 7) * 8); }
#pragma unroll
          for (int i = 0; i < 4; ++i) { const int p = tid + 512 * i; *(LAS pg8::u32x4*)(F.lds + (p >> 3) * ROWB + (p & 7) * 16) = st[i]; } }
        __syncthreads();
#pragma unroll
        for (int ch = 0; ch < 8; ++ch) {
            if (ch < nchunk) {
                const bool more = ch + 1 < nchunk;
                if (more) { const bf16* gp = P + (size_t)(rb + 256 * (ch + 1)) * ldp + A_IK;
#pragma unroll
                    for (int i = 0; i < 4; ++i) { const int p = tid + 512 * i; st[i] = *(const pg8::u32x4*)(gp + (size_t)(p >> 3) * ldp + (p & 7) * 8); } }
                const LAS unsigned char* buf = F.lds + (ch & 1) * BUFB + c * ROWB + 16 * hi;
#pragma unroll
                for (int jj = 0; jj < 8; ++jj) {
                    const int j = 8 * ch + jj;
                    if (j <= jmax) {
                        ix_f32x16 acc = {};
#pragma unroll
                        for (int s = 0; s < 4; ++s) { const ix_bf16x8 bfr = *(const LAS ix_bf16x8*)(buf + jj * 32 * ROWB + 32 * s); acc = __builtin_amdgcn_mfma_f32_32x32x16_bf16(afr[s], bfr, acc, 0, 0, 0); }
                        float s0 = 0.f, s1 = 0.f;
#pragma unroll
                        for (int x = 0; x < 8; ++x) { s0 = fmaf(fmaxf(acc[x], 0.f), w0[x], s0); s1 = fmaf(fmaxf(acc[8 + x], 0.f), w1[x], s1); }
                        const auto rr = __builtin_amdgcn_permlane32_swap(__float_as_uint(s0), __float_as_uint(s1), false, false);
                        const float tot = __uint_as_float(rr[0]) + __uint_as_float(rr[1]);
                        uk[j] = (32 * j + c <= tq) ? fkey(tot) : 0u;
                    }
                }
                if (more) {
#pragma unroll
                    for (int i = 0; i < 4; ++i) { const int p = tid + 512 * i; *(LAS pg8::u32x4*)(F.lds + ((ch + 1) & 1) * BUFB + (p >> 3) * ROWB + (p & 7) * 16) = st[i]; } }
                __syncthreads();
            }
        }
        unsigned thr = 0u;
        if (t0 >= 256) {
#pragma unroll 1
            for (int bit = 31; bit >= 0; --bit) {
                const unsigned cand = thr | (1u << bit); int cnt = 0;
#pragma unroll
                for (int g = 0; g < 8; ++g) if (8 * g <= jmax) {
#pragma unroll
                    for (int x = 0; x < 8; ++x) cnt += (uk[8 * g + x] >= cand) ? 1 : 0; }
                if (half_sum(cnt) >= 256) thr = cand;
            }
        }
        int ngt = 0, neq = 0;
#pragma unroll
        for (int j = 0; j < 64; ++j) { ngt += (uk[j] > thr) ? 1 : 0; neq += (uk[j] == thr) ? 1 : 0; }
        ngt = half_sum(ngt); neq = half_sum(neq);
        const int need = 256 - ngt; const bool ties = (thr != 0u) && (neq != need);
        unsigned long long okm = ~0ull;
        if (__any(ties)) { okm = 0ull; int run = 0;
#pragma unroll
            for (int j = 0; j < 64; ++j) { const unsigned long long m = __ballot(uk[j] == thr); const unsigned mh = hi ? (unsigned)(m >> 32) : (unsigned)m;
                const int below = __popc(mh & ((1u << c) - 1u)); if (!ties || run + below < need) okm |= 1ull << j; run += __popc(mh); } }
        unsigned mw0 = 0u, mw1 = 0u;
#pragma unroll
        for (int j = 0; j < 64; ++j) { const bool sel = (uk[j] > thr) || (thr != 0u && uk[j] == thr && ((okm >> j) & 1ull));
            const unsigned long long m = __ballot(sel);
            mw0 = (lane == j) ? (unsigned)m : mw0; mw1 = (lane == j) ? (unsigned)(m >> 32) : mw1; }
        unsigned* mp = F.mask + (size_t)(row0 + 2 * wave) * 64 + lane;
        mp[0] = mw0; mp[64] = mw1;
    }
}

struct AttItem { int bh, qb0, qb1; };
__device__ __forceinline__ AttItem att_decode(int Lc, int Gq  ) {
    AttItem it; const int xcd = Lc & 7, k = Lc >> 3, per = Gq * 4, gi = k / per, r = k - gi * per;
    it.bh = (gi * 8 + xcd) * Gq + r / 4; const int x = r & 3; it.qb0 = x; it.qb1 = 7 - x; return it;
}
template <int L> __device__ __forceinline__ att::BlockRef<bf16, bf16> att_ref(const AttItem& it, int pass, bf16* P, const unsigned* mask) {
    constexpr int LDP = n1pad(L), KOFF = (L == 0) ? A_K : 2048, VOFF = (L == 0) ? A_V : 4096, KVHS = (L == 0) ? 0 : 128;
    const int qb = pass ? it.qb1 : it.qb0, b = it.bh >> 4, h = it.bh & 15;
    att::BlockRef<bf16, bf16> r;
    r.Q = P + (size_t)(b * SEQ + qb * 256) * LDP + h * 128; r.O = P + (size_t)(b * SEQ + qb * 256) * LDP + h * 128;
    r.K = P + (size_t)(b * SEQ) * LDP + KOFF + h * KVHS; r.V = P + (size_t)(b * SEQ) * LDP + VOFF + h * KVHS;
    r.M = mask + (size_t)(b * SEQ + qb * 256) * 64; r.P0 = qb * 256;
    return r;
}
template <int L> __device__ __forceinline__ void attn_phase(bf16* P, const unsigned* mask, char* lds, int G) {
    constexpr int LDP = n1pad(L), MK = (L == 0) ? 0 : 1, GQ = (L == 0) ? 16 : 1, TOTAL = 512, W = 1 << 28;
    int Lc = blockIdx.x; if (Lc >= TOTAL) return;
    AttItem it = att_decode(Lc, GQ); int pass = 0;
    att::BlockRef<bf16, bf16> cur = att_ref<L>(it, 0, P, mask);
    att::Seam<bf16> S;
    att::causal_swa_prime<bf16, bf16, LDP, LDP, MK>(cur, W, lds, S);
    for (;;) {
        const bool more_pass = pass == 0, more_item = Lc + G < TOTAL, last = !more_pass && !more_item;
        AttItem itn = it; int passn = pass + 1, Ln = Lc;
        if (!more_pass) { passn = 0; Ln = more_item ? Lc + G : Lc; itn = att_decode(Ln, GQ); }
        const att::BlockRef<bf16, bf16> nxt = last ? cur : att_ref<L>(itn, passn, P, mask);
        att::causal_swa_block<bf16, bf16, LDP, LDP, MK>(cur, nxt, SEQ, W, lds, S);
        if (last) break;
        cur = nxt; it = itn; pass = passn; Lc = Ln;
    }
}

namespace ret {
typedef short bf16x8 __attribute__((ext_vector_type(8)));
typedef short s16x4 __attribute__((ext_vector_type(4)));
typedef float f32x16 __attribute__((ext_vector_type(16)));
__device__ __forceinline__ unsigned off_b(unsigned row, unsigned ch) { return 256u * row + 16u * (ch ^ ((row & 3) << 2)); }
__device__ __forceinline__ unsigned img_off(unsigned row, unsigned ch) { return 8192u * (row >> 5) + off_b(row & 31, ch); }
__device__ __forceinline__ unsigned addr_row(unsigned lane, unsigned rblk, unsigned s) { return 8192u * rblk + off_b(lane & 31, 2 * s + (lane >> 5)); }
__device__ __forceinline__ unsigned addr_tr(unsigned lane, unsigned row4, unsigned c) {
    const unsigned blk = (lane >> 4) & 1, q = (lane & 15) >> 2, p = lane & 3;
    return img_off(row4 + q, 4 * c + 2 * blk + (p >> 1)) + 8 * (p & 1);
}
__device__ __forceinline__ s16x4 tr_read(unsigned a) { s16x4 r; asm volatile("ds_read_b64_tr_b16 %0, %1" : "=&v"(r) : "v"(a) : "memory"); return r; }
__device__ __forceinline__ bf16x8 cat8(s16x4 lo, s16x4 hi) { return (bf16x8){lo[0], lo[1], lo[2], lo[3], hi[0], hi[1], hi[2], hi[3]}; }
__device__ __forceinline__ unsigned cvtpk(float lo, float hi) { unsigned r; asm volatile("v_cvt_pk_bf16_f32 %0, %1, %2" : "=v"(r) : "v"(lo), "v"(hi)); return r; }
__device__ __forceinline__ bf16x8 pack_acc8(const f32x16& a, int s) {
    pg8::u32x4 w = {cvtpk(a[8 * s + 0], a[8 * s + 1]), cvtpk(a[8 * s + 2], a[8 * s + 3]), cvtpk(a[8 * s + 4], a[8 * s + 5]), cvtpk(a[8 * s + 6], a[8 * s + 7])};
    return *reinterpret_cast<bf16x8*>(&w);
}
#define RET_LGKM0() do { asm volatile("s_waitcnt lgkmcnt(0)" ::: "memory"); __builtin_amdgcn_sched_barrier(0); } while (0)
constexpr int OFF_Q = 0, OFF_K = 32768, OFF_V = 65536, OFF_S = 98304;
}

__device__ __forceinline__ void ret_phase(Frame& F) {
    using namespace ret;
    PHASE_IDS();
    bf16* P = F.P; constexpr int ldp = n1pad(2);
    const int xcd = blockIdx.x & 7, kk = blockIdx.x >> 3, bh = xcd * 8 + (kk >> 2), dvq = kk & 3, b = bh >> 3, h = bh & 7;
    const int ib = (wave < 4) ? wave : 7 - wave, dh = wave >> 2;
    const int dkb = wave & 3, dvb = wave >> 2;
    const int c = lane & 31, hi = lane >> 5;
    const float lg = log2f(1.f - exp2f(-5.f - (float)h));
    const float g128 = exp2f(128.f * lg), g127 = exp2f(127.f * lg), g1 = exp2f(lg);
    const unsigned lbase = (unsigned)(size_t)F.lds_gen;
    const size_t rowg0 = (size_t)b * SEQ;
    const bf16* qg = P + rowg0 * ldp + h * 128; const bf16* vg = P + rowg0 * ldp + 2048 + h * 256 + dvq * 64;
    for (int i = tid; i < 32768 / 16; i += 512) *(LAS pg8::u32x4*)(F.lds + OFF_S + i * 16) = (pg8::u32x4){0u, 0u, 0u, 0u};
    f32x16 st = {};
    pg8::u32x4 rq[4], rk[4], rv[2];
#define RET_LOAD(n) do { const size_t r0_ = (size_t)(n) * 128; \
        _Pragma("unroll") for (int i = 0; i < 4; ++i) { const int p = tid + 512 * i; const bf16* g_ = qg + (r0_ + (p >> 4)) * ldp + (p & 15) * 8; rq[i] = *(const pg8::u32x4*)g_; rk[i] = *(const pg8::u32x4*)(g_ + 1024); } \
        _Pragma("unroll") for (int i = 0; i < 2; ++i) { const int p = tid + 512 * i; rv[i] = *(const pg8::u32x4*)(vg + (r0_ + (p >> 3)) * ldp + (p & 7) * 8); } } while (0)
#define RET_SCALE8(r, f) do { float x_[8]; x_[0] = __uint_as_float(r.x << 16); x_[1] = __uint_as_float(r.x & 0xffff0000u); x_[2] = __uint_as_float(r.y << 16); x_[3] = __uint_as_float(r.y & 0xffff0000u); \
        x_[4] = __uint_as_float(r.z << 16); x_[5] = __uint_as_float(r.z & 0xffff0000u); x_[6] = __uint_as_float(r.w << 16); x_[7] = __uint_as_float(r.w & 0xffff0000u); \
        r.x = cvtpk(x_[0] * (f), x_[1] * (f)); r.y = cvtpk(x_[2] * (f), x_[3] * (f)); r.z = cvtpk(x_[4] * (f), x_[5] * (f)); r.w = cvtpk(x_[6] * (f), x_[7] * (f)); } while (0)
#define RET_WRITE() do { \
        _Pragma("unroll") for (int i = 0; i < 4; ++i) { const int p = tid + 512 * i, row = p >> 4; const float fq = exp2f((float)row * lg), fk = exp2f(-(float)row * lg); \
            RET_SCALE8(rq[i], fq); RET_SCALE8(rk[i], fk); const unsigned o_ = img_off(row, p & 15); *(LAS pg8::u32x4*)(F.lds + OFF_Q + o_) = rq[i]; *(LAS pg8::u32x4*)(F.lds + OFF_K + o_) = rk[i]; } \
        _Pragma("unroll") for (int i = 0; i < 2; ++i) { const int p = tid + 512 * i; *(LAS pg8::u32x4*)(F.lds + OFF_V + img_off(p >> 3, p & 7)) = rv[i]; } } while (0)
    RET_LOAD(0); RET_WRITE();
    __syncthreads();
#pragma unroll 1
    for (int n = 0; n < 16; ++n) {
        if (n + 1 < 16) RET_LOAD(n + 1);
        f32x16 o = {};
#pragma unroll
        for (int s = 0; s < 8; ++s) {
            const bf16x8 a = *(const LAS bf16x8*)(F.lds + OFF_Q + addr_row(lane, ib, s));
            const s16x4 b0 = tr_read(lbase + OFF_S + addr_tr(lane, 16 * s + 8 * hi, dh)), b1 = tr_read(lbase + OFF_S + addr_tr(lane, 16 * s + 8 * hi + 4, dh));
            RET_LGKM0();
            o = __builtin_amdgcn_mfma_f32_32x32x16_bf16(a, cat8(b0, b1), o, 0, 0, 0);
        }
#pragma unroll
        for (int jb = 0; jb < 4; ++jb) {
            if (jb <= ib) {
                f32x16 sacc = {};
#pragma unroll
                for (int s = 0; s < 8; ++s) {
                    const bf16x8 a = *(const LAS bf16x8*)(F.lds + OFF_K + addr_row(lane, jb, s)), bq = *(const LAS bf16x8*)(F.lds + OFF_Q + addr_row(lane, ib, s));
                    sacc = __builtin_amdgcn_mfma_f32_32x32x16_bf16(a, bq, sacc, 0, 0, 0);
                }
                if (jb == ib) {
#pragma unroll
                    for (int r = 0; r < 16; ++r) { const int jl = (r & 3) + 8 * (r >> 2) + 4 * hi; if (jl > c) sacc[r] = 0.f; }
                }
#pragma unroll
                for (int s = 0; s < 2; ++s) {
                    const bf16x8 pa = pack_acc8(sacc, s);
                    const s16x4 b0 = tr_read(lbase + OFF_V + addr_tr(lane, 32 * jb + 16 * s + 4 * hi, dh)), b1 = tr_read(lbase + OFF_V + addr_tr(lane, 32 * jb + 16 * s + 8 + 4 * hi, dh));
                    RET_LGKM0();
                    o = __builtin_amdgcn_mfma_f32_32x32x16_bf16(pa, cat8(b0, b1), o, 0, 0, 0);
                }
            }
        }
        f32x16 xs = {};
#pragma unroll
        for (int s = 0; s < 8; ++s) {
            const s16x4 a0 = tr_read(lbase + OFF_K + addr_tr(lane, 16 * s + 8 * hi, dkb)), a1 = tr_read(lbase + OFF_K + addr_tr(lane, 16 * s + 8 * hi + 4, dkb));
            const s16x4 b0 = tr_read(lbase + OFF_V + addr_tr(lane, 16 * s + 8 * hi, dvb)), b1 = tr_read(lbase + OFF_V + addr_tr(lane, 16 * s + 8 * hi + 4, dvb));
            RET_LGKM0();
            xs = __builtin_amdgcn_mfma_f32_32x32x16_bf16(cat8(a0, a1), cat8(b0, b1), xs, 0, 0, 0);
        }
#pragma unroll
        for (int r = 0; r < 16; ++r) st[r] = g128 * st[r] + g127 * xs[r];
        {
            const size_t rowb = rowg0 + (size_t)n * 128 + ib * 32;
#pragma unroll
            for (int r = 0; r < 16; ++r) {
                const int il = (r & 3) + 8 * (r >> 2) + 4 * hi; const float v = o[r];
                float q = v * v; q += swz_xor<1>(q); q += swz_xor<2>(q); q += swz_xor<4>(q); q += swz_xor<8>(q); q += swz_xor<16>(q);
                if (c == 0) F.ssq[((rowb + il) * 8 + h) * 8 + dvq * 2 + dh] = q;
                const float vn = swz_xor<1>(v);
                if ((c & 1) == 0) *(unsigned*)(P + (rowb + il) * ldp + 2048 + h * 256 + dvq * 64 + dh * 32 + c) = cvtpk(v, vn);
            }
        }
        __syncthreads();
#pragma unroll
        for (int r = 0; r < 16; ++r) { const int dk = 32 * dkb + (r & 3) + 8 * (r >> 2) + 4 * hi, dv = 32 * dvb + c;
            *(LAS bf16*)(F.lds + OFF_S + img_off(dk, dv >> 3) + (dv & 7) * 2) = f2bf(g1 * st[r]); }
        if (n + 1 < 16) RET_WRITE();
        __syncthreads();
    }
#undef RET_LOAD
#undef RET_SCALE8
#undef RET_WRITE
}

namespace hg {
constexpr int OFF_Q = 0, OFF_K = 16384, OFF_V = 32768, OFF_S = 49152, OFF_T = 81920;
}
__device__ __forceinline__ void hgrn_phase(Frame& F) {
    using namespace ret;
    PHASE_IDS();
    bf16* P = F.P; constexpr int ldp = n1pad(3);
    const int xcd = blockIdx.x & 7, kk = blockIdx.x >> 3, bh = xcd * 16 + (kk >> 1), dvh = kk & 1, b = bh >> 4, h = bh & 15;
    const int c = lane & 31, hi = lane >> 5;
    const unsigned lbase = (unsigned)(size_t)F.lds_gen;
    const size_t rowg0 = (size_t)b * SEQ;
    const int ch = tid & 127, seg = tid >> 7;
    const bf16* qg = P + rowg0 * ldp + h * 128 + ch;
    const bf16* vg = P + rowg0 * ldp + 4096 + h * 128 + dvh * 64;
    LAS float* segt = (LAS float*)(F.lds + hg::OFF_T); LAS float* esr = segt + 512; LAS float* ebl = esr + 128; LAS float* ebr = ebl + 128;
    f32x16 st0 = {}, st1 = {};
    unsigned short rq[16], rf[16]; pg8::u32x4 rv;
#define HG_LOAD(n) do { const size_t r0_ = (size_t)(n) * 64 + seg * 16; \
        _Pragma("unroll") for (int t = 0; t < 16; ++t) { rq[t] = qg[(r0_ + t) * ldp]; rf[t] = qg[(r0_ + t) * ldp + 2048]; } \
        rv = *(const pg8::u32x4*)(vg + ((size_t)(n) * 64 + (tid >> 3)) * ldp + (tid & 7) * 8); } while (0)
    HG_LOAD(0);
#pragma unroll 1
    for (int n = 0; n < 32; ++n) {
        float bl[16]; float run = 0.f;
#pragma unroll
        for (int t = 0; t < 16; ++t) { run += bf2f(rf[t]); bl[t] = run; }
        segt[seg * 128 + ch] = run;
        *(LAS pg8::u32x4*)(F.lds + hg::OFF_V + img_off(tid >> 3, tid & 7)) = rv;
        __syncthreads();
        const float s0 = segt[ch], s1 = segt[128 + ch], s2 = segt[256 + ch], s3 = segt[384 + ch];
        const float pre = (seg == 0) ? 0.f : (seg == 1 ? s0 : (seg == 2 ? s0 + s1 : s0 + s1 + s2));
        const float bref = s0 + s1, blast = (s0 + s1) + (s2 + s3);
        if (seg == 0) { esr[ch] = __expf(bref); ebl[ch] = __expf(blast); ebr[ch] = __expf(blast - bref); }
#pragma unroll
        for (int t = 0; t < 16; ++t) {
            const int tok = seg * 16 + t; const float lf = bf2f(rf[t]); const float e = __expf(pre + bl[t] - bref);
            const float qt = bf2f(rq[t]) * e, kt = (1.f - __expf(lf)) * __builtin_amdgcn_rcpf(e);
            const unsigned o_ = img_off(tok, ch >> 3) + (ch & 7) * 2;
            *(LAS bf16*)(F.lds + hg::OFF_Q + o_) = f2bf(qt); *(LAS bf16*)(F.lds + hg::OFF_K + o_) = f2bf(kt);
        }
        if (n + 1 < 32) HG_LOAD(n + 1);
        __syncthreads();
        if (wave >= 4) {
            const int dkb = wave - 4;
#pragma unroll
            for (int r = 0; r < 16; ++r) { const int dk = 32 * dkb + (r & 3) + 8 * (r >> 2) + 4 * hi; const float sc = esr[dk];
                *(LAS bf16*)(F.lds + hg::OFF_S + img_off(dk, c >> 3) + (c & 7) * 2) = f2bf(sc * st0[r]);
                *(LAS bf16*)(F.lds + hg::OFF_S + img_off(dk, (32 + c) >> 3) + (c & 7) * 2) = f2bf(sc * st1[r]); }
        }
        __syncthreads();
        if (wave >= 4) {
            const int dkb = wave - 4; f32x16 x0 = {}, x1 = {};
#pragma unroll
            for (int s = 0; s < 4; ++s) {
                const s16x4 a0 = tr_read(lbase + hg::OFF_K + addr_tr(lane, 16 * s + 8 * hi, dkb)), a1 = tr_read(lbase + hg::OFF_K + addr_tr(lane, 16 * s + 8 * hi + 4, dkb));
                const s16x4 b0 = tr_read(lbase + hg::OFF_V + addr_tr(lane, 16 * s + 8 * hi, 0)), b1 = tr_read(lbase + hg::OFF_V + addr_tr(lane, 16 * s + 8 * hi + 4, 0));
                const s16x4 d0 = tr_read(lbase + hg::OFF_V + addr_tr(lane, 16 * s + 8 * hi, 1)), d1 = tr_read(lbase + hg::OFF_V + addr_tr(lane, 16 * s + 8 * hi + 4, 1));
                RET_LGKM0();
                const bf16x8 a = cat8(a0, a1);
                x0 = __builtin_amdgcn_mfma_f32_32x32x16_bf16(a, cat8(b0, b1), x0, 0, 0, 0);
                x1 = __builtin_amdgcn_mfma_f32_32x32x16_bf16(a, cat8(d0, d1), x1, 0, 0, 0);
            }
#pragma unroll
            for (int r = 0; r < 16; ++r) { const int dk = 32 * dkb + (r & 3) + 8 * (r >> 2) + 4 * hi; const float el = ebl[dk], er = ebr[dk];
                st0[r] = el * st0[r] + er * x0[r]; st1[r] = el * st1[r] + er * x1[r]; }
        } else {
            const int tb = wave & 1, dvb = wave >> 1;
            f32x16 o = {};
#pragma unroll
            for (int s = 0; s < 8; ++s) {
                const bf16x8 a = *(const LAS bf16x8*)(F.lds + hg::OFF_Q + addr_row(lane, tb, s));
                const s16x4 b0 = tr_read(lbase + hg::OFF_S + addr_tr(lane, 16 * s + 8 * hi, dvb)), b1 = tr_read(lbase + hg::OFF_S + addr_tr(lane, 16 * s + 8 * hi + 4, dvb));
                RET_LGKM0();
                o = __builtin_amdgcn_mfma_f32_32x32x16_bf16(a, cat8(b0, b1), o, 0, 0, 0);
            }
#pragma unroll
            for (int sb = 0; sb < 2; ++sb) {
                if (sb <= tb) {
                    f32x16 sacc = {};
#pragma unroll
                    for (int s = 0; s < 8; ++s) {
                        const bf16x8 a = *(const LAS bf16x8*)(F.lds + hg::OFF_K + addr_row(lane, sb, s)), bq = *(const LAS bf16x8*)(F.lds + hg::OFF_Q + addr_row(lane, tb, s));
                        sacc = __builtin_amdgcn_mfma_f32_32x32x16_bf16(a, bq, sacc, 0, 0, 0);
                    }
                    if (sb == tb) {
#pragma unroll
                        for (int r = 0; r < 16; ++r) { const int sl = (r & 3) + 8 * (r >> 2) + 4 * hi; if (sl > c) sacc[r] = 0.f; }
                    }
#pragma unroll
                    for (int s = 0; s < 2; ++s) {
                        const bf16x8 pa = pack_acc8(sacc, s);
                        const s16x4 b0 = tr_read(lbase + hg::OFF_V + addr_tr(lane, 32 * sb + 16 * s + 4 * hi, dvb)), b1 = tr_read(lbase + hg::OFF_V + addr_tr(lane, 32 * sb + 16 * s + 8 + 4 * hi, dvb));
                        RET_LGKM0();
                        o = __builtin_amdgcn_mfma_f32_32x32x16_bf16(pa, cat8(b0, b1), o, 0, 0, 0);
                    }
                }
            }
            const size_t rowb = rowg0 + (size_t)n * 64 + tb * 32;
#pragma unroll
            for (int r = 0; r < 16; ++r) {
                const int il = (r & 3) + 8 * (r >> 2) + 4 * hi; const float v = o[r];
                float q = v * v; q += swz_xor<1>(q); q += swz_xor<2>(q); q += swz_xor<4>(q); q += swz_xor<8>(q); q += swz_xor<16>(q);
                if (c == 0) F.ssq[((rowb + il) * 16 + h) * 4 + dvh * 2 + dvb] = q;
                const float vn = swz_xor<1>(v);
                if ((c & 1) == 0) *(unsigned*)(P + (rowb + il) * ldp + 4096 + h * 128 + dvh * 64 + dvb * 32 + c) = cvtpk(v, vn);
            }
        }
        __syncthreads();
    }
#undef HG_LOAD
}

struct Args { const float* in[12]; float* out; unsigned char* ws; };
template <int L> __device__ __forceinline__ void mixer_phase(Frame& F, const XcdBarrier& bar) {
    if (L == 0) { index_topk_phase(F); xcd_barrier(bar); attn_phase<0>(F.P, F.mask, (char*)F.lds_gen, F.G); }
    if (L == 1) attn_phase<1>(F.P, F.mask, (char*)F.lds_gen, F.G);
    if (L == 2) ret_phase(F);
    if (L == 3) hgrn_phase(F);
}
template <int L> __device__ __forceinline__ void layer_phases(Frame& F, const XcdBarrier& bar) {
    constexpr int N1 = n1pad(L);
    {
        pg8::Gemm g{F.U, F.WIN, MTOK, N1, D_MODEL, D_MODEL}; pg8::StaticOrder S; S.init(MTOK, N1, F.G, (int)blockIdx.x);
        EpiProj<L> E{F.P, N1, F.cos128, F.sin128, F.cos64, F.sin64, F.lb};
        pg8::gemm_phase<EpiProj<L>, pg8::StaticOrder, true, true>(F.lds, g, S, E);
    }
    xcd_barrier(bar);
    mixer_phase<L>(F, bar);
    xcd_barrier(bar);
    {
        pg8::Gemm g{F.U, F.WIN + (size_t)N1 * D_MODEL, MTOK, D_INNER, D_MODEL, D_MODEL}; pg8::StaticOrder S; S.init(MTOK, D_INNER, F.G, (int)blockIdx.x);
        EpiGate<L> E{F.P + ocol(L), N1, F.ssq};
        pg8::gemm_phase<EpiGate<L>, pg8::StaticOrder, true, true>(F.lds, g, S, E);
    }
    xcd_barrier(bar);
    {
        pg8::Gemm g{F.P + ocol(L), F.WOUT, MTOK, D_MODEL, D_INNER, N1}; pg8::StaticOrder S; S.init(MTOK, D_MODEL, F.G, (int)blockIdx.x);
        EpiAddF32 E{F.H, D_MODEL};
        pg8::gemm_phase<EpiAddF32, pg8::StaticOrder, true, true>(F.lds, g, S, E);
    }
    xcd_barrier(bar);
    if (L < 3) { norm_rows(F, F.H, F.norm_g + (L + 1) * D_MODEL, nullptr); conv_weights<(L < 3 ? L + 1 : 3)>(F); xcd_barrier(bar); }
    else final_rows(F);
}
__global__ void __launch_bounds__(NWAVES * 64, 2) mega_fwd(Args args) {
    extern __shared__ __attribute__((aligned(16))) unsigned char lds_raw[];
    Frame F;
    F.lds = (LAS unsigned char*)lds_raw; F.lds_gen = lds_raw; F.MISC = (volatile LAS unsigned*)(F.lds + MISC_OFF);
    F.G = gridDim.x;
    unsigned char* ws = args.ws;
    F.ctl = (unsigned*)(ws + WS_CTL);
    F.x = args.in[0]; F.norm_g = args.in[1]; F.final_g = args.in[2];
    F.w_in[0] = args.in[3]; F.w_out[0] = args.in[4]; F.w_in[1] = args.in[5]; F.w_out[1] = args.in[6]; F.w_in[2] = args.in[7]; F.w_out[2] = args.in[8]; F.w_in[3] = args.in[9]; F.w_out[3] = args.in[10];
    F.lb_logits = args.in[11]; F.H = args.out;
    F.cos128 = (float*)(ws + WS_TAB); F.sin128 = F.cos128 + 2048 * 64; F.cos64 = F.sin128 + 2048 * 64; F.sin64 = F.cos64 + 2048 * 32; F.lb = F.sin64 + 2048 * 32;
    F.ssq = (float*)(ws + WS_SSQ); F.mask = (unsigned*)(ws + WS_MASK);
    F.WIN = (bf16*)(ws + WS_WIN); F.WOUT = (bf16*)(ws + WS_WOUT); F.U = (bf16*)(ws + WS_U); F.P = (bf16*)(ws + WS_P);
    for (int u = threadIdx.x; u < (LDS_BYTES - RING_BYTES) / 4; u += NWAVES * 64) ((LAS unsigned*)(F.lds + RING_BYTES))[u] = 0u;
    __syncthreads();
    const XcdBarrier bar = xcd_barrier_post(F.ctl + CW_BAR, F.MISC + 8);
    make_tables(F); norm_rows(F, F.x, F.norm_g, F.H); conv_weights<0>(F);
    xcd_barrier(bar);
    layer_phases<0>(F, bar);
    layer_phases<1>(F, bar);
    layer_phases<2>(F, bar);
    layer_phases<3>(F, bar);
}

extern "C" void kernel_launch(void* const* d_in, const int* in_sizes, int n_in, void* d_out, int out_size, void* d_ws, size_t ws_size, hipStream_t stream) {
    static int grid = 0;
    if (grid == 0) {
        int dev = 0, cus = 0;
        if (hipGetDevice(&dev) != hipSuccess || hipDeviceGetAttribute(&cus, hipDeviceAttributeMultiprocessorCount, dev) != hipSuccess) { grid = -1; return; }
        if (hipFuncSetAttribute((const void*)mega_fwd, hipFuncAttributeMaxDynamicSharedMemorySize, LDS_BYTES) != hipSuccess) { grid = -1; return; }
        int per_cu = 0; (void)hipOccupancyMaxActiveBlocksPerMultiprocessor(&per_cu, (const void*)mega_fwd, NWAVES * 64, LDS_BYTES); (void)hipGetLastError();
        if (cus < 256) { fprintf(stderr, "kernel_launch: needs 256 CUs\n"); grid = -1; return; }
        grid = 256;
        if (ws_size < WS_END || n_in != 12) { fprintf(stderr, "kernel_launch: unexpected workspace / inputs\n"); grid = -1; return; }
    }
    if (grid < 0) return;
    (void)hipMemsetAsync((char*)d_ws + WS_CTL, 0, CTL_ZERO_BYTES, stream);
    Args a; for (int i = 0; i < 12; ++i) a.in[i] = (const float*)d_in[i];
    a.out = (float*)d_out; a.ws = (unsigned char*)d_ws;
    hipLaunchKernelGGL(mega_fwd, dim3(grid), dim3(NWAVES * 64), LDS_BYTES, stream, a);
}
```

```cpp
#include <hip/hip_runtime.h>
#include <cstdio>
#include <cstdint>
#define GAS __attribute__((address_space(1)))
#define LAS __attribute__((address_space(3)))
namespace pg8 {
#define PG8_LAS __attribute__((address_space(3)))
typedef unsigned short bf16_t;
typedef short bf16x8 __attribute__((ext_vector_type(8)));
typedef float f32x4 __attribute__((ext_vector_type(4)));
typedef unsigned u32x4 __attribute__((ext_vector_type(4)));
constexpr int BM = 256, BK = 64, HALF = 128, HTB = HALF * BK * 2  , STAGE_BYTES = 8 * HTB, NXCD = 8, WGM = 8;

__host__ __device__ __forceinline__ int lds_byte(int r, int c) { const int st = (r >> 4) * 2 + (c >> 5), rr = r & 15, cc = c & 31, ob = rr * 64 + cc * 2; return st * 1024 + (ob ^ (((ob >> 9) & 1) << 5)); }
__host__ __device__ __forceinline__ void stage_rc(int b, int& R, int& C) { const int st = b / 1024, sb = b % 1024, swz = sb ^ (((sb >> 9) & 1) << 5); R = (st >> 1) * 16 + swz / 64; C = (st & 1) * 32 + (swz % 64) / 2; }
__host__ __device__ __forceinline__ int perm32(int rho) { const int n = rho >> 4, i = rho & 15; return 8 * (i >> 2) + 4 * n + (i & 3); }

struct Unit { int pm, pn; };
struct Gemm { const bf16_t* A; const bf16_t* Bt; int M, N, K, lda; };

struct StaticOrder {
    int nM, nN, nwg, G, c;
    __host__ __device__ void init(int M, int N, int G_, int c_) { nM = M / BM; nN = N / BM; nwg = nM * nN; G = G_; c = c_; }
    __host__ __device__ bool next(int i, Unit& u) const {
        const long L = (long)i * G + c; if (L >= nwg) return false;
        int wgid = (int)L; { const int q = nwg / NXCD, r = nwg % NXCD, xcd = wgid % NXCD, off = wgid / NXCD; wgid = (xcd < r ? xcd * (q + 1) : r * (q + 1) + (xcd - r) * q) + off; }
        const int nig = WGM * nN, gid = wgid / nig, fm = gid * WGM, gsz = (nM - fm) < WGM ? (nM - fm) : WGM;
        u.pm = fm + ((wgid % nig) % gsz); u.pn = (wgid % nig) / gsz; return true;
    }
    __device__ __forceinline__ void a_ready(const Unit&) const {}
    __device__ __forceinline__ void done(const Unit&) const {}
};

__device__ __forceinline__ unsigned cvt_pk_bf16(float lo, float hi) { unsigned r; asm volatile("v_cvt_pk_bf16_f32 %0, %1, %2" : "=v"(r) : "v"(lo), "v"(hi)); return r; }
typedef float f32x2 __attribute__((ext_vector_type(2)));
template <class Epi, class Sched, bool ALIGN_EPI = false, bool SP2 = false>
__device__ __forceinline__ void gemm_phase(PG8_LAS unsigned char* lds, const Gemm g, const Sched& S, const Epi& E) {
    int tid_o = threadIdx.x; asm volatile("" : "+v"(tid_o));
    const int tid = tid_o, wid = __builtin_amdgcn_readfirstlane(tid >> 6), lane = tid & 63, wr = wid >> 2, wc = wid & 3, fr = lane & 15, fq = lane >> 4;
    const int K = g.K, nt = K / BK;
    unsigned voffA[2], voffB[2];
#pragma unroll
    for (int i = 0; i < 2; ++i) { int R, C; stage_rc(tid * 16 + i * 8192, R, C); const int Rb = Epi::PERM ? ((R & ~31) + perm32(R & 31)) : R;
        voffA[i] = (unsigned)(R * g.lda + C) * 2u; voffB[i] = (unsigned)(Rb * K + C) * 2u; }
    const size_t kstep = (size_t)(BK * 2);
    const size_t hstepA = (size_t)HALF * g.lda * 2, hstepB = (size_t)HALF * K * 2;
    const size_t tstepA = 2 * hstepA, tstepB = 2 * hstepB;
    const unsigned ldsw = (unsigned)wid * 1024u;
    const int aoff = lds_byte(wr * 64 + fr, fq * 8), boff = lds_byte(wc * 32 + fr, fq * 8);
#define PG8_SA(b, h) (((b) * 2 + (h)) * HTB)
#define PG8_SB(b, h) ((4 + (b) * 2 + (h)) * HTB)
#define PG8_STAGE(bufoff, gbase, voff) do { _Pragma("unroll") for (int _i = 0; _i < 2; ++_i) \
        __builtin_amdgcn_global_load_lds((const unsigned*)((const char*)(gbase) + (voff)[_i]), (PG8_LAS unsigned*)(lds + (bufoff) + ldsw + _i * 8192), 16, 0, 0); } while (0)
#define PG8_LDA(dst, b, h) do { _Pragma("unroll") for (int m = 0; m < 4; ++m) _Pragma("unroll") for (int k = 0; k < 2; ++k) dst[m][k] = *(const PG8_LAS bf16x8*)(lds + PG8_SA(b, h) + aoff + m * 2048 + k * 1024); } while (0)
#define PG8_LDB(dst, b, h) do { _Pragma("unroll") for (int n = 0; n < 2; ++n) _Pragma("unroll") for (int k = 0; k < 2; ++k) dst[n][k] = *(const PG8_LAS bf16x8*)(lds + PG8_SB(b, h) + boff + n * 2048 + k * 1024); } while (0)
#define PG8_MMA(ai, bj, At, Bt) do { __builtin_amdgcn_s_setprio(1); _Pragma("unroll") for (int m = 0; m < 4; ++m) _Pragma("unroll") for (int n = 0; n < 2; ++n) _Pragma("unroll") for (int k = 0; k < 2; ++k) \
        acc[ai][bj][m][n] = __builtin_amdgcn_mfma_f32_16x16x32_bf16(Bt[n][k], At[m][k], acc[ai][bj][m][n], 0, 0, 0); __builtin_amdgcn_s_setprio(0); } while (0)
#define PG8_WAIT_V(n) asm volatile("s_waitcnt vmcnt(" #n ")" ::: "memory")
#define PG8_WAIT_L(n) asm volatile("s_waitcnt lgkmcnt(" #n ")" ::: "memory")
#define PG8_BAR __builtin_amdgcn_s_barrier()
#define PG8_SCHED __builtin_amdgcn_sched_barrier(0)
    Unit cur, nxt; int ui = 0;
    if (!S.next(0, cur)) return;
    f32x4 acc[2][2][4][2];
#pragma unroll
    for (int a = 0; a < 2; ++a)
#pragma unroll
        for (int b = 0; b < 2; ++b)
#pragma unroll
            for (int m = 0; m < 4; ++m)
#pragma unroll
                for (int n = 0; n < 2; ++n) acc[a][b][m][n] = (f32x4){0.f, 0.f, 0.f, 0.f};
    bf16x8 At[4][2], B0[2][2], B1[2][2];
    const char* cA = (const char*)g.A + (size_t)cur.pm * tstepA; const char* cB = (const char*)g.Bt + (size_t)cur.pn * tstepB;
    S.a_ready(cur);
    if constexpr (SP2) {
        PG8_STAGE(PG8_SB(0, 0), cB, voffB); PG8_STAGE(PG8_SB(0, 1), cB + hstepB, voffB); PG8_STAGE(PG8_SA(0, 0), cA, voffA); PG8_STAGE(PG8_SA(0, 1), cA + hstepA, voffA);
        if (wr == 1) PG8_BAR;
        PG8_WAIT_V(2); PG8_BAR;
        PG8_STAGE(PG8_SB(1, 0), cB + kstep, voffB); PG8_STAGE(PG8_SA(1, 0), cA + kstep, voffA); PG8_STAGE(PG8_SB(1, 1), cB + hstepB + kstep, voffB);
        PG8_WAIT_V(6); PG8_BAR;
    } else {
        PG8_STAGE(PG8_SB(0, 0), cB, voffB); PG8_STAGE(PG8_SA(0, 0), cA, voffA); PG8_STAGE(PG8_SB(0, 1), cB + hstepB, voffB); PG8_STAGE(PG8_SA(0, 1), cA + hstepA, voffA);
        if (wr == 1) PG8_BAR;
        PG8_WAIT_V(4); PG8_BAR;
        PG8_STAGE(PG8_SB(1, 0), cB + kstep, voffB); PG8_STAGE(PG8_SA(1, 0), cA + kstep, voffA); PG8_STAGE(PG8_SB(1, 1), cB + hstepB + kstep, voffB);
        PG8_WAIT_V(6); PG8_BAR;
    }
    for (;;) {
        const bool has_next = S.next(ui + 1, nxt);
        const char* nA = has_next ? (const char*)g.A + (size_t)nxt.pm * tstepA : cA; const char* nB = has_next ? (const char*)g.Bt + (size_t)nxt.pn * tstepB : cB;
        for (int t = 0; t < nt; t += 2) {
            const bool last = (t == nt - 2);
            const char* a1 = cA + (size_t)(t + 1) * kstep;
            const char* a2 = last ? nA : cA + (size_t)(t + 2) * kstep; const char* b2 = last ? nB : cB + (size_t)(t + 2) * kstep;
            const char* a3 = a2 + kstep; const char* b3 = b2 + kstep;
            if (last && has_next) S.a_ready(nxt);
            if constexpr (SP2) {
            PG8_LDB(B0, 0, 0); PG8_LDB(B1, 0, 1); PG8_SCHED; PG8_LDA(At, 0, 0); PG8_STAGE(PG8_SA(1, 1), a1 + hstepA, voffA);
            PG8_WAIT_V(8); PG8_WAIT_L(0); PG8_BAR; PG8_MMA(0, 0, At, B0); PG8_MMA(0, 1, At, B1); PG8_BAR; PG8_SCHED;
            PG8_LDA(At, 0, 1); PG8_STAGE(PG8_SB(0, 0), b2, voffB); PG8_STAGE(PG8_SB(0, 1), b2 + hstepB, voffB); PG8_STAGE(PG8_SA(0, 0), a2, voffA);
            PG8_WAIT_V(8); PG8_WAIT_L(0); PG8_BAR; PG8_MMA(1, 0, At, B0); PG8_MMA(1, 1, At, B1); PG8_BAR; PG8_SCHED;
            PG8_LDB(B0, 1, 0); PG8_LDB(B1, 1, 1); PG8_SCHED; PG8_LDA(At, 1, 0); PG8_STAGE(PG8_SA(0, 1), a2 + hstepA, voffA);
            PG8_WAIT_V(8); PG8_WAIT_L(0); PG8_BAR; PG8_MMA(0, 0, At, B0); PG8_MMA(0, 1, At, B1); PG8_BAR; PG8_SCHED;
            PG8_LDA(At, 1, 1); PG8_STAGE(PG8_SB(1, 0), b3, voffB); PG8_STAGE(PG8_SB(1, 1), b3 + hstepB, voffB); PG8_STAGE(PG8_SA(1, 0), a3, voffA);
            PG8_WAIT_V(8); PG8_WAIT_L(0); PG8_BAR; PG8_MMA(1, 0, At, B0); PG8_MMA(1, 1, At, B1); PG8_BAR; PG8_SCHED;
            } else {
            PG8_LDB(B0, 0, 0); PG8_SCHED; PG8_LDA(At, 0, 0); PG8_STAGE(PG8_SA(1, 1), a1 + hstepA, voffA);
            PG8_WAIT_L(8); PG8_BAR; PG8_WAIT_L(0); PG8_MMA(0, 0, At, B0); PG8_BAR; PG8_SCHED;
            PG8_LDB(B1, 0, 1); PG8_STAGE(PG8_SB(0, 0), b2, voffB);
            PG8_BAR; PG8_WAIT_L(0); PG8_MMA(0, 1, At, B1); PG8_BAR;
            PG8_LDA(At, 0, 1); PG8_STAGE(PG8_SA(0, 0), a2, voffA);
            PG8_BAR; PG8_WAIT_L(0); PG8_MMA(1, 0, At, B0); PG8_BAR; PG8_SCHED;
            PG8_STAGE(PG8_SB(0, 1), b2 + hstepB, voffB);
            PG8_WAIT_V(6); PG8_BAR; PG8_MMA(1, 1, At, B1); PG8_BAR;
            PG8_LDB(B0, 1, 0); PG8_SCHED; PG8_LDA(At, 1, 0); PG8_STAGE(PG8_SA(0, 1), a2 + hstepA, voffA);
            PG8_WAIT_L(8); PG8_BAR; PG8_WAIT_L(0); PG8_MMA(0, 0, At, B0); PG8_BAR; PG8_SCHED;
            PG8_LDB(B1, 1, 1); PG8_STAGE(PG8_SB(1, 0), b3, voffB);
            PG8_BAR; PG8_WAIT_L(0); PG8_MMA(0, 1, At, B1); PG8_BAR;
            PG8_LDA(At, 1, 1); PG8_STAGE(PG8_SA(1, 0), a3, voffA);
            PG8_BAR; PG8_WAIT_L(0); PG8_MMA(1, 0, At, B0); PG8_BAR; PG8_SCHED;
            PG8_STAGE(PG8_SB(1, 1), b3 + hstepB, voffB);
            PG8_WAIT_V(6); PG8_BAR; PG8_MMA(1, 1, At, B1); PG8_BAR;
            }
        }
        if constexpr (ALIGN_EPI) { if (wr == 0) PG8_BAR; }
        if constexpr (!Epi::AFTER_DRAIN) { E(acc, cur, wr, wc, fr, fq); S.done(cur); }
        if (!has_next) break;
#pragma unroll
        for (int a = 0; a < 2; ++a)
#pragma unroll
            for (int b = 0; b < 2; ++b)
#pragma unroll
                for (int m = 0; m < 4; ++m)
#pragma unroll
                    for (int n = 0; n < 2; ++n) acc[a][b][m][n] = (f32x4){0.f, 0.f, 0.f, 0.f};
        cur = nxt; cA = nA; cB = nB; ++ui;
        if constexpr (ALIGN_EPI) { if (wr == 1) PG8_BAR; }
    }
    PG8_WAIT_V(0);
    if constexpr (!ALIGN_EPI) { if (wr == 0) PG8_BAR; }
    PG8_BAR;
    if constexpr (Epi::AFTER_DRAIN) { E.fused(acc, cur, wr, wc, fr, fq, lds, wid, lane); S.done(cur); }
#undef PG8_SA
#undef PG8_SB
#undef PG8_STAGE
#undef PG8_LDA
#undef PG8_LDB
#undef PG8_MMA
#undef PG8_WAIT_V
#undef PG8_WAIT_L
#undef PG8_BAR
#undef PG8_SCHED
}
}
#define XB_TMO      128
#define XB_XCNT(j)  (256  + 64 * (j))
#define XB_XSUB(j)  (1280 + 64 * (j))
#define XB_XGEN(j)  (2304 + 64 * (j))
#define XB_TOP      3328
#define XB_TOPGEN   3392
#define XCD_BAR_WORDS 3456
#define XB_SPIN_CAP (1u << 18)

__device__ __forceinline__ unsigned xb_ld(unsigned* p)              { return __hip_atomic_load(p, __ATOMIC_RELAXED, __HIP_MEMORY_SCOPE_AGENT); }
__device__ __forceinline__ unsigned xb_add(unsigned* p, unsigned v) { return __hip_atomic_fetch_add(p, v, __ATOMIC_RELAXED, __HIP_MEMORY_SCOPE_AGENT); }
__device__ __forceinline__ unsigned xb_xcc_id() { return (unsigned)__builtin_amdgcn_s_getreg((3 << 11) | 20) & 0xFu; }
#define XB_SPIN(cond, bar) do { unsigned _sp = 0; while (cond) { __builtin_amdgcn_s_sleep(1); \
    if ((++_sp & 255u) == 0u) { if (xb_ld(&(bar)[XB_TMO])) break; if (_sp > XB_SPIN_CAP) { atomicAdd(&(bar)[XB_TMO], 1u); break; } } } } while (0)

struct XcdBarrier {
    unsigned* bar; unsigned x;
    volatile LAS unsigned* st;
};

__device__ __forceinline__ XcdBarrier xcd_barrier_post(unsigned* bar, volatile LAS unsigned* st) {
    XcdBarrier b; b.bar = bar; b.x = xb_xcc_id(); b.st = st;
    if (threadIdx.x == 0) (void)xb_add(&bar[XB_XCNT(b.x)], 1u);
    return b;
}
__device__ __forceinline__ void xcd_barrier_complete(unsigned* bar, unsigned x, unsigned& nloc, unsigned& nx) {
    const unsigned G = gridDim.x * gridDim.y * gridDim.z;
    unsigned sum, cnt, mine, sp = 0u;
    for (;;) {
        sum = 0u; cnt = 0u; mine = 0u;
#pragma unroll
        for (unsigned j = 0; j < 16; ++j) { const unsigned c = xb_ld(&bar[XB_XCNT(j)]); sum += c; cnt += (c > 0u) ? 1u : 0u; mine = (j == x) ? c : mine; }
        if (sum == G) break;
        __builtin_amdgcn_s_sleep(1);
        if ((++sp & 255u) == 0u) { if (xb_ld(&bar[XB_TMO])) break; if (sp > XB_SPIN_CAP) { atomicAdd(&bar[XB_TMO], 1u); break; } }
    }
    nloc = mine > 0u ? mine : 1u; nx = cnt > 0u ? cnt : 1u;
}

__device__ __forceinline__ void xcd_barrier(const XcdBarrier& b) {
    asm volatile("s_waitcnt vmcnt(0)" ::: "memory");
    __syncthreads();
    if (threadIdx.x == 0) {
        unsigned* bar = b.bar;
        __builtin_amdgcn_s_waitcnt(0);
        unsigned nloc = b.st[0], nx = b.st[1];
        if (nloc == 0u) { xcd_barrier_complete(bar, b.x, nloc, nx); b.st[0] = nloc; b.st[1] = nx; }
        const unsigned old = xb_add(&bar[XB_XSUB(b.x)], 1u);
        const unsigned gen = old / nloc;
        if (old + 1u == (gen + 1u) * nloc) {
            __builtin_amdgcn_fence(__ATOMIC_RELEASE, "agent");
            asm volatile("s_waitcnt vmcnt(0)" ::: "memory");
            const unsigned og = xb_add(&bar[XB_TOP], 1u);
            const unsigned tg = og / nx;
            if (og + 1u == (tg + 1u) * nx) xb_add(&bar[XB_TOPGEN], 1u);
            else XB_SPIN(xb_ld(&bar[XB_TOPGEN]) == tg, bar);
            __builtin_amdgcn_fence(__ATOMIC_ACQUIRE, "agent");
            xb_add(&bar[XB_XGEN(b.x)], 1u);
            asm volatile("s_waitcnt vmcnt(0)" ::: "memory");
        } else {
            XB_SPIN(xb_ld(&bar[XB_XGEN(b.x)]) == gen, bar);
            __builtin_amdgcn_fence(__ATOMIC_ACQUIRE, "agent");
            asm volatile("s_waitcnt vmcnt(0)" ::: "memory");
        }
    }
    __syncthreads();
}

typedef unsigned short bf16;
typedef GAS unsigned gu32;
constexpr int D_MODEL = 1024, SEQ = 2048, D_INNER = 2048, MTOK = 16384, NWAVES = 8;
constexpr float QK_SCALE = 0.08838834764831845f;
constexpr size_t MiB = 1u << 20;
constexpr size_t WS_CTL = 0, CTL_ZERO_BYTES = 64 * 1024, WS_TAB = 1 * MiB, WS_SSQ = 3 * MiB, WS_MASK = 7 * MiB, WS_WIN = 12 * MiB, WS_WOUT = 28 * MiB, WS_U = 32 * MiB, WS_P = 64 * MiB, WS_END = 256 * MiB;
constexpr int CW_BAR = 1024;
constexpr int RING_BYTES = 131072, MISC_OFF = RING_BYTES + 320, LDS_BYTES = 147456;
__host__ __device__ constexpr int n1pad(int L) { return L == 0 ? 3584 : (L == 1 ? 6144 : (L == 2 ? 4096 : 6144)); }
__host__ __device__ constexpr int n1real(int L) { return L == 0 ? 3408 : (L == 1 ? 6144 : (L == 2 ? 4096 : 6144)); }
__host__ __device__ constexpr int nsrc(int L) { return L == 0 ? 5456 : (L == 1 ? 8192 : (L == 2 ? 6144 : 8192)); }
__host__ __device__ constexpr int ocol(int L) { return L == 0 ? 0 : (L == 1 ? 0 : (L == 2 ? 2048 : 4096)); }
constexpr int A_K = 2048, A_V = 2176, A_IQ = 2304, A_IK = 3328, A_IW = 3392;

__device__ __forceinline__ float bf2f(bf16 v) { return __uint_as_float(((unsigned)v) << 16); }
__device__ __forceinline__ bf16 f2bf(float f) { unsigned u = __float_as_uint(f); return (bf16)((u + 0x7fffu + ((u >> 16) & 1u)) >> 16); }
__device__ __forceinline__ unsigned pk2(float lo, float hi) { return (unsigned)f2bf(lo) | ((unsigned)f2bf(hi) << 16); }
template <int CTRL, int ROWMASK> __device__ __forceinline__ float dpp_f(float old, float v) { return __int_as_float(__builtin_amdgcn_update_dpp(__float_as_int(old), __float_as_int(v), CTRL, ROWMASK, 0xf, false)); }
template <int CTRL, int ROWMASK> __device__ __forceinline__ int dpp_i(int old, int v) { return __builtin_amdgcn_update_dpp(old, v, CTRL, ROWMASK, 0xf, false); }
__device__ __forceinline__ float half_sum_f(float v) {
    v += dpp_f<0x111, 0xf>(0.f, v); v += dpp_f<0x112, 0xf>(0.f, v); v += dpp_f<0x114, 0xf>(0.f, v); v += dpp_f<0x118, 0xf>(0.f, v); v += dpp_f<0x142, 0xa>(0.f, v);
    return v;
}
__device__ __forceinline__ int half_sum_i(int v) {
    v += dpp_i<0x111, 0xf>(0, v); v += dpp_i<0x112, 0xf>(0, v); v += dpp_i<0x114, 0xf>(0, v); v += dpp_i<0x118, 0xf>(0, v); v += dpp_i<0x142, 0xa>(0, v);
    return v;
}
__device__ __forceinline__ float wave_sum(float v) {
    v = half_sum_f(v); v += dpp_f<0x143, 0xc>(0.f, v);
    return __int_as_float(__builtin_amdgcn_readlane(__float_as_int(v), 63));
}
__device__ __forceinline__ float wave_max(float v) {
    v = fmaxf(v, dpp_f<0x111, 0xf>(v, v)); v = fmaxf(v, dpp_f<0x112, 0xf>(v, v)); v = fmaxf(v, dpp_f<0x114, 0xf>(v, v)); v = fmaxf(v, dpp_f<0x118, 0xf>(v, v));
    v = fmaxf(v, dpp_f<0x142, 0xa>(v, v)); v = fmaxf(v, dpp_f<0x143, 0xc>(v, v));
    return __int_as_float(__builtin_amdgcn_readlane(__float_as_int(v), 63));
}
__device__ __forceinline__ float lane_xor1(float v) { return dpp_f<0xB1, 0xf>(v, v); }
__device__ __forceinline__ float silu_f(float z) { return z * __builtin_amdgcn_rcpf(1.f + __expf(-z)); }
__device__ __forceinline__ float sigmoid_f(float z) { return __builtin_amdgcn_rcpf(1.f + __expf(-z)); }
#define LDS_WAIT() asm volatile("s_waitcnt lgkmcnt(0)" ::: "memory")
#define LDS_BARRIER() do { asm volatile("s_waitcnt lgkmcnt(0)" ::: "memory"); __builtin_amdgcn_s_barrier(); asm volatile("" ::: "memory"); } while (0)
#define PHASE_IDS() int tid_o_ = threadIdx.x; asm volatile("" : "+v"(tid_o_)); const int tid = tid_o_, lane = tid & 63, wave = __builtin_amdgcn_readfirstlane(tid >> 6); (void)lane; (void)wave

struct Frame {
    LAS unsigned char* lds; unsigned char* lds_gen; volatile LAS unsigned* MISC; unsigned* ctl;
    int G;
    const float* x; const float* norm_g; const float* final_g; const float* w_in[4]; const float* w_out[4]; const float* lb_logits;
    float* H;
    float *cos128, *sin128, *cos64, *sin64, *lb, *ssq; unsigned* mask;
    bf16 *WIN, *WOUT, *U, *P;
};

template <int L> __device__ __forceinline__ int proj_mode(int g32) {
    if (L == 0) return g32 < 68 ? 1 : (g32 < 72 ? 0 : (g32 < 106 ? 2 : 0));
    if (L == 1) return g32 < 128 ? 1 : 0;
    if (L == 2) return g32 < 32 ? 1 : (g32 < 64 ? 3 : 0);
    return g32 < 64 ? 4 : (g32 < 128 ? 5 : 0);
}
template <int L> struct EpiProj {
    static constexpr bool PERM = true, AFTER_DRAIN = false;
    bf16* P; int ldp; const float *c128, *s128, *c64, *s64, *lb;
    __device__ __forceinline__ void operator()(const pg8::f32x4 (&acc)[2][2][4][2], const pg8::Unit& u, int wr, int wc, int fr, int fq) const {
        const int row0 = u.pm * 256 + wr * 64 + fr, colb = u.pn * 256 + wc * 32 + 8 * fq;
#pragma unroll
        for (int bj = 0; bj < 2; ++bj) {
            const int col = colb + bj * 128; const int mode = proj_mode<L>(__builtin_amdgcn_readfirstlane(col >> 5));
#pragma unroll
            for (int ai = 0; ai < 2; ++ai)
#pragma unroll
                for (int m = 0; m < 4; ++m) {
                    const int row = row0 + ai * 128 + m * 16, pos = row & (SEQ - 1);
                    pg8::f32x4 v0 = acc[ai][bj][m][0], v1 = acc[ai][bj][m][1];
                    if (mode == 1 || mode == 3) { const int i0 = ((col & 127) >> 3) * 4;
                        const pg8::f32x4 c = *(const pg8::f32x4*)(c128 + pos * 64 + i0), s = *(const pg8::f32x4*)(s128 + pos * 64 + i0);
                        const pg8::f32x4 o1 = v0 * c - v1 * s, o2 = v0 * s + v1 * c; v0 = o1; v1 = o2;
                        if (mode == 3) { v0 = v0 * QK_SCALE; v1 = v1 * QK_SCALE; } }
                    else if (mode == 2) { const int i0 = ((col & 63) >> 3) * 4;
                        const pg8::f32x4 c = *(const pg8::f32x4*)(c64 + pos * 32 + i0), s = *(const pg8::f32x4*)(s64 + pos * 32 + i0);
                        const pg8::f32x4 o1 = v0 * c - v1 * s, o2 = v0 * s + v1 * c; v0 = o1; v1 = o2; }
                    else if (mode == 4) {
#pragma unroll
                        for (int j = 0; j < 4; ++j) { v0[j] = silu_f(v0[j]) * QK_SCALE; v1[j] = silu_f(v1[j]) * QK_SCALE; } }
                    else if (mode == 5) { const pg8::f32x4 l0 = *(const pg8::f32x4*)(lb + col - 2048), l1 = *(const pg8::f32x4*)(lb + col - 2048 + 4);
#pragma unroll
                        for (int j = 0; j < 4; ++j) { v0[j] = __logf(l0[j] + (1.f - l0[j]) * sigmoid_f(v0[j])); v1[j] = __logf(l1[j] + (1.f - l1[j]) * sigmoid_f(v1[j])); } }
                    pg8::u32x4 w; w.x = pg8::cvt_pk_bf16(v0[0], v0[1]); w.y = pg8::cvt_pk_bf16(v0[2], v0[3]); w.z = pg8::cvt_pk_bf16(v1[0], v1[1]); w.w = pg8::cvt_pk_bf16(v1[2], v1[3]);
                    *(pg8::u32x4*)(P + (size_t)row * ldp + col) = w;
                }
        }
    }
};
template <int L> struct EpiGate {
    static constexpr bool PERM = true, AFTER_DRAIN = false;
    bf16* O; int ldo; const float* ssq;
    __device__ __forceinline__ void operator()(const pg8::f32x4 (&acc)[2][2][4][2], const pg8::Unit& u, int wr, int wc, int fr, int fq) const {
        const int row0 = u.pm * 256 + wr * 64 + fr, colb = u.pn * 256 + wc * 32 + 8 * fq;
#pragma unroll
        for (int ai = 0; ai < 2; ++ai)
#pragma unroll
            for (int m = 0; m < 4; ++m) {
                const int row = row0 + ai * 128 + m * 16;
#pragma unroll
                for (int bj = 0; bj < 2; ++bj) {
                    const int col = colb + bj * 128; float rs = 1.f;
                    if (L == 2) { const pg8::f32x4 q = *(const pg8::f32x4*)(ssq + ((size_t)row * 8 + (col >> 8)) * 8), q2 = *(const pg8::f32x4*)(ssq + ((size_t)row * 8 + (col >> 8)) * 8 + 4);
                        rs = rsqrtf((((q[0] + q[1]) + (q[2] + q[3])) + ((q2[0] + q2[1]) + (q2[2] + q2[3]))) * (1.f / 256.f) + 1e-6f); }
                    if (L == 3) { const pg8::f32x4 q = *(const pg8::f32x4*)(ssq + ((size_t)row * 16 + (col >> 7)) * 4); rs = rsqrtf(((q[0] + q[1]) + (q[2] + q[3])) * (1.f / 128.f) + 1e-6f); }
                    bf16* p = O + (size_t)row * ldo + col; const pg8::u32x4 r = *(const pg8::u32x4*)p;
                    const pg8::f32x4 z0 = acc[ai][bj][m][0], z1 = acc[ai][bj][m][1];
                    float o[8]; o[0] = __uint_as_float(r.x << 16); o[1] = __uint_as_float(r.x & 0xffff0000u); o[2] = __uint_as_float(r.y << 16); o[3] = __uint_as_float(r.y & 0xffff0000u);
                    o[4] = __uint_as_float(r.z << 16); o[5] = __uint_as_float(r.z & 0xffff0000u); o[6] = __uint_as_float(r.w << 16); o[7] = __uint_as_float(r.w & 0xffff0000u);
#pragma unroll
                    for (int j = 0; j < 4; ++j) { o[j] = o[j] * rs * silu_f(z0[j]); o[4 + j] = o[4 + j] * rs * silu_f(z1[j]); }
                    pg8::u32x4 w; w.x = pg8::cvt_pk_bf16(o[0], o[1]); w.y = pg8::cvt_pk_bf16(o[2], o[3]); w.z = pg8::cvt_pk_bf16(o[4], o[5]); w.w = pg8::cvt_pk_bf16(o[6], o[7]);
                    *(pg8::u32x4*)p = w;
                }
            }
    }
};
struct EpiAddF32 {
    static constexpr bool PERM = false, AFTER_DRAIN = false;
    float* C; int ldc;
    __device__ __forceinline__ void operator()(const pg8::f32x4 (&acc)[2][2][4][2], const pg8::Unit& u, int wr, int wc, int fr, int fq) const {
        const int row0 = u.pm * 256 + wr * 64 + fr, col0 = u.pn * 256 + wc * 32 + 4 * fq;
#pragma unroll
        for (int ai = 0; ai < 2; ++ai)
#pragma unroll
            for (int m = 0; m < 4; ++m) { float* rowp = C + (size_t)(row0 + ai * 128 + m * 16) * ldc + col0;
#pragma unroll
                for (int bj = 0; bj < 2; ++bj)
#pragma unroll
                    for (int n = 0; n < 2; ++n) { pg8::f32x4* p = (pg8::f32x4*)(rowp + bj * 128 + n * 16); *p = *p + acc[ai][bj][m][n]; } }
    }
};

template <int L> __device__ __forceinline__ int srccol(int n) {
    if (n >= n1pad(L)) return n1real(L) + (n - n1pad(L));
    if (n >= n1real(L)) return -1;
    const int mode = proj_mode<L>(n >> 5);
    if (mode == 1 || mode == 3) { const int w = n & 127; return (n & ~127) + 64 * ((w >> 2) & 1) + 4 * (w >> 3) + (w & 3); }
    if (mode == 2) { const int r = n - A_IQ, w = r & 63; return A_IQ + (r & ~63) + 32 * ((w >> 2) & 1) + 4 * (w >> 3) + (w & 3); }
    return n;
}
template <int L  > __device__ __forceinline__ void conv_item(const float* W, int Nsrc, bf16* WT, int Kdim, int nblk, int item, LAS float* scr, int lane) {
    const int kb = item / nblk, nb = item % nblk, k0 = 32 * kb, n0 = 64 * nb;
    int src = n0 + 4 * (lane & 15); if (L >= 0) src = srccol<(L < 0 ? 0 : L)>(src);
    pg8::f32x4 v[8];
#pragma unroll
    for (int i = 0; i < 8; ++i) { const int kk = 4 * i + (lane >> 4); v[i] = (src >= 0) ? *(const pg8::f32x4*)(W + (size_t)(k0 + kk) * Nsrc + src) : (pg8::f32x4){0.f, 0.f, 0.f, 0.f}; }
#pragma unroll
    for (int i = 0; i < 8; ++i) { const int kk = 4 * i + (lane >> 4); *(LAS pg8::f32x4*)(scr + kk * 68 + 4 * (lane & 15)) = v[i]; }
    LDS_WAIT();
    const int c = lane & 3;
#pragma unroll
    for (int j = 0; j < 4; ++j) { const int n = (lane >> 2) + 16 * j; const LAS float* s = scr + (8 * c) * 68 + n;
        pg8::u32x4 o; o.x = pk2(s[0 * 68], s[1 * 68]); o.y = pk2(s[2 * 68], s[3 * 68]); o.z = pk2(s[4 * 68], s[5 * 68]); o.w = pk2(s[6 * 68], s[7 * 68]);
        *(pg8::u32x4*)(WT + (size_t)(n0 + n) * Kdim + k0 + 8 * c) = o; }
    LDS_WAIT();
}
template <int L> __device__ __forceinline__ void conv_weights(Frame& F) {
    PHASE_IDS();
    LAS float* scr = (LAS float*)(F.lds + wave * 16384);
    const int gw = blockIdx.x * NWAVES + wave, NGW = F.G * NWAVES;
    constexpr int NB_IN = (n1pad(L) + 2048) / 64, I_IN = NB_IN * (1024 / 32), NB_OUT = 1024 / 64, I_OUT = NB_OUT * (2048 / 32);
    for (int it = gw; it < I_IN + I_OUT; it += NGW) {
        if (it < I_IN) conv_item<L>(F.w_in[L], nsrc(L), F.WIN, 1024, NB_IN, it, scr, lane);
        else conv_item<-1>(F.w_out[L], 1024, F.WOUT, 2048, NB_OUT, it - I_IN, scr, lane);
    }
}
__device__ __forceinline__ void norm_rows(Frame& F, const float* src, const float* g, float* copy_to) {
    PHASE_IDS();
    const int gw = blockIdx.x * NWAVES + wave, NGW = F.G * NWAVES;
    float4 gg[4];
#pragma unroll
    for (int j = 0; j < 4; ++j) gg[j] = ((const float4*)g)[lane + 64 * j];
    for (int row = gw; row < MTOK; row += 2 * NGW) {
        const int row2 = row + NGW;
        const float4* xa = (const float4*)(src + (size_t)row * D_MODEL) + lane; const float4* xb = (const float4*)(src + (size_t)row2 * D_MODEL) + lane;
        float4 va[4], vb[4]; float sa = 0.f, sb = 0.f;
#pragma unroll
        for (int j = 0; j < 4; ++j) { va[j] = xa[64 * j]; vb[j] = xb[64 * j]; }
#pragma unroll
        for (int j = 0; j < 4; ++j) { sa += va[j].x * va[j].x + va[j].y * va[j].y + va[j].z * va[j].z + va[j].w * va[j].w; sb += vb[j].x * vb[j].x + vb[j].y * vb[j].y + vb[j].z * vb[j].z + vb[j].w * vb[j].w; }
        const float ra = rsqrtf(wave_sum(sa) * (1.f / D_MODEL) + 1e-6f), rb = rsqrtf(wave_sum(sb) * (1.f / D_MODEL) + 1e-6f);
#pragma unroll
        for (int j = 0; j < 4; ++j) {
            if (copy_to) { ((float4*)(copy_to + (size_t)row * D_MODEL))[lane + 64 * j] = va[j]; ((float4*)(copy_to + (size_t)row2 * D_MODEL))[lane + 64 * j] = vb[j]; }
            uint2 o; o.x = pk2(va[j].x * ra * gg[j].x, va[j].y * ra * gg[j].y); o.y = pk2(va[j].z * ra * gg[j].z, va[j].w * ra * gg[j].w);
            *(uint2*)(F.U + (size_t)row * D_MODEL + (lane + 64 * j) * 4) = o;
            uint2 o2; o2.x = pk2(vb[j].x * rb * gg[j].x, vb[j].y * rb * gg[j].y); o2.y = pk2(vb[j].z * rb * gg[j].z, vb[j].w * rb * gg[j].w);
            *(uint2*)(F.U + (size_t)row2 * D_MODEL + (lane + 64 * j) * 4) = o2;
        }
    }
}
__device__ __forceinline__ void final_rows(Frame& F) {
    PHASE_IDS();
    const int gw = blockIdx.x * NWAVES + wave, NGW = F.G * NWAVES;
    for (int row = gw; row < MTOK; row += NGW) {
        float4* xr = (float4*)(F.H + (size_t)row * D_MODEL) + lane;
        float4 v[4]; float s = 0.f;
#pragma unroll
        for (int j = 0; j < 4; ++j) { v[j] = xr[64 * j]; s += v[j].x * v[j].x + v[j].y * v[j].y + v[j].z * v[j].z + v[j].w * v[j].w; }
        const float r = rsqrtf(wave_sum(s) * (1.f / D_MODEL) + 1e-6f);
#pragma unroll
        for (int j = 0; j < 4; ++j) { const float4 gg = ((const float4*)F.final_g)[lane + 64 * j]; xr[64 * j] = make_float4(v[j].x * r * gg.x, v[j].y * r * gg.y, v[j].z * r * gg.z, v[j].w * r * gg.w); }
    }
}
__device__ __forceinline__ void make_tables(Frame& F) {
    PHASE_IDS();
    const int gt = blockIdx.x * 512 + tid, NT = F.G * 512;
    for (int i = gt; i < 2048 * 64; i += NT) {
        { const int pos = i >> 6, f = i & 63; const float freq = exp2f(-((float)(2 * f) / 128.f) * 13.287712379549449f);
          double rev = (double)pos * (double)freq * 0.15915494309189535; rev -= floor(rev);
          F.cos128[i] = __builtin_amdgcn_cosf((float)rev); F.sin128[i] = __builtin_amdgcn_sinf((float)rev); }
        if (i < 2048 * 32) { const int pos = i >> 5, f = i & 31; const float freq = exp2f(-((float)(2 * f) / 64.f) * 13.287712379549449f);
          double rev = (double)pos * (double)freq * 0.15915494309189535; rev -= floor(rev);
          F.cos64[i] = __builtin_amdgcn_cosf((float)rev); F.sin64[i] = __builtin_amdgcn_sinf((float)rev); }
        if (i < 2048) { const float l0 = F.lb_logits[i], l1 = F.lb_logits[2048 + i], l2 = F.lb_logits[4096 + i], l3 = F.lb_logits[6144 + i];
          const float m = fmaxf(fmaxf(l0, l1), fmaxf(l2, l3)); const float e0 = __expf(l0 - m), e1 = __expf(l1 - m), e2 = __expf(l2 - m), e3 = __expf(l3 - m);
          F.lb[i] = (e1 + e2 + e3) / (e0 + e1 + e2 + e3); }
    }
}
namespace att {
constexpr int D = 128;
constexpr float THR = 8.f;
constexpr bool WSKIP = false;
constexpr float SCALE = 0.08838834764831845f;
constexpr int NW = 8, QBLK = 32, KVBLK = 64, QB = NW * QBLK;
constexpr int SHM_V = KVBLK * D * 2, SHM_K = KVBLK * D * 2;
constexpr int LDS_BYTES = 2 * SHM_V + 2 * SHM_K + NW * 64 * 4;
typedef short bf16x8 __attribute__((ext_vector_type(8)));
typedef short s16x4 __attribute__((ext_vector_type(4)));
typedef float f32x16 __attribute__((ext_vector_type(16)));
typedef float f32x4 __attribute__((ext_vector_type(4)));
typedef unsigned u32x4 __attribute__((ext_vector_type(4)));
template <class A, class Bt> struct same_t { static constexpr bool v = false; };
template <class A> struct same_t<A, A> { static constexpr bool v = true; };
#define KSWZ(row, colB) ((row) * 256 + ((colB) ^ (((row) & 7) << 4)))
#define SBAR() __builtin_amdgcn_sched_barrier(0)
__device__ __forceinline__ int v_st(int k, int c) { const int kk = (k & ~0xC) | ((k & 4) << 1) | ((k & 8) >> 1); return ((kk >> 3) * 4 + (c >> 5)) * 512 + ((kk & 7) * 32 + (c & 31)) * 2; }
__device__ __forceinline__ int v_rd_base(int lane) { return ((lane & 3) << 3) | (((lane >> 2) & 3) << 6) | (((lane >> 4) & 1) << 5) | (((lane >> 5) & 1) << 8); }
constexpr int v_rd_off(int d0, int ks, int half) { return d0 * 512 + ks * 4096 + half * 2048; }
__device__ __forceinline__ int crow(int r, int hi) { return (r & 3) + 8 * (r >> 2) + 4 * hi; }
__device__ __forceinline__ unsigned cvtpk(float lo, float hi) {
    unsigned r; asm volatile("v_cvt_pk_bf16_f32 %0, %1, %2" : "=v"(r) : "v"(lo), "v"(hi)); return r;
}
__device__ __forceinline__ bf16x8 pack8(f32x4 a, f32x4 b) {
    u32x4 w = {cvtpk(a[0], a[1]), cvtpk(a[2], a[3]), cvtpk(b[0], b[1]), cvtpk(b[2], b[3])};
    return *reinterpret_cast<bf16x8*>(&w);
}
template <class T> __device__ __forceinline__ bf16x8 load8(const T* p) {
    if constexpr (same_t<T, float>::v) { return pack8(*(const f32x4*)p, *(const f32x4*)(p + 4)); }
    else { return *reinterpret_cast<const bf16x8*>(p); }
}
__device__ __forceinline__ void mask_bits(f32x16& p0, f32x16& p1, unsigned w0, unsigned w1) {
    const float NEG = -__builtin_inff();
#pragma unroll
    for (int r = 0; r < 16; ++r) { const int c = (r & 3) + 8 * (r >> 2); if (!((w0 >> c) & 1u)) p0[r] = NEG; if (!((w1 >> c) & 1u)) p1[r] = NEG; }
}
__device__ __forceinline__ float wmult(float s, int d) {
    const unsigned ud = (unsigned)d; const int cnt = (ud <= 128u ? 1 : 0) + ((((d & 3) == 0) && ud <= 512u) ? 1 : 0) + ((((d & 15) == 0) && d >= 0) ? 1 : 0);
    const float add = cnt >= 3 ? 12.4293792f : (cnt == 2 ? 7.84206515f : 0.f);
    return cnt == 0 ? -__builtin_inff() : s + add;
}
__device__ __forceinline__ void mask_mult(f32x16& p0, f32x16& p1, int dq) {
#pragma unroll
    for (int r = 0; r < 16; ++r) { const int c = (r & 3) + 8 * (r >> 2); p0[r] = wmult(p0[r], dq - c); p1[r] = wmult(p1[r], dq - c - 32); }
}
__device__ __forceinline__ void mask_far(f32x16& p0, f32x16& p1, int dq) {
    const float NEG = -__builtin_inff(); const int dm = dq & 15;
#pragma unroll
    for (int r = 0; r < 16; ++r) { const int c = ((r & 3) + 8 * (r >> 2)) & 15; const float v = (dm == c) ? 0.f : NEG; p0[r] += v; p1[r] += v; }
}
__device__ __forceinline__ void mask_mid(f32x16& p0, f32x16& p1, int dq) {
    const float NEG = -__builtin_inff(); const int dm = dq & 15, d4 = dq & 3;
#pragma unroll
    for (int r = 0; r < 16; ++r) { const int c = ((r & 3) + 8 * (r >> 2)) & 15; const float v = (dm == c) ? 7.84206515f : ((d4 == (r & 3)) ? 0.f : NEG); p0[r] += v; p1[r] += v; }
}
__device__ __forceinline__ void mask_near(f32x16& p0, f32x16& p1, int dq) {
    const int dm = dq & 15, d4 = dq & 3;
#pragma unroll
    for (int r = 0; r < 16; ++r) { const int c = ((r & 3) + 8 * (r >> 2)) & 15; const float v = (dm == c) ? 12.4293792f : ((d4 == (r & 3)) ? 7.84206515f : 0.f); p0[r] += v; p1[r] += v; }
}
__device__ __forceinline__ void partialSM(f32x16& p0, f32x16& p1, float& m_reg, float& mn, float& alpha) {
    float pmax = p0[0]; for (int r = 1; r < 16; ++r) pmax = fmaxf(pmax, p0[r]); for (int r = 0; r < 16; ++r) pmax = fmaxf(pmax, p1[r]);
    { auto rr = __builtin_amdgcn_permlane32_swap(__float_as_uint(pmax), __float_as_uint(pmax), false, false);
      pmax = fmaxf(__uint_as_float(rr[0]), __uint_as_float(rr[1])); }
    constexpr float C2 = 1.4426950408889634f * SCALE;
    if (__builtin_expect(__all((pmax - m_reg) * SCALE <= THR), 1)) { mn = m_reg; alpha = 1.f; }
    else { mn = fmaxf(m_reg, pmax); alpha = __builtin_amdgcn_exp2f((m_reg - mn) * C2); m_reg = mn; }
    const float mnL = -mn * C2;
    for (int r = 0; r < 16; ++r) p0[r] = fmaf(p0[r], C2, mnL); for (int r = 0; r < 16; ++r) p1[r] = fmaf(p1[r], C2, mnL);
    for (int r = 0; r < 16; ++r) p0[r] = __builtin_amdgcn_exp2f(p0[r]);
}
__device__ __forceinline__ void finishSM(f32x16& p0, f32x16& p1, float alpha, float& l_reg, bf16x8& pa0, bf16x8& pa1, bf16x8& pa2, bf16x8& pa3) {
    for (int r = 0; r < 16; ++r) p1[r] = __builtin_amdgcn_exp2f(p1[r]);
    float ps = 0; for (int r = 0; r < 16; ++r) ps += p0[r]; for (int r = 0; r < 16; ++r) ps += p1[r];
    { auto rr = __builtin_amdgcn_permlane32_swap(__float_as_uint(ps), __float_as_uint(ps), false, false);
      ps = __uint_as_float(rr[0]) + __uint_as_float(rr[1]); }
    l_reg = l_reg * alpha + ps;
#define PK4(P, B_, OUT) do { unsigned a0 = cvtpk(P[B_+0], P[B_+1]), a1 = cvtpk(P[B_+2], P[B_+3]);                          \
        unsigned b0 = cvtpk(P[B_+4], P[B_+5]), b1 = cvtpk(P[B_+6], P[B_+7]);                                             \
        auto r0 = __builtin_amdgcn_permlane32_swap(a0, b0, false, false); auto r1 = __builtin_amdgcn_permlane32_swap(a1, b1, false, false); \
        u32x4 w = {r0[0], r1[0], r0[1], r1[1]}; OUT = *reinterpret_cast<bf16x8*>(&w); } while (0)
    PK4(p0, 0, pa0); PK4(p0, 8, pa1); PK4(p1, 0, pa2); PK4(p1, 8, pa3);
#undef PK4
}
template <int KB, bool SK>
__device__ __forceinline__ void qkt(f32x16& p0, f32x16& p1, const char* K_lds, int r32, int hi, const bf16x8* qr, bool act) {
    if (SK && !act) { const float NEG = -__builtin_inff();
#pragma unroll
        for (int r = 0; r < 16; ++r) { p0[r] = NEG; p1[r] = NEG; } return; }
    p0 = f32x16{}; p1 = f32x16{};
    const char* kb[4];
#pragma unroll
    for (int dd = 0; dd < 4; ++dd) kb[dd] = K_lds + KB * SHM_K + KSWZ(r32, (dd * 16 + hi * 8) * 2);
#pragma unroll
    for (int d0 = 0; d0 < 8; ++d0) { const char* a = kb[d0 & 3] + (d0 >> 2) * 128;
        bf16x8 b0 = *reinterpret_cast<const bf16x8*>(a);
        bf16x8 b1 = *reinterpret_cast<const bf16x8*>(a + 32 * 256);
        p0 = __builtin_amdgcn_mfma_f32_32x32x16_bf16(b0, qr[d0], p0, 0, 0, 0);
        p1 = __builtin_amdgcn_mfma_f32_32x32x16_bf16(b1, qr[d0], p1, 0, 0, 0); }
}
template <int VB, bool SK>
__device__ __forceinline__ void pv_tile(f32x16* o, int vb0, bf16x8 pa0, bf16x8 pa1, bf16x8 pa2, bf16x8 pa3, bool act) {
    if (SK && !act) return;
#define TRRD(dst, off) asm volatile("ds_read_b64_tr_b16 %0, %1 offset:%2" : "=&v"(dst) : "v"(vb0), "i"(off) : "memory")
#define PV_D0(d0) do { s16x4 l0, l1, l2, l3, h0, h1, h2, h3; constexpr int b_ = VB * SHM_V + v_rd_off(d0, 0, 0);     \
        TRRD(l0, b_); TRRD(h0, b_ + 2048); TRRD(l1, b_ + 4096); TRRD(h1, b_ + 6144); TRRD(l2, b_ + 8192); TRRD(h2, b_ + 10240); TRRD(l3, b_ + 12288); TRRD(h3, b_ + 14336); \
        asm volatile("s_waitcnt lgkmcnt(0)" ::: "memory"); SBAR();                 \
        o[d0] = __builtin_amdgcn_mfma_f32_32x32x16_bf16(pa0, (bf16x8){l0[0], l0[1], l0[2], l0[3], h0[0], h0[1], h0[2], h0[3]}, o[d0], 0, 0, 0);   \
        o[d0] = __builtin_amdgcn_mfma_f32_32x32x16_bf16(pa1, (bf16x8){l1[0], l1[1], l1[2], l1[3], h1[0], h1[1], h1[2], h1[3]}, o[d0], 0, 0, 0);   \
        o[d0] = __builtin_amdgcn_mfma_f32_32x32x16_bf16(pa2, (bf16x8){l2[0], l2[1], l2[2], l2[3], h2[0], h2[1], h2[2], h2[3]}, o[d0], 0, 0, 0);   \
        o[d0] = __builtin_amdgcn_mfma_f32_32x32x16_bf16(pa3, (bf16x8){l3[0], l3[1], l3[2], l3[3], h3[0], h3[1], h3[2], h3[3]}, o[d0], 0, 0, 0); } while (0)
    PV_D0(0); PV_D0(1); PV_D0(2); PV_D0(3);
#undef PV_D0
#undef TRRD
}
template <class TIn, class TOut> struct BlockRef { const TIn* Q; const TIn* K; const TIn* V; TOut* O; const unsigned* M; int P0; };
template <class TIn> struct Seam {
    bf16x8 qr[8];
    bf16x8 st_v0, st_v1, st_k0, st_k1; f32x4 sf0, sf1, sf2, sf3;
    f32x4 tq[16];
};
__device__ __forceinline__ int swa_jlo(int P0, int W) { const int lowk = P0 - W + 1; return lowk > 0 ? lowk / KVBLK : 0; }
#define ROW(p, k0, rr) ((p) + (size_t)((k0) + (rr)) * RSK + sc)
#define VMW() asm volatile("s_waitcnt vmcnt(0)" ::: "memory")
#define VMWN(n) asm volatile("s_waitcnt vmcnt(%0)" :: "i"(n) : "memory")
#define SLOAD_H(Kp, Vp, k0) do { S.st_v0 = load8<TIn>(ROW(Vp, k0, sr)); S.st_v1 = load8<TIn>(ROW(Vp, k0, 32 + sr));              \
                         S.st_k0 = load8<TIn>(ROW(Kp, k0, sr)); S.st_k1 = load8<TIn>(ROW(Kp, k0, 32 + sr)); } while (0)
#define SWRITE_HK(bf) do { *(bf16x8*)(K_lds + (bf) * SHM_K + kws) = S.st_k0; *(bf16x8*)(K_lds + (bf) * SHM_K + kws + 32 * 256) = S.st_k1; } while (0)
#define SWRITE_HV(bf) do { *(bf16x8*)(V_lds + (bf) * SHM_V + vst0) = S.st_v0; *(bf16x8*)(V_lds + (bf) * SHM_V + vst1) = S.st_v1; } while (0)
#define SWRITE_H(bf) do { SWRITE_HV(bf); SWRITE_HK(bf); } while (0)
#define SLOAD_F(p, k0) do { S.sf0 = *(const f32x4*)ROW(p, k0, sr); S.sf1 = *(const f32x4*)(ROW(p, k0, sr) + 4);                \
                            S.sf2 = *(const f32x4*)ROW(p, k0, 32 + sr); S.sf3 = *(const f32x4*)(ROW(p, k0, 32 + sr) + 4); } while (0)
#define SWRITE_KF(bf) do { *(bf16x8*)(K_lds + (bf) * SHM_K + kws) = pack8(S.sf0, S.sf1); *(bf16x8*)(K_lds + (bf) * SHM_K + kws + 32 * 256) = pack8(S.sf2, S.sf3); } while (0)
#define SWRITE_VF(bf) do { *(bf16x8*)(V_lds + (bf) * SHM_V + vst0) = pack8(S.sf0, S.sf1); *(bf16x8*)(V_lds + (bf) * SHM_V + vst1) = pack8(S.sf2, S.sf3); } while (0)
template <class TIn, class TOut, int RSQ, int RSK, int MK>
__device__ __forceinline__ void causal_swa_prime(const BlockRef<TIn, TOut>& cur, int W, char* lds, Seam<TIn>& S) {
    constexpr bool F32 = same_t<TIn, float>::v;
    int tid_o = threadIdx.x; asm volatile("" : "+v"(tid_o)); const int tid = tid_o, wid = __builtin_amdgcn_readfirstlane(tid >> 6), lane = tid & 63, r32 = lane & 31, hi = lane >> 5;
    const int sr = tid >> 4, sc = (tid & 15) * 8, kws = KSWZ(sr, sc * 2); char* K_lds = lds + 2 * SHM_V;
    const int kb0 = swa_jlo(cur.P0, W) * KVBLK;
    for (int d0 = 0; d0 < 8; ++d0) S.qr[d0] = load8<TIn>(cur.Q + (size_t)(wid * QBLK + r32) * RSQ + d0 * 16 + hi * 8);
    if constexpr (F32) { SLOAD_F((const float*)cur.K, kb0); VMW(); SWRITE_KF(0); SBAR(); SLOAD_F((const float*)cur.V, kb0); }
    else { SLOAD_H(cur.K, cur.V, kb0); VMW(); SWRITE_HK(0); }
    __syncthreads();
}
template <class TIn, class TOut, int RSQ, int RSK, int MK>
__device__ __forceinline__ void causal_swa_block(const BlockRef<TIn, TOut>& cur, const BlockRef<TIn, TOut>& nxt, int skv, int W, char* lds, Seam<TIn>& S) {
    constexpr bool F32 = same_t<TIn, float>::v;
    int tid_o = threadIdx.x; asm volatile("" : "+v"(tid_o)); const int tid = tid_o, wid = __builtin_amdgcn_readfirstlane(tid >> 6), lane = tid & 63, r32 = lane & 31, hi = lane >> 5;
    const int j_lo = swa_jlo(cur.P0, W);
    int j_hi = (cur.P0 + QB - 1) / KVBLK + 1; if (j_hi > skv / KVBLK) j_hi = skv / KVBLK;
    const int NT = j_hi - j_lo;
    const int kbn = swa_jlo(nxt.P0, W) * KVBLK;
    const int qlo = cur.P0 + wid * QBLK, qm = qlo + r32 - 4 * hi;
    const unsigned* mrow = (MK == 0) ? cur.M + (size_t)(wid * QBLK + r32) * 64 : nullptr; uint2 mw = make_uint2(0u, 0u); if constexpr (MK == 0) mw = *(const uint2*)(mrow + 2 * j_lo);
    char* V_lds = lds; char* K_lds = lds + 2 * SHM_V;
    float* ws = (float*)(lds + 2 * SHM_V + 2 * SHM_K) + wid * 64; float* li_l = ws, * al_l = ws + 32;
    float m_reg = -1e30f, l_reg = 0; f32x16 o[4] = {};
    const int sr = tid >> 4, sc = (tid & 15) * 8, vst0 = v_st(sr, sc), vst1 = v_st(32 + sr, sc), kws = KSWZ(sr, sc * 2);
    const int vb0 = (int)(uintptr_t)V_lds + v_rd_base(lane);
    const TIn* Kh = cur.K; const TIn* Vh = cur.V;
#define RESC(a) do { if (__any((a) < 1.f)) { if (hi == 0) al_l[r32] = (a); asm volatile("s_waitcnt lgkmcnt(0)" ::: "memory");              \
                     for (int d_ = 0; d_ < 4; ++d_) for (int r = 0; r < 16; ++r) o[d_][r] *= al_l[crow(r, hi)]; } } while (0)
#define KBASE(t) ((j_lo + (t)) * KVBLK)
#define ACT(t) (KBASE(t) <= qlo + QBLK - 1 && KBASE(t) + KVBLK - 1 >= qlo - W + 1)
#define MASKT(P0_, P1_, t) do { const int kb_ = KBASE(t); \
        if constexpr (MK == 1) { const int dmin_ = qlo - (kb_ + KVBLK - 1), dmax_ = qlo + QBLK - 1 - kb_; \
            if (dmin_ > 512) mask_far(P0_, P1_, qm - kb_); else if (dmin_ > 128 && dmax_ <= 512) mask_mid(P0_, P1_, qm - kb_); \
            else if (dmin_ >= 0 && dmax_ <= 128) mask_near(P0_, P1_, qm - kb_); else mask_mult(P0_, P1_, qm - kb_); } \
        else { mask_bits(P0_, P1_, mw.x >> (4 * hi), mw.y >> (4 * hi)); const int tn_ = ((t) + 1 < NT) ? (t) + 1 : (t); mw = *(const uint2*)(mrow + 2 * (j_lo + tn_)); } } while (0)
    constexpr int NQL = F32 ? 16 : 8;
    constexpr bool SK = WSKIP && !F32;
#define SEAM_K0() do { VMWN(NQL); if constexpr (F32) { SWRITE_KF(0); SBAR(); SLOAD_F((const float*)nxt.V, kbn); } else { SWRITE_HK(0); } SBAR(); } while (0)
    f32x16 pA0, pA1, pB0, pB1; float mnA, mnB, alA, alB; bf16x8 pa0, pa1, pa2, pa3;
    if constexpr (F32) { VMW(); SWRITE_VF(0); SBAR(); } else { SWRITE_HV(0); SBAR(); }
    if (NT > 1) { if constexpr (F32) SLOAD_F((const float*)Kh, KBASE(1)); else SLOAD_H(Kh, Vh, KBASE(1)); }
    SBAR(); qkt<0, SK>(pA0, pA1, K_lds, r32, hi, S.qr, ACT(0));
    if constexpr (F32) { if (NT > 1) { VMW(); SWRITE_KF(1); SBAR(); SLOAD_F((const float*)Vh, KBASE(1)); } }
    MASKT(pA0, pA1, 0); partialSM(pA0, pA1, m_reg, mnA, alA);
    if (NT > 1) { VMW(); if constexpr (F32) { SWRITE_VF(1); SBAR(); if (NT > 2) SLOAD_F((const float*)Kh, KBASE(2)); } else SWRITE_H(1); }
    __syncthreads();
#define HALF_STEP(PX0, PX1, mnX, alX, PY0, PY1, alY, t, KB, VB, SB) do {                                                      \
        SBAR(); qkt<KB, SK>(PX0, PX1, K_lds, r32, hi, S.qr, ACT(t));                                             \
        finishSM(PY0, PY1, alY, l_reg, pa0, pa1, pa2, pa3); SBAR();                                                           \
        if ((t) + 1 < NT) { if constexpr (F32) { VMW(); SWRITE_KF(SB); SBAR(); SLOAD_F((const float*)Vh, KBASE((t) + 1)); }  \
                            else { SLOAD_H(Kh, Vh, KBASE((t) + 1)); } SBAR(); }                                               \
        pv_tile<VB, SK>(o, vb0, pa0, pa1, pa2, pa3, ACT((t) - 1)); MASKT(PX0, PX1, (t)); partialSM(PX0, PX1, m_reg, mnX, alX);                                        \
        __syncthreads();                                                                                                      \
        if ((t) + 1 < NT) { VMW(); if constexpr (F32) { SWRITE_VF(SB); SBAR(); if ((t) + 2 < NT) SLOAD_F((const float*)Kh, KBASE((t) + 2)); } \
                            else { SWRITE_H(SB); } }                                                                          \
        RESC(alX); __syncthreads(); } while (0)
    for (int t = 1; t + 1 < NT; t += 2) {
        HALF_STEP(pB0, pB1, mnB, alB, pA0, pA1, alA, t, 1, 0, 0);
        HALF_STEP(pA0, pA1, mnA, alA, pB0, pB1, alB, t + 1, 0, 1, 1);
    }
    const bool even = (NT & 1) == 0;
    if (even) { SBAR(); qkt<1, SK>(pB0, pB1, K_lds, r32, hi, S.qr, ACT(NT - 1)); SBAR(); }
#define QROW(e) (nxt.Q + (size_t)(wid * QBLK + r32) * RSQ + ((e) >> 1) * 16 + hi * 8 + ((e) & 1) * 4)
    if constexpr (F32) { SLOAD_F((const float*)nxt.K, kbn); SBAR();
#pragma unroll
        for (int e = 0; e < 8; ++e) S.tq[e] = *(const f32x4*)QROW(e); }
    else { SLOAD_H(nxt.K, nxt.V, kbn); SBAR();
#pragma unroll
        for (int d0 = 0; d0 < 8; ++d0) S.qr[d0] = load8<TIn>(nxt.Q + (size_t)(wid * QBLK + r32) * RSQ + d0 * 16 + hi * 8); }
    SBAR();
    finishSM(pA0, pA1, alA, l_reg, pa0, pa1, pa2, pa3); SBAR();
    if constexpr (F32) {
#pragma unroll
        for (int e = 8; e < 16; ++e) S.tq[e] = *(const f32x4*)QROW(e); SBAR(); }
#undef QROW
    pv_tile<0, SK>(o, vb0, pa0, pa1, pa2, pa3, ACT(even ? NT - 2 : NT - 1));
    if (even) { MASKT(pB0, pB1, NT - 1); partialSM(pB0, pB1, m_reg, mnB, alB); __syncthreads(); RESC(alB);
        finishSM(pB0, pB1, alB, l_reg, pa0, pa1, pa2, pa3); SBAR(); pv_tile<1, SK>(o, vb0, pa0, pa1, pa2, pa3, ACT(NT - 1)); }
    SBAR(); SEAM_K0();
    if (hi == 0) li_l[r32] = l_reg; asm volatile("s_waitcnt lgkmcnt(0)" ::: "memory");
    float rli[16];
#pragma unroll
    for (int r = 0; r < 16; ++r) rli[r] = __builtin_amdgcn_rcpf(li_l[crow(r, hi)]);
    TOut* Ow = cur.O + (size_t)(wid * QBLK) * RSQ;
#pragma unroll
    for (int r = 0; r < 16; ++r) { const int orow = crow(r, hi);
#pragma unroll
        for (int d0 = 0; d0 < 4; ++d0) { const float v = o[d0][r] * rli[r];
            if constexpr (same_t<TOut, float>::v) { Ow[(size_t)orow * RSQ + d0 * 32 + r32] = v; }
            else { const float vn = __int_as_float(__builtin_amdgcn_update_dpp(__float_as_int(v), __float_as_int(v), 0xB1, 0xf, 0xf, false));
                   if ((r32 & 1) == 0) *(unsigned*)(Ow + (size_t)orow * RSQ + d0 * 32 + r32) = cvtpk(v, vn); } } }
    if constexpr (F32) {
#pragma unroll
        for (int d0 = 0; d0 < 8; ++d0) S.qr[d0] = pack8(S.tq[2 * d0], S.tq[2 * d0 + 1]); }
    __syncthreads();
#undef RESC
#undef KBASE
#undef ACT
#undef MASKT
#undef SEAM_K0
#undef HALF_STEP
}
#undef ROW
#undef VMW
#undef VMWN
#undef SLOAD_H
#undef SWRITE_HK
#undef SWRITE_HV
#undef SWRITE_H
#undef SLOAD_F
#undef SWRITE_KF
#undef SWRITE_VF
}

__device__ __forceinline__ unsigned fkey(float f) { const unsigned u = __float_as_uint(f + 0.0f); return (u & 0x80000000u) ? ~u : (u | 0x80000000u); }

__device__ __forceinline__ void naive_index_topk(Frame& F) {
    PHASE_IDS();
    const bf16* P = F.P; constexpr int ldp = n1pad(0);
    LAS float* iq = (LAS float*)F.lds; LAS float* iw = iq + 1024; LAS float* sc = iw + 16; LAS unsigned* mw = (LAS unsigned*)(sc + 2048); LAS unsigned* cnt = mw + 64;
    for (int row = blockIdx.x; row < MTOK; row += F.G) {
        const int t = row & (SEQ - 1), rb = row - t;
        for (int i = tid; i < 1024; i += 512) iq[i] = bf2f(P[(size_t)row * ldp + A_IQ + i]);
        if (tid < 16) iw[tid] = bf2f(P[(size_t)row * ldp + A_IW + tid]) * (1.f / 32.f);
        if (tid < 64) mw[tid] = 0u;
        __syncthreads();
        for (int s = tid; s <= t; s += 512) {
            const uint4* kp = (const uint4*)(P + (size_t)(rb + s) * ldp + A_IK);
            float kk[64];
#pragma unroll
            for (int c = 0; c < 8; ++c) { const uint4 r = kp[c]; const unsigned w[4] = {r.x, r.y, r.z, r.w};
#pragma unroll
                for (int j = 0; j < 4; ++j) { kk[c * 8 + 2 * j] = __uint_as_float(w[j] << 16); kk[c * 8 + 2 * j + 1] = __uint_as_float(w[j] & 0xffff0000u); } }
            float score = 0.f;
            for (int h = 0; h < 16; ++h) { float d = 0.f;
#pragma unroll
                for (int j = 0; j < 64; ++j) d = fmaf(iq[h * 64 + j], kk[j], d);
                score += fmaxf(d, 0.f) * iw[h]; }
            sc[s] = score;
        }
        __syncthreads();
        if (t + 1 <= 256) { for (int s = tid; s <= t; s += 512) atomicOr((unsigned*)&mw[s >> 5], 1u << (s & 31)); }
        else {
            unsigned myk[4];
#pragma unroll
            for (int j = 0; j < 4; ++j) { const int s = tid + 512 * j; myk[j] = (s <= t) ? fkey(sc[s]) : 0u; }
            unsigned prefix = 0u;
            for (int bit = 31; bit >= 0; --bit) {
                const unsigned cand = prefix | (1u << bit); unsigned c = 0;
#pragma unroll
                for (int j = 0; j < 4; ++j) c += (myk[j] >= cand) ? 1u : 0u;
                if (tid == 0) *cnt = 0u;
                __syncthreads(); if (c) atomicAdd((unsigned*)cnt, c); __syncthreads();
                const unsigned total = *cnt; __syncthreads();
                if (total >= 256u) prefix = cand;
            }
            unsigned cg = 0, ce = 0;
#pragma unroll
            for (int j = 0; j < 4; ++j) { cg += (myk[j] > prefix) ? 1u : 0u; ce += (myk[j] == prefix) ? 1u : 0u; }
            if (tid == 0) *cnt = 0u;
            __syncthreads(); atomicAdd((unsigned*)cnt, cg | (ce << 16)); __syncthreads();
            const unsigned tot = *cnt; const int n_gt = (int)(tot & 0xffffu), n_eq = (int)(tot >> 16); const int need = 256 - n_gt;
#pragma unroll
            for (int j = 0; j < 4; ++j) { const int s = tid + 512 * j; if (myk[j] > prefix || (myk[j] == prefix && n_eq == need)) atomicOr((unsigned*)&mw[s >> 5], 1u << (s & 31)); }
            if (n_eq != need && tid == 0) { int left = need; for (int s = 0; s <= t && left > 0; ++s) if (fkey(sc[s]) == prefix) { atomicOr((unsigned*)&mw[s >> 5], 1u << (s & 31)); --left; } }
        }
        __syncthreads();
        if (tid < 64) F.mask[(size_t)row * 64 + tid] = mw[tid];
        __syncthreads();
    }
}

template <int MODE> __device__ __forceinline__ void naive_attn(Frame& F, int ldp, int koff, int voff, int kvhs) {
    PHASE_IDS();
    bf16* P = F.P; const int wv = wave;
    LAS int* keys = (LAS int*)F.lds; LAS float* qs = (LAS float*)(keys + 400); LAS float* sc = qs + 2048; LAS float* linv = sc + 16 * 400; LAS int* pre = (LAS int*)(linv + 16); LAS int* nk_s = pre + 64;
    for (int row = blockIdx.x; row < MTOK; row += F.G) {
        const int t = row & (SEQ - 1), rb = row - t;
        for (int i = tid; i < 2048; i += 512) qs[i] = bf2f(P[(size_t)row * ldp + i]);
        if (MODE == 0) {
            unsigned w = 0; if (tid < 64) { w = F.mask[(size_t)row * 64 + tid]; pre[tid] = __popc(w); }
            __syncthreads();
            if (tid == 0) { int run = 0; for (int i = 0; i < 64; ++i) { const int x = pre[i]; pre[i] = run; run += x; } *nk_s = run; }
            __syncthreads();
            if (tid < 64) { int pos = pre[tid]; while (w) { const int b = __ffs(w) - 1; keys[pos++] = tid * 32 + b; w &= w - 1; } }
        } else {
            if (tid < 387) { const int cfg = tid / 129, j = tid % 129, dil = cfg == 0 ? 1 : (cfg == 1 ? 4 : 16); const int s = t - j * dil; keys[tid] = s >= 0 ? s : -1; }
            if (tid == 0) *nk_s = 387;
        }
        __syncthreads();
        const int nk = *nk_s;
        if (tid < nk) {
            const int e = tid, s = keys[e];
#pragma unroll 1
            for (int h = 0; h < 16; ++h) {
                float d = -__builtin_inff();
                if (s >= 0) { const uint4* kp = (const uint4*)(P + (size_t)(rb + s) * ldp + koff + h * kvhs); d = 0.f;
#pragma unroll
                    for (int c = 0; c < 16; ++c) { const uint4 r = kp[c]; const unsigned w[4] = {r.x, r.y, r.z, r.w}; const LAS float* qp = qs + h * 128 + c * 8;
#pragma unroll
                        for (int j = 0; j < 4; ++j) { d = fmaf(qp[2 * j], __uint_as_float(w[j] << 16), d); d = fmaf(qp[2 * j + 1], __uint_as_float(w[j] & 0xffff0000u), d); } }
                    d *= QK_SCALE; }
                sc[h * 400 + e] = d;
            }
        }
        __syncthreads();
        for (int hh = 0; hh < 2; ++hh) { const int h = wv * 2 + hh; float m = -__builtin_inff();
            for (int e = lane; e < nk; e += 64) m = fmaxf(m, sc[h * 400 + e]);
            m = wave_max(m); float sum = 0.f;
            for (int e = lane; e < nk; e += 64) { const float p = __expf(sc[h * 400 + e] - m); sc[h * 400 + e] = p; sum += p; }
            sum = wave_sum(sum); if (lane == 0) linv[h] = 1.f / sum; }
        __syncthreads();
        const int d = tid & 127, hg = tid >> 7; float acc[4] = {0.f, 0.f, 0.f, 0.f};
        for (int e = 0; e < nk; ++e) { const int s = keys[e]; if (s < 0) continue; const bf16* vp = P + (size_t)(rb + s) * ldp + voff + d;
#pragma unroll
            for (int j = 0; j < 4; ++j) { const int h = hg * 4 + j; acc[j] = fmaf(sc[h * 400 + e], bf2f(vp[h * kvhs]), acc[j]); } }
#pragma unroll
        for (int j = 0; j < 4; ++j) { const int h = hg * 4 + j; P[(size_t)row * ldp + h * 128 + d] = f2bf(acc[j] * linv[h]); }
        __syncthreads();
    }
}

__device__ __forceinline__ void naive_ret(Frame& F) {
    if (blockIdx.x >= 32) return;
    bf16* P = F.P; constexpr int ldp = n1pad(2);
    int tid_o_ = threadIdx.x; asm volatile("" : "+v"(tid_o_));
    const int grp = tid_o_ >> 8, tid = tid_o_ & 255, lane = tid & 63, wv = tid >> 6, item = blockIdx.x * 2 + grp, bl = item >> 3, h = item & 7;
    const float gamma = 1.f - exp2f(-5.f - (float)h);
    LAS float* base = (LAS float*)(F.lds + grp * 40960);
    LAS float* qs = base; LAS float* ks = qs + 16 * 128; LAS float* ob = ks + 16 * 128; LAS float* sq = ob + 16 * 256;
    float S[128];
#pragma unroll
    for (int i = 0; i < 128; ++i) S[i] = 0.f;
    for (int t0 = 0; t0 < SEQ; t0 += 16) {
        const size_t row0 = (size_t)bl * SEQ + t0;
        for (int i = tid; i < 16 * 128; i += 256) { const int tt = i >> 7, c = i & 127; const bf16* pr = P + (row0 + tt) * ldp + h * 128 + c; qs[i] = bf2f(pr[0]); ks[i] = bf2f(pr[1024]); }
        __syncthreads();
#pragma unroll 1
        for (int tt = 0; tt < 16; ++tt) {
            const float v = bf2f(P[(row0 + tt) * ldp + 2048 + h * 256 + tid]); float o = 0.f;
#pragma unroll
            for (int i = 0; i < 128; i += 4) { const pg8::f32x4 k4 = *(const LAS pg8::f32x4*)&ks[tt * 128 + i], q4 = *(const LAS pg8::f32x4*)&qs[tt * 128 + i];
                S[i] = fmaf(gamma, S[i], k4.x * v); o = fmaf(q4.x, S[i], o); S[i + 1] = fmaf(gamma, S[i + 1], k4.y * v); o = fmaf(q4.y, S[i + 1], o);
                S[i + 2] = fmaf(gamma, S[i + 2], k4.z * v); o = fmaf(q4.z, S[i + 2], o); S[i + 3] = fmaf(gamma, S[i + 3], k4.w * v); o = fmaf(q4.w, S[i + 3], o); }
            ob[tt * 256 + tid] = o;
        }
        __syncthreads();
        for (int j = 0; j < 4; ++j) { const int tt = wv * 4 + j; float s = 0.f; for (int c = lane; c < 256; c += 64) s += ob[tt * 256 + c] * ob[tt * 256 + c]; s = wave_sum(s);
            if (lane < 8) F.ssq[((row0 + tt) * 8 + h) * 8 + lane] = lane == 0 ? s : 0.f; }
        for (int tt = 0; tt < 16; ++tt) P[(row0 + tt) * ldp + 2048 + h * 256 + tid] = f2bf(ob[tt * 256 + tid]);
        __syncthreads();
    }
}

__device__ __forceinline__ void naive_hgrn(Frame& F) {
    if (blockIdx.x >= 32) return;
    bf16* P = F.P; constexpr int ldp = n1pad(3);
    int tid_o_ = threadIdx.x; asm volatile("" : "+v"(tid_o_));
    const int grp = tid_o_ >> 7, tid = tid_o_ & 127, lane = tid & 63, wv = tid >> 6, item = blockIdx.x * 4 + grp, bl = item >> 4, h = item & 15;
    LAS float* base = (LAS float*)(F.lds + grp * 28672);
    LAS float* qs = base; LAS float* gs = qs + 16 * 128; LAS float* ob = gs + 16 * 128;
    float S[128];
#pragma unroll
    for (int i = 0; i < 128; ++i) S[i] = 0.f;
    for (int t0 = 0; t0 < SEQ; t0 += 16) {
        const size_t row0 = (size_t)bl * SEQ + t0;
        for (int tt = 0; tt < 16; ++tt) { const bf16* pr = P + (row0 + tt) * ldp + h * 128 + tid;
            qs[tt * 128 + tid] = bf2f(pr[0]); gs[tt * 128 + tid] = __expf(bf2f(pr[2048])); }
        __syncthreads();
#pragma unroll 1
        for (int tt = 0; tt < 16; ++tt) {
            const float v = bf2f(P[(row0 + tt) * ldp + 4096 + h * 128 + tid]); float o = 0.f;
#pragma unroll
            for (int i = 0; i < 128; i += 4) { const pg8::f32x4 g4 = *(const LAS pg8::f32x4*)&gs[tt * 128 + i], q4 = *(const LAS pg8::f32x4*)&qs[tt * 128 + i];
                S[i] = fmaf(g4.x, S[i] - v, v); o = fmaf(q4.x, S[i], o); S[i + 1] = fmaf(g4.y, S[i + 1] - v, v); o = fmaf(q4.y, S[i + 1], o);
                S[i + 2] = fmaf(g4.z, S[i + 2] - v, v); o = fmaf(q4.z, S[i + 2], o); S[i + 3] = fmaf(g4.w, S[i + 3] - v, v); o = fmaf(q4.w, S[i + 3], o); }
            ob[tt * 128 + tid] = o;
        }
        __syncthreads();
        for (int j = 0; j < 8; ++j) { const int tt = wv * 8 + j; float s = ob[tt * 128 + lane] * ob[tt * 128 + lane] + ob[tt * 128 + lane + 64] * ob[tt * 128 + lane + 64]; s = wave_sum(s);
            if (lane < 4) F.ssq[((row0 + tt) * 16 + h) * 4 + lane] = lane == 0 ? s : 0.f; }
        for (int tt = 0; tt < 16; ++tt) P[(row0 + tt) * ldp + 4096 + h * 128 + tid] = f2bf(ob[tt * 128 + tid]);
        __syncthreads();
    }
}

typedef short ix_bf16x8 __attribute__((ext_vector_type(8)));
typedef float ix_f32x16 __attribute__((ext_vector_type(16)));
__device__ __forceinline__ int half_sum(int v, int hi) {
    v = half_sum_i(v);
    const int lo = __builtin_amdgcn_readlane(v, 31), up = __builtin_amdgcn_readlane(v, 63);
    return hi ? up : lo;
}
__device__ __forceinline__ void index_topk_phase(Frame& F) {
    PHASE_IDS();
    const bf16* P = F.P; constexpr int ldp = n1pad(0), ROWB = 144, BUFB = 256 * ROWB;
    const int c = lane & 31, hi = lane >> 5;
#pragma unroll 1
    for (int uu = 0; uu < 4; ++uu) {
        const int unit = (uu & 1) ? (1023 - (uu >> 1) * 256 - (int)blockIdx.x) : ((uu >> 1) * 256 + (int)blockIdx.x);
        const int row0 = unit * 16, rb = row0 & ~(SEQ - 1), tu = row0 & (SEQ - 1);
        const int t0 = tu + 2 * wave, tq = t0 + hi;
        const int nchunk = (tu + 15) / 256 + 1, jmax = (t0 + 1) >> 5;
        ix_bf16x8 afr[4];
        { const bf16* ap = P + (size_t)(row0 + 2 * wave + (c >> 4)) * ldp + A_IQ + (c & 15) * 64 + 8 * hi;
#pragma unroll
          for (int s = 0; s < 4; ++s) afr[s] = *(const ix_bf16x8*)(ap + 16 * s); }
        float w0[8], w1[8];
        { const bf16* wp = P + (size_t)(row0 + 2 * wave) * ldp + A_IW;
#pragma unroll
          for (int j = 0; j < 8; ++j) { const int hd = (j & 3) + 8 * (j >> 2) + 4 * hi; w0[j] = bf2f(wp[hd]) * (1.f / 32.f); w1[j] = bf2f(wp[ldp + hd]) * (1.f / 32.f); } }
        unsigned uk[64];
#pragma unroll
        for (int j = 0; j < 64; ++j) uk[j] = 0u;
        pg8::u32x4 st[4];
        { const bf16* gp = P + (size_t)rb * ldp + A_IK;
#pragma unroll
          for (int i = 0; i < 4; ++i) { const int p = tid + 512 * i; st[i] = *(const pg8::u32x4*)(gp + (size_t)(p >> 3) * ldp + (p & 7) * 8); }
#pragma unroll
          for (int i = 0; i < 4; ++i) { const int p = tid + 512 * i; *(LAS pg8::u32x4*)(F.lds + (p >> 3) * ROWB + (p & 7) * 16) = st[i]; } }
        __syncthreads();
#pragma unroll
        for (int ch = 0; ch < 8; ++ch) {
            if (ch < nchunk) {
                const bool more = ch + 1 < nchunk;
                if (more) { const bf16* gp = P + (size_t)(rb + 256 * (ch + 1)) * ldp + A_IK;
#pragma unroll
                    for (int i = 0; i < 4; ++i) { const int p = tid + 512 * i; st[i] = *(const pg8::u32x4*)(gp + (size_t)(p >> 3) * ldp + (p & 7) * 8); } }
                const LAS unsigned char* buf = F.lds + (ch & 1) * BUFB + c * ROWB + 16 * hi;
#pragma unroll
                for (int jj = 0; jj < 8; ++jj) {
                    const int j = 8 * ch + jj;
                    if (j <= jmax) {
                        ix_f32x16 acc = {};
#pragma unroll
                        for (int s = 0; s < 4; ++s) { const ix_bf16x8 bfr = *(const LAS ix_bf16x8*)(buf + jj * 32 * ROWB + 32 * s); acc = __builtin_amdgcn_mfma_f32_32x32x16_bf16(afr[s], bfr, acc, 0, 0, 0); }
                        float s0 = 0.f, s1 = 0.f;
#pragma unroll
                        for (int x = 0; x < 8; ++x) { s0 = fmaf(fmaxf(acc[x], 0.f), w0[x], s0); s1 = fmaf(fmaxf(acc[8 + x], 0.f), w1[x], s1); }
                        const auto rr = __builtin_amdgcn_permlane32_swap(__float_as_uint(s0), __float_as_uint(s1), false, false);
                        const float tot = __uint_as_float(rr[0]) + __uint_as_float(rr[1]);
                        uk[j] = (32 * j + c <= tq) ? fkey(tot) : 0u;
                    }
                }
                if (more) {
#pragma unroll
                    for (int i = 0; i < 4; ++i) { const int p = tid + 512 * i; *(LAS pg8::u32x4*)(F.lds + ((ch + 1) & 1) * BUFB + (p >> 3) * ROWB + (p & 7) * 16) = st[i]; } }
                __syncthreads();
            }
        }
        unsigned thr = 0u;
        if (t0 >= 256) {
#pragma unroll 1
            for (int bit = 31; bit >= 0; --bit) {
                const unsigned cand = thr | (1u << bit); int cnt = 0;
#pragma unroll
                for (int g = 0; g < 8; ++g) if (8 * g <= jmax) {
#pragma unroll
                    for (int x = 0; x < 8; ++x) cnt += (uk[8 * g + x] >= cand) ? 1 : 0; }
                if (half_sum(cnt, hi) >= 256) thr = cand;
            }
        }
        int ngt = 0, neq = 0;
#pragma unroll
        for (int j = 0; j < 64; ++j) { ngt += (uk[j] > thr) ? 1 : 0; neq += (uk[j] == thr) ? 1 : 0; }
        ngt = half_sum(ngt, hi); neq = half_sum(neq, hi);
        const int need = 256 - ngt; const bool ties = (thr != 0u) && (neq != need);
        unsigned long long okm = ~0ull;
        if (__any(ties)) { okm = 0ull; int run = 0;
#pragma unroll
            for (int j = 0; j < 64; ++j) { const unsigned long long m = __ballot(uk[j] == thr); const unsigned mh = hi ? (unsigned)(m >> 32) : (unsigned)m;
                const int below = __popc(mh & ((1u << c) - 1u)); if (!ties || run + below < need) okm |= 1ull << j; run += __popc(mh); } }
        unsigned mw0 = 0u, mw1 = 0u;
#pragma unroll
        for (int j = 0; j < 64; ++j) { const bool sel = (uk[j] > thr) || (thr != 0u && uk[j] == thr && ((okm >> j) & 1ull));
            const unsigned long long m = __ballot(sel);
            mw0 = (lane == j) ? (unsigned)m : mw0; mw1 = (lane == j) ? (unsigned)(m >> 32) : mw1; }
        unsigned* mp = F.mask + (size_t)(row0 + 2 * wave) * 64 + lane;
        mp[0] = mw0; mp[64] = mw1;
    }
}

struct AttItem { int bh, qb0, qb1; };
__device__ __forceinline__ AttItem att_decode(int Lc, int Gq  ) {
    AttItem it; const int xcd = Lc & 7, k = Lc >> 3, per = Gq * 4, gi = k / per, r = k - gi * per;
    it.bh = (gi * 8 + xcd) * Gq + r / 4; const int x = r & 3; it.qb0 = x; it.qb1 = 7 - x; return it;
}
template <int L> __device__ __forceinline__ att::BlockRef<bf16, bf16> att_ref(const AttItem& it, int pass, bf16* P, const unsigned* mask) {
    constexpr int LDP = n1pad(L), KOFF = (L == 0) ? A_K : 2048, VOFF = (L == 0) ? A_V : 4096, KVHS = (L == 0) ? 0 : 128;
    const int qb = pass ? it.qb1 : it.qb0, b = it.bh >> 4, h = it.bh & 15;
    att::BlockRef<bf16, bf16> r;
    r.Q = P + (size_t)(b * SEQ + qb * 256) * LDP + h * 128; r.O = P + (size_t)(b * SEQ + qb * 256) * LDP + h * 128;
    r.K = P + (size_t)(b * SEQ) * LDP + KOFF + h * KVHS; r.V = P + (size_t)(b * SEQ) * LDP + VOFF + h * KVHS;
    r.M = mask + (size_t)(b * SEQ + qb * 256) * 64; r.P0 = qb * 256;
    return r;
}
template <int L> __device__ __forceinline__ void attn_phase(bf16* P, const unsigned* mask, char* lds, int G) {
    constexpr int LDP = n1pad(L), MK = (L == 0) ? 0 : 1, GQ = (L == 0) ? 16 : 1, TOTAL = 512, W = 1 << 28;
    int Lc = blockIdx.x; if (Lc >= TOTAL) return;
    AttItem it = att_decode(Lc, GQ); int pass = 0;
    att::BlockRef<bf16, bf16> cur = att_ref<L>(it, 0, P, mask);
    att::Seam<bf16> S;
    att::causal_swa_prime<bf16, bf16, LDP, LDP, MK>(cur, W, lds, S);
    for (;;) {
        const bool more_pass = pass == 0, more_item = Lc + G < TOTAL, last = !more_pass && !more_item;
        AttItem itn = it; int passn = pass + 1, Ln = Lc;
        if (!more_pass) { passn = 0; Ln = more_item ? Lc + G : Lc; itn = att_decode(Ln, GQ); }
        const att::BlockRef<bf16, bf16> nxt = last ? cur : att_ref<L>(itn, passn, P, mask);
        att::causal_swa_block<bf16, bf16, LDP, LDP, MK>(cur, nxt, SEQ, W, lds, S);
        if (last) break;
        cur = nxt; it = itn; pass = passn; Lc = Ln;
    }
}

namespace ret {
typedef short bf16x8 __attribute__((ext_vector_type(8)));
typedef short s16x4 __attribute__((ext_vector_type(4)));
typedef float f32x16 __attribute__((ext_vector_type(16)));
__device__ __forceinline__ unsigned off_b(unsigned row, unsigned ch) { return 256u * row + 16u * (ch ^ ((row & 3) << 2)); }
__device__ __forceinline__ unsigned img_off(unsigned row, unsigned ch) { return 8192u * (row >> 5) + off_b(row & 31, ch); }
__device__ __forceinline__ unsigned addr_row(unsigned lane, unsigned rblk, unsigned s) { return 8192u * rblk + off_b(lane & 31, 2 * s + (lane >> 5)); }
__device__ __forceinline__ unsigned addr_tr(unsigned lane, unsigned row4, unsigned c) {
    const unsigned blk = (lane >> 4) & 1, q = (lane & 15) >> 2, p = lane & 3;
    return img_off(row4 + q, 4 * c + 2 * blk + (p >> 1)) + 8 * (p & 1);
}
__device__ __forceinline__ s16x4 tr_read(unsigned a) { s16x4 r; asm volatile("ds_read_b64_tr_b16 %0, %1" : "=&v"(r) : "v"(a) : "memory"); return r; }
__device__ __forceinline__ bf16x8 cat8(s16x4 lo, s16x4 hi) { return (bf16x8){lo[0], lo[1], lo[2], lo[3], hi[0], hi[1], hi[2], hi[3]}; }
__device__ __forceinline__ unsigned cvtpk(float lo, float hi) { unsigned r; asm volatile("v_cvt_pk_bf16_f32 %0, %1, %2" : "=v"(r) : "v"(lo), "v"(hi)); return r; }
__device__ __forceinline__ bf16x8 pack_acc8(const f32x16& a, int s) {
    pg8::u32x4 w = {cvtpk(a[8 * s + 0], a[8 * s + 1]), cvtpk(a[8 * s + 2], a[8 * s + 3]), cvtpk(a[8 * s + 4], a[8 * s + 5]), cvtpk(a[8 * s + 6], a[8 * s + 7])};
    return *reinterpret_cast<bf16x8*>(&w);
}
#define RET_LGKM0() do { asm volatile("s_waitcnt lgkmcnt(0)" ::: "memory"); __builtin_amdgcn_sched_barrier(0); } while (0)
constexpr int OFF_Q = 0, OFF_K = 32768, OFF_V = 65536, OFF_S = 98304;
}

__device__ __forceinline__ void ret_phase(Frame& F) {
    using namespace ret;
    PHASE_IDS();
    bf16* P = F.P; constexpr int ldp = n1pad(2);
    const int xcd = blockIdx.x & 7, kk = blockIdx.x >> 3, bh = xcd * 8 + (kk >> 2), dvq = kk & 3, b = bh >> 3, h = bh & 7;
    const int ib = (wave < 4) ? wave : 7 - wave, dh = wave >> 2;
    const int dkb = wave & 3, dvb = wave >> 2;
    const int c = lane & 31, hi = lane >> 5;
    const float lg = log2f(1.f - exp2f(-5.f - (float)h));
    const float g128 = exp2f(128.f * lg), g127 = exp2f(127.f * lg), g1 = exp2f(lg);
    const unsigned lbase = (unsigned)(size_t)F.lds_gen;
    const size_t rowg0 = (size_t)b * SEQ;
    const bf16* qg = P + rowg0 * ldp + h * 128; const bf16* vg = P + rowg0 * ldp + 2048 + h * 256 + dvq * 64;
    for (int i = tid; i < 32768 / 16; i += 512) *(LAS pg8::u32x4*)(F.lds + OFF_S + i * 16) = (pg8::u32x4){0u, 0u, 0u, 0u};
    f32x16 st = {};
    pg8::u32x4 rq[4], rk[4], rv[2];
#define RET_LOAD(n) do { const size_t r0_ = (size_t)(n) * 128; \
        _Pragma("unroll") for (int i = 0; i < 4; ++i) { const int p = tid + 512 * i; const bf16* g_ = qg + (r0_ + (p >> 4)) * ldp + (p & 15) * 8; rq[i] = *(const pg8::u32x4*)g_; rk[i] = *(const pg8::u32x4*)(g_ + 1024); } \
        _Pragma("unroll") for (int i = 0; i < 2; ++i) { const int p = tid + 512 * i; rv[i] = *(const pg8::u32x4*)(vg + (r0_ + (p >> 3)) * ldp + (p & 7) * 8); } } while (0)
#define RET_SCALE8(r, f) do { float x_[8]; x_[0] = __uint_as_float(r.x << 16); x_[1] = __uint_as_float(r.x & 0xffff0000u); x_[2] = __uint_as_float(r.y << 16); x_[3] = __uint_as_float(r.y & 0xffff0000u); \
        x_[4] = __uint_as_float(r.z << 16); x_[5] = __uint_as_float(r.z & 0xffff0000u); x_[6] = __uint_as_float(r.w << 16); x_[7] = __uint_as_float(r.w & 0xffff0000u); \
        r.x = cvtpk(x_[0] * (f), x_[1] * (f)); r.y = cvtpk(x_[2] * (f), x_[3] * (f)); r.z = cvtpk(x_[4] * (f), x_[5] * (f)); r.w = cvtpk(x_[6] * (f), x_[7] * (f)); } while (0)
#define RET_WRITE() do { \
        _Pragma("unroll") for (int i = 0; i < 4; ++i) { const int p = tid + 512 * i, row = p >> 4; const float fq = exp2f((float)row * lg), fk = exp2f(-(float)row * lg); \
            RET_SCALE8(rq[i], fq); RET_SCALE8(rk[i], fk); const unsigned o_ = img_off(row, p & 15); *(LAS pg8::u32x4*)(F.lds + OFF_Q + o_) = rq[i]; *(LAS pg8::u32x4*)(F.lds + OFF_K + o_) = rk[i]; } \
        _Pragma("unroll") for (int i = 0; i < 2; ++i) { const int p = tid + 512 * i; *(LAS pg8::u32x4*)(F.lds + OFF_V + img_off(p >> 3, p & 7)) = rv[i]; } } while (0)
    RET_LOAD(0); RET_WRITE();
    __syncthreads();
#pragma unroll 1
    for (int n = 0; n < 16; ++n) {
        if (n + 1 < 16) RET_LOAD(n + 1);
        f32x16 o = {};
#pragma unroll
        for (int s = 0; s < 8; ++s) {
            const bf16x8 a = *(const LAS bf16x8*)(F.lds + OFF_Q + addr_row(lane, ib, s));
            const s16x4 b0 = tr_read(lbase + OFF_S + addr_tr(lane, 16 * s + 8 * hi, dh)), b1 = tr_read(lbase + OFF_S + addr_tr(lane, 16 * s + 8 * hi + 4, dh));
            RET_LGKM0();
            o = __builtin_amdgcn_mfma_f32_32x32x16_bf16(a, cat8(b0, b1), o, 0, 0, 0);
        }
#pragma unroll
        for (int jb = 0; jb < 4; ++jb) {
            if (jb <= ib) {
                f32x16 sacc = {};
#pragma unroll
                for (int s = 0; s < 8; ++s) {
                    const bf16x8 a = *(const LAS bf16x8*)(F.lds + OFF_K + addr_row(lane, jb, s)), bq = *(const LAS bf16x8*)(F.lds + OFF_Q + addr_row(lane, ib, s));
                    sacc = __builtin_amdgcn_mfma_f32_32x32x16_bf16(a, bq, sacc, 0, 0, 0);
                }
                if (jb == ib) {
#pragma unroll
                    for (int r = 0; r < 16; ++r) { const int jl = (r & 3) + 8 * (r >> 2) + 4 * hi; if (jl > c) sacc[r] = 0.f; }
                }
#pragma unroll
                for (int s = 0; s < 2; ++s) {
                    const bf16x8 pa = pack_acc8(sacc, s);
                    const s16x4 b0 = tr_read(lbase + OFF_V + addr_tr(lane, 32 * jb + 16 * s + 4 * hi, dh)), b1 = tr_read(lbase + OFF_V + addr_tr(lane, 32 * jb + 16 * s + 8 + 4 * hi, dh));
                    RET_LGKM0();
                    o = __builtin_amdgcn_mfma_f32_32x32x16_bf16(pa, cat8(b0, b1), o, 0, 0, 0);
                }
            }
        }
        f32x16 xs = {};
#pragma unroll
        for (int s = 0; s < 8; ++s) {
            const s16x4 a0 = tr_read(lbase + OFF_K + addr_tr(lane, 16 * s + 8 * hi, dkb)), a1 = tr_read(lbase + OFF_K + addr_tr(lane, 16 * s + 8 * hi + 4, dkb));
            const s16x4 b0 = tr_read(lbase + OFF_V + addr_tr(lane, 16 * s + 8 * hi, dvb)), b1 = tr_read(lbase + OFF_V + addr_tr(lane, 16 * s + 8 * hi + 4, dvb));
            RET_LGKM0();
            xs = __builtin_amdgcn_mfma_f32_32x32x16_bf16(cat8(a0, a1), cat8(b0, b1), xs, 0, 0, 0);
        }
#pragma unroll
        for (int r = 0; r < 16; ++r) st[r] = g128 * st[r] + g127 * xs[r];
        {
            const size_t rowb = rowg0 + (size_t)n * 128 + ib * 32;
#pragma unroll
            for (int r = 0; r < 16; ++r) {
                const int il = (r & 3) + 8 * (r >> 2) + 4 * hi; const float v = o[r];
                const float q = half_sum_f(v * v);
                if (c == 31) F.ssq[((rowb + il) * 8 + h) * 8 + dvq * 2 + dh] = q;
                const float vn = lane_xor1(v);
                if ((c & 1) == 0) *(unsigned*)(P + (rowb + il) * ldp + 2048 + h * 256 + dvq * 64 + dh * 32 + c) = cvtpk(v, vn);
            }
        }
        LDS_BARRIER();
#pragma unroll
        for (int r = 0; r < 16; ++r) { const int dk = 32 * dkb + (r & 3) + 8 * (r >> 2) + 4 * hi, dv = 32 * dvb + c;
            *(LAS bf16*)(F.lds + OFF_S + img_off(dk, dv >> 3) + (dv & 7) * 2) = f2bf(g1 * st[r]); }
        if (n + 1 < 16) RET_WRITE();
        LDS_BARRIER();
    }
#undef RET_LOAD
#undef RET_SCALE8
#undef RET_WRITE
}

namespace hg {
constexpr int PITCH = 132;
constexpr int OFF_Q = 0, OFF_K = 16384, OFF_V = 32768, OFF_T0 = 49152, OFF_T1 = 81920, OFF_C = 114688;
}
__device__ __forceinline__ void hgrn_prep_phase(Frame& F) {
    PHASE_IDS();
    bf16* P = F.P; constexpr int ldp = n1pad(3);
    float* tab = (float*)F.mask;
    LAS float* Lt = (LAS float*)F.lds; LAS float* segt = Lt + 64 * hg::PITCH;
    const int tok = tid >> 3, c16 = tid & 7, ch = tid & 127, seg = tid >> 7;
#pragma unroll 1
    for (int i = 0; i < 16; ++i) {
        const int it = blockIdx.x + 256 * i, bh = it >> 5, n = it & 31;
        bf16* gp = P + ((size_t)(bh >> 4) * SEQ + n * 64 + tok) * ldp + (bh & 15) * 128 + c16 * 16;
        const pg8::u32x4 q0 = *(const pg8::u32x4*)gp, q1 = *(const pg8::u32x4*)(gp + 8), f0 = *(const pg8::u32x4*)(gp + 2048), f1 = *(const pg8::u32x4*)(gp + 2056);
        float lf[16];
        { const unsigned w[8] = {f0.x, f0.y, f0.z, f0.w, f1.x, f1.y, f1.z, f1.w};
#pragma unroll
          for (int j = 0; j < 8; ++j) { lf[2 * j] = __uint_as_float(w[j] << 16); lf[2 * j + 1] = __uint_as_float(w[j] & 0xffff0000u); } }
#pragma unroll
        for (int j = 0; j < 4; ++j) *(LAS pg8::f32x4*)(Lt + tok * hg::PITCH + c16 * 16 + 4 * j) = (pg8::f32x4){lf[4 * j], lf[4 * j + 1], lf[4 * j + 2], lf[4 * j + 3]};
        __syncthreads();
        float bl[16]; float run = 0.f;
#pragma unroll
        for (int t = 0; t < 16; ++t) { run += Lt[(seg * 16 + t) * hg::PITCH + ch]; bl[t] = run; }
        segt[seg * 128 + ch] = run;
        __syncthreads();
        { const float s0 = segt[ch], s1 = segt[128 + ch], s2 = segt[256 + ch], s3 = segt[384 + ch];
          const float pre = (seg == 0) ? 0.f : (seg == 1 ? s0 : (seg == 2 ? s0 + s1 : s0 + s1 + s2)), bref = s0 + s1;
          if (seg == 0) { tab[(size_t)it * 256 + ch] = bref; tab[(size_t)it * 256 + 128 + ch] = s2 + s3; }
#pragma unroll
          for (int t = 0; t < 16; ++t) Lt[(seg * 16 + t) * hg::PITCH + ch] = __expf(pre + bl[t] - bref); }
        __syncthreads();
        float e[16];
#pragma unroll
        for (int j = 0; j < 4; ++j) { const pg8::f32x4 v = *(const LAS pg8::f32x4*)(Lt + tok * hg::PITCH + c16 * 16 + 4 * j); e[4 * j] = v[0]; e[4 * j + 1] = v[1]; e[4 * j + 2] = v[2]; e[4 * j + 3] = v[3]; }
        float qv[16];
        { const unsigned w[8] = {q0.x, q0.y, q0.z, q0.w, q1.x, q1.y, q1.z, q1.w};
#pragma unroll
          for (int j = 0; j < 8; ++j) { qv[2 * j] = __uint_as_float(w[j] << 16); qv[2 * j + 1] = __uint_as_float(w[j] & 0xffff0000u); } }
        unsigned qo[8], ko[8];
#pragma unroll
        for (int j = 0; j < 8; ++j) {
            const float ea = e[2 * j], eb = e[2 * j + 1];
            qo[j] = pg8::cvt_pk_bf16(qv[2 * j] * ea, qv[2 * j + 1] * eb);
            ko[j] = pg8::cvt_pk_bf16((1.f - __expf(lf[2 * j])) * __builtin_amdgcn_rcpf(ea), (1.f - __expf(lf[2 * j + 1])) * __builtin_amdgcn_rcpf(eb));
        }
        *(pg8::u32x4*)gp = (pg8::u32x4){qo[0], qo[1], qo[2], qo[3]}; *(pg8::u32x4*)(gp + 8) = (pg8::u32x4){qo[4], qo[5], qo[6], qo[7]};
        *(pg8::u32x4*)(gp + 2048) = (pg8::u32x4){ko[0], ko[1], ko[2], ko[3]}; *(pg8::u32x4*)(gp + 2056) = (pg8::u32x4){ko[4], ko[5], ko[6], ko[7]};
        __syncthreads();
    }
}
__device__ __forceinline__ void hgrn_seq_phase(Frame& F) {
    using namespace ret;
    PHASE_IDS();
    bf16* P = F.P; constexpr int ldp = n1pad(3);
    const float* tab = (const float*)F.mask;
    const int xcd = blockIdx.x & 7, kk = blockIdx.x >> 3, bh = xcd * 16 + (kk >> 1), dvh = kk & 1, b = bh >> 4, h = bh & 15;
    const int c = lane & 31, hi = lane >> 5;
    const unsigned lbase = (unsigned)(size_t)F.lds_gen;
    const size_t rowg0 = (size_t)b * SEQ;
    const bf16* qg = P + rowg0 * ldp + h * 128; const bf16* vg = P + rowg0 * ldp + 4096 + h * 128 + dvh * 64;
    const float* tg = tab + (size_t)bh * 32 * 256;
    LAS float* ctab = (LAS float*)(F.lds + hg::OFF_C);
    for (int i = tid; i < 65536 / 16; i += 512) *(LAS pg8::u32x4*)(F.lds + hg::OFF_T0 + i * 16) = (pg8::u32x4){0u, 0u, 0u, 0u};
    f32x16 t0 = {}, t1 = {};
    pg8::u32x4 rq[2], rk[2], rv; pg8::f32x4 ru, rb;
#define HG_LOAD(n) do { const size_t r0_ = (size_t)(n) * 64; \
        _Pragma("unroll") for (int i = 0; i < 2; ++i) { const int p = tid + 512 * i; const bf16* g_ = qg + (r0_ + (p >> 4)) * ldp + (p & 15) * 8; rq[i] = *(const pg8::u32x4*)g_; rk[i] = *(const pg8::u32x4*)(g_ + 2048); } \
        rv = *(const pg8::u32x4*)(vg + (r0_ + (tid >> 3)) * ldp + (tid & 7) * 8); \
        if (tid < 32) { ru = *(const pg8::f32x4*)(tg + (size_t)(n) * 256 + 128 + 4 * tid); rb = ((n) + 1 < 32) ? *(const pg8::f32x4*)(tg + (size_t)((n) + 1) * 256 + 4 * tid) : (pg8::f32x4){0.f, 0.f, 0.f, 0.f}; } } while (0)
#define HG_WRITE() do { \
        _Pragma("unroll") for (int i = 0; i < 2; ++i) { const int p = tid + 512 * i; const unsigned o_ = img_off(p >> 4, p & 15); *(LAS pg8::u32x4*)(F.lds + hg::OFF_Q + o_) = rq[i]; *(LAS pg8::u32x4*)(F.lds + hg::OFF_K + o_) = rk[i]; } \
        *(LAS pg8::u32x4*)(F.lds + hg::OFF_V + img_off(tid >> 3, tid & 7)) = rv; \
        if (tid < 32) *(LAS pg8::f32x4*)(ctab + 4 * tid) = (pg8::f32x4){__expf(ru[0] + rb[0]), __expf(ru[1] + rb[1]), __expf(ru[2] + rb[2]), __expf(ru[3] + rb[3])}; } while (0)
    HG_LOAD(0); HG_WRITE();
    __syncthreads();
#pragma unroll 1
    for (int n = 0; n < 32; ++n) {
        if (n + 1 < 32) HG_LOAD(n + 1);
        const int tcur = (n & 1) ? hg::OFF_T1 : hg::OFF_T0, tnxt = (n & 1) ? hg::OFF_T0 : hg::OFF_T1;
        if (wave >= 4) {
            const int dkb = wave - 4;
#pragma unroll
            for (int sp = 0; sp < 2; ++sp) {
                s16x4 ar[4], br[4], dr[4];
#pragma unroll
                for (int u = 0; u < 2; ++u) { const int s = 2 * sp + u;
                    ar[2 * u] = tr_read(lbase + hg::OFF_K + addr_tr(lane, 16 * s + 8 * hi, dkb)); ar[2 * u + 1] = tr_read(lbase + hg::OFF_K + addr_tr(lane, 16 * s + 8 * hi + 4, dkb));
                    br[2 * u] = tr_read(lbase + hg::OFF_V + addr_tr(lane, 16 * s + 8 * hi, 0)); br[2 * u + 1] = tr_read(lbase + hg::OFF_V + addr_tr(lane, 16 * s + 8 * hi + 4, 0));
                    dr[2 * u] = tr_read(lbase + hg::OFF_V + addr_tr(lane, 16 * s + 8 * hi, 1)); dr[2 * u + 1] = tr_read(lbase + hg::OFF_V + addr_tr(lane, 16 * s + 8 * hi + 4, 1)); }
                RET_LGKM0();
#pragma unroll
                for (int u = 0; u < 2; ++u) { const bf16x8 a = cat8(ar[2 * u], ar[2 * u + 1]);
                    t0 = __builtin_amdgcn_mfma_f32_32x32x16_bf16(a, cat8(br[2 * u], br[2 * u + 1]), t0, 0, 0, 0);
                    t1 = __builtin_amdgcn_mfma_f32_32x32x16_bf16(a, cat8(dr[2 * u], dr[2 * u + 1]), t1, 0, 0, 0); }
            }
#pragma unroll
            for (int g = 0; g < 4; ++g) { const pg8::f32x4 cv = *(const LAS pg8::f32x4*)(ctab + 32 * dkb + 8 * g + 4 * hi);
#pragma unroll
                for (int x = 0; x < 4; ++x) { const int r = 4 * g + x; t0[r] *= cv[x]; t1[r] *= cv[x]; } }
#pragma unroll
            for (int r = 0; r < 16; r += 2) { const int dk = 32 * dkb + (r & 3) + 8 * (r >> 2) + 4 * hi;
                const unsigned w0 = cvtpk(t0[r], t0[r + 1]), w1 = cvtpk(t1[r], t1[r + 1]);
                *(LAS bf16*)(F.lds + tnxt + img_off(dk, c >> 3) + (c & 7) * 2) = (bf16)(w0 & 0xffffu); *(LAS bf16*)(F.lds + tnxt + img_off(dk + 1, c >> 3) + (c & 7) * 2) = (bf16)(w0 >> 16);
                *(LAS bf16*)(F.lds + tnxt + img_off(dk, (32 + c) >> 3) + (c & 7) * 2) = (bf16)(w1 & 0xffffu); *(LAS bf16*)(F.lds + tnxt + img_off(dk + 1, (32 + c) >> 3) + (c & 7) * 2) = (bf16)(w1 >> 16); }
        } else {
            const int tb = wave & 1, dvb = wave >> 1;
            f32x16 o = {};
#pragma unroll
            for (int sp = 0; sp < 2; ++sp) {
                s16x4 br[8]; bf16x8 a[4];
#pragma unroll
                for (int u = 0; u < 4; ++u) { const int s = 4 * sp + u; a[u] = *(const LAS bf16x8*)(F.lds + hg::OFF_Q + addr_row(lane, tb, s));
                    br[2 * u] = tr_read(lbase + tcur + addr_tr(lane, 16 * s + 8 * hi, dvb)); br[2 * u + 1] = tr_read(lbase + tcur + addr_tr(lane, 16 * s + 8 * hi + 4, dvb)); }
                RET_LGKM0();
#pragma unroll
                for (int u = 0; u < 4; ++u) o = __builtin_amdgcn_mfma_f32_32x32x16_bf16(a[u], cat8(br[2 * u], br[2 * u + 1]), o, 0, 0, 0);
            }
#pragma unroll
            for (int sb = 0; sb < 2; ++sb) {
                if (sb <= tb) {
                    f32x16 sacc = {};
                    s16x4 vr[4];
#pragma unroll
                    for (int s = 0; s < 2; ++s) { vr[2 * s] = tr_read(lbase + hg::OFF_V + addr_tr(lane, 32 * sb + 16 * s + 4 * hi, dvb)); vr[2 * s + 1] = tr_read(lbase + hg::OFF_V + addr_tr(lane, 32 * sb + 16 * s + 8 + 4 * hi, dvb)); }
#pragma unroll
                    for (int s = 0; s < 8; ++s) {
                        const bf16x8 a = *(const LAS bf16x8*)(F.lds + hg::OFF_K + addr_row(lane, sb, s)), bq = *(const LAS bf16x8*)(F.lds + hg::OFF_Q + addr_row(lane, tb, s));
                        sacc = __builtin_amdgcn_mfma_f32_32x32x16_bf16(a, bq, sacc, 0, 0, 0);
                    }
                    if (sb == tb) {
#pragma unroll
                        for (int r = 0; r < 16; ++r) { const int sl = (r & 3) + 8 * (r >> 2) + 4 * hi; if (sl > c) sacc[r] = 0.f; }
                    }
                    RET_LGKM0();
#pragma unroll
                    for (int s = 0; s < 2; ++s) o = __builtin_amdgcn_mfma_f32_32x32x16_bf16(pack_acc8(sacc, s), cat8(vr[2 * s], vr[2 * s + 1]), o, 0, 0, 0);
                }
            }
            const size_t rowb = rowg0 + (size_t)n * 64 + tb * 32;
#pragma unroll
            for (int r = 0; r < 16; ++r) {
                const int il = (r & 3) + 8 * (r >> 2) + 4 * hi; const float v = o[r];
                const float q = half_sum_f(v * v);
                if (c == 31) F.ssq[((rowb + il) * 16 + h) * 4 + dvh * 2 + dvb] = q;
                const float vn = lane_xor1(v);
                if ((c & 1) == 0) *(unsigned*)(P + (rowb + il) * ldp + 4096 + h * 128 + dvh * 64 + dvb * 32 + c) = cvtpk(v, vn);
            }
        }
        LDS_BARRIER();
        if (n + 1 < 32) HG_WRITE();
        LDS_BARRIER();
    }
#undef HG_LOAD
#undef HG_WRITE
}

struct Args { const float* in[12]; float* out; unsigned char* ws; };
template <int L> __device__ __forceinline__ void mixer_phase(Frame& F, const XcdBarrier& bar) {
    if (L == 0) { index_topk_phase(F); xcd_barrier(bar); attn_phase<0>(F.P, F.mask, (char*)F.lds_gen, F.G); }
    if (L == 1) attn_phase<1>(F.P, F.mask, (char*)F.lds_gen, F.G);
    if (L == 2) ret_phase(F);
    if (L == 3) { hgrn_prep_phase(F); xcd_barrier(bar); hgrn_seq_phase(F); }
}
template <int L> __device__ __forceinline__ void layer_phases(Frame& F, const XcdBarrier& bar) {
    constexpr int N1 = n1pad(L);
    {
        pg8::Gemm g{F.U, F.WIN, MTOK, N1, D_MODEL, D_MODEL}; pg8::StaticOrder S; S.init(MTOK, N1, F.G, (int)blockIdx.x);
        EpiProj<L> E{F.P, N1, F.cos128, F.sin128, F.cos64, F.sin64, F.lb};
        pg8::gemm_phase<EpiProj<L>, pg8::StaticOrder, true, true>(F.lds, g, S, E);
    }
    xcd_barrier(bar);
    mixer_phase<L>(F, bar);
    xcd_barrier(bar);
    {
        pg8::Gemm g{F.U, F.WIN + (size_t)N1 * D_MODEL, MTOK, D_INNER, D_MODEL, D_MODEL}; pg8::StaticOrder S; S.init(MTOK, D_INNER, F.G, (int)blockIdx.x);
        EpiGate<L> E{F.P + ocol(L), N1, F.ssq};
        pg8::gemm_phase<EpiGate<L>, pg8::StaticOrder, true, true>(F.lds, g, S, E);
    }
    xcd_barrier(bar);
    {
        pg8::Gemm g{F.P + ocol(L), F.WOUT, MTOK, D_MODEL, D_INNER, N1}; pg8::StaticOrder S; S.init(MTOK, D_MODEL, F.G, (int)blockIdx.x);
        EpiAddF32 E{F.H, D_MODEL};
        pg8::gemm_phase<EpiAddF32, pg8::StaticOrder, true, true>(F.lds, g, S, E);
    }
    xcd_barrier(bar);
    if (L < 3) { norm_rows(F, F.H, F.norm_g + (L + 1) * D_MODEL, nullptr); conv_weights<(L < 3 ? L + 1 : 3)>(F); xcd_barrier(bar); }
    else final_rows(F);
}
__global__ void __launch_bounds__(NWAVES * 64, 2) mega_fwd(Args args) {
    extern __shared__ __attribute__((aligned(16))) unsigned char lds_raw[];
    Frame F;
    F.lds = (LAS unsigned char*)lds_raw; F.lds_gen = lds_raw; F.MISC = (volatile LAS unsigned*)(F.lds + MISC_OFF);
    F.G = gridDim.x;
    unsigned char* ws = args.ws;
    F.ctl = (unsigned*)(ws + WS_CTL);
    F.x = args.in[0]; F.norm_g = args.in[1]; F.final_g = args.in[2];
    F.w_in[0] = args.in[3]; F.w_out[0] = args.in[4]; F.w_in[1] = args.in[5]; F.w_out[1] = args.in[6]; F.w_in[2] = args.in[7]; F.w_out[2] = args.in[8]; F.w_in[3] = args.in[9]; F.w_out[3] = args.in[10];
    F.lb_logits = args.in[11]; F.H = args.out;
    F.cos128 = (float*)(ws + WS_TAB); F.sin128 = F.cos128 + 2048 * 64; F.cos64 = F.sin128 + 2048 * 64; F.sin64 = F.cos64 + 2048 * 32; F.lb = F.sin64 + 2048 * 32;
    F.ssq = (float*)(ws + WS_SSQ); F.mask = (unsigned*)(ws + WS_MASK);
    F.WIN = (bf16*)(ws + WS_WIN); F.WOUT = (bf16*)(ws + WS_WOUT); F.U = (bf16*)(ws + WS_U); F.P = (bf16*)(ws + WS_P);
    for (int u = threadIdx.x; u < (LDS_BYTES - RING_BYTES) / 4; u += NWAVES * 64) ((LAS unsigned*)(F.lds + RING_BYTES))[u] = 0u;
    __syncthreads();
    const XcdBarrier bar = xcd_barrier_post(F.ctl + CW_BAR, F.MISC + 8);
    make_tables(F); norm_rows(F, F.x, F.norm_g, F.H); conv_weights<0>(F);
    xcd_barrier(bar);
    layer_phases<0>(F, bar);
    layer_phases<1>(F, bar);
    layer_phases<2>(F, bar);
    layer_phases<3>(F, bar);
}

extern "C" void kernel_launch(void* const* d_in, const int* in_sizes, int n_in, void* d_out, int out_size, void* d_ws, size_t ws_size, hipStream_t stream) {
    static int grid = 0;
    if (grid == 0) {
        int dev = 0, cus = 0;
        if (hipGetDevice(&dev) != hipSuccess || hipDeviceGetAttribute(&cus, hipDeviceAttributeMultiprocessorCount, dev) != hipSuccess) { grid = -1; return; }
        if (hipFuncSetAttribute((const void*)mega_fwd, hipFuncAttributeMaxDynamicSharedMemorySize, LDS_BYTES) != hipSuccess) { grid = -1; return; }
        int per_cu = 0; (void)hipOccupancyMaxActiveBlocksPerMultiprocessor(&per_cu, (const void*)mega_fwd, NWAVES * 64, LDS_BYTES); (void)hipGetLastError();
        if (cus < 256) { fprintf(stderr, "kernel_launch: needs 256 CUs\n"); grid = -1; return; }
        grid = 256;
        if (ws_size < WS_END || n_in != 12) { fprintf(stderr, "kernel_launch: unexpected workspace / inputs\n"); grid = -1; return; }
    }
    if (grid < 0) return;
    (void)hipMemsetAsync((char*)d_ws + WS_CTL, 0, CTL_ZERO_BYTES, stream);
    Args a; for (int i = 0; i < 12; ++i) a.in[i] = (const float*)d_in[i];
    a.out = (float*)d_out; a.ws = (unsigned char*)d_ws;
    hipLaunchKernelGGL(mega_fwd, dim3(grid), dim3(NWAVES * 64), LDS_BYTES, stream, a);
}
```

```cpp
#include <hip/hip_runtime.h>
#include <cstdio>
#include <cstdint>
#define GAS __attribute__((address_space(1)))
#define LAS __attribute__((address_space(3)))
namespace pg8 {
#define PG8_LAS __attribute__((address_space(3)))
typedef unsigned short bf16_t;
typedef short bf16x8 __attribute__((ext_vector_type(8)));
typedef float f32x4 __attribute__((ext_vector_type(4)));
typedef unsigned u32x4 __attribute__((ext_vector_type(4)));
constexpr int BM = 256, BK = 64, HALF = 128, HTB = HALF * BK * 2  , STAGE_BYTES = 8 * HTB, NXCD = 8, WGM = 8;

__host__ __device__ __forceinline__ int lds_byte(int r, int c) { const int st = (r >> 4) * 2 + (c >> 5), rr = r & 15, cc = c & 31, ob = rr * 64 + cc * 2; return st * 1024 + (ob ^ (((ob >> 9) & 1) << 5)); }
__host__ __device__ __forceinline__ void stage_rc(int b, int& R, int& C) { const int st = b / 1024, sb = b % 1024, swz = sb ^ (((sb >> 9) & 1) << 5); R = (st >> 1) * 16 + swz / 64; C = (st & 1) * 32 + (swz % 64) / 2; }
__host__ __device__ __forceinline__ int perm32(int rho) { const int n = rho >> 4, i = rho & 15; return 8 * (i >> 2) + 4 * n + (i & 3); }

struct Unit { int pm, pn; };
struct Gemm { const bf16_t* A; const bf16_t* Bt; int M, N, K, lda; };

struct StaticOrder {
    int nM, nN, nwg, G, c;
    __host__ __device__ void init(int M, int N, int G_, int c_) { nM = M / BM; nN = N / BM; nwg = nM * nN; G = G_; c = c_; }
    __host__ __device__ bool next(int i, Unit& u) const {
        const long L = (long)i * G + c; if (L >= nwg) return false;
        int wgid = (int)L; { const int q = nwg / NXCD, r = nwg % NXCD, xcd = wgid % NXCD, off = wgid / NXCD; wgid = (xcd < r ? xcd * (q + 1) : r * (q + 1) + (xcd - r) * q) + off; }
        const int nig = WGM * nN, gid = wgid / nig, fm = gid * WGM, gsz = (nM - fm) < WGM ? (nM - fm) : WGM;
        u.pm = fm + ((wgid % nig) % gsz); u.pn = (wgid % nig) / gsz; return true;
    }
    __device__ __forceinline__ void a_ready(const Unit&) const {}
    __device__ __forceinline__ void done(const Unit&) const {}
};

__device__ __forceinline__ unsigned cvt_pk_bf16(float lo, float hi) { unsigned r; asm volatile("v_cvt_pk_bf16_f32 %0, %1, %2" : "=v"(r) : "v"(lo), "v"(hi)); return r; }
typedef float f32x2 __attribute__((ext_vector_type(2)));
template <class Epi, class Sched, bool ALIGN_EPI = false, bool SP2 = false>
__device__ __forceinline__ void gemm_phase(PG8_LAS unsigned char* lds, const Gemm g, const Sched& S, const Epi& E) {
    int tid_o = threadIdx.x; asm volatile("" : "+v"(tid_o));
    const int tid = tid_o, wid = __builtin_amdgcn_readfirstlane(tid >> 6), lane = tid & 63, wr = wid >> 2, wc = wid & 3, fr = lane & 15, fq = lane >> 4;
    const int K = g.K, nt = K / BK;
    unsigned voffA[2], voffB[2];
#pragma unroll
    for (int i = 0; i < 2; ++i) { int R, C; stage_rc(tid * 16 + i * 8192, R, C); const int Rb = Epi::PERM ? ((R & ~31) + perm32(R & 31)) : R;
        voffA[i] = (unsigned)(R * g.lda + C) * 2u; voffB[i] = (unsigned)(Rb * K + C) * 2u; }
    const size_t kstep = (size_t)(BK * 2);
    const size_t hstepA = (size_t)HALF * g.lda * 2, hstepB = (size_t)HALF * K * 2;
    const size_t tstepA = 2 * hstepA, tstepB = 2 * hstepB;
    const unsigned ldsw = (unsigned)wid * 1024u;
    const int aoff = lds_byte(wr * 64 + fr, fq * 8), boff = lds_byte(wc * 32 + fr, fq * 8);
#define PG8_SA(b, h) (((b) * 2 + (h)) * HTB)
#define PG8_SB(b, h) ((4 + (b) * 2 + (h)) * HTB)
#define PG8_STAGE(bufoff, gbase, voff) do { _Pragma("unroll") for (int _i = 0; _i < 2; ++_i) \
        __builtin_amdgcn_global_load_lds((const unsigned*)((const char*)(gbase) + (voff)[_i]), (PG8_LAS unsigned*)(lds + (bufoff) + ldsw + _i * 8192), 16, 0, 0); } while (0)
#define PG8_LDA(dst, b, h) do { _Pragma("unroll") for (int m = 0; m < 4; ++m) _Pragma("unroll") for (int k = 0; k < 2; ++k) dst[m][k] = *(const PG8_LAS bf16x8*)(lds + PG8_SA(b, h) + aoff + m * 2048 + k * 1024); } while (0)
#define PG8_LDB(dst, b, h) do { _Pragma("unroll") for (int n = 0; n < 2; ++n) _Pragma("unroll") for (int k = 0; k < 2; ++k) dst[n][k] = *(const PG8_LAS bf16x8*)(lds + PG8_SB(b, h) + boff + n * 2048 + k * 1024); } while (0)
#define PG8_MMA(ai, bj, At, Bt) do { __builtin_amdgcn_s_setprio(1); _Pragma("unroll") for (int m = 0; m < 4; ++m) _Pragma("unroll") for (int n = 0; n < 2; ++n) _Pragma("unroll") for (int k = 0; k < 2; ++k) \
        acc[ai][bj][m][n] = __builtin_amdgcn_mfma_f32_16x16x32_bf16(Bt[n][k], At[m][k], acc[ai][bj][m][n], 0, 0, 0); __builtin_amdgcn_s_setprio(0); } while (0)
#define PG8_WAIT_V(n) asm volatile("s_waitcnt vmcnt(" #n ")" ::: "memory")
#define PG8_WAIT_L(n) asm volatile("s_waitcnt lgkmcnt(" #n ")" ::: "memory")
#define PG8_BAR __builtin_amdgcn_s_barrier()
#define PG8_SCHED __builtin_amdgcn_sched_barrier(0)
    Unit cur, nxt; int ui = 0;
    if (!S.next(0, cur)) return;
    f32x4 acc[2][2][4][2];
#pragma unroll
    for (int a = 0; a < 2; ++a)
#pragma unroll
        for (int b = 0; b < 2; ++b)
#pragma unroll
            for (int m = 0; m < 4; ++m)
#pragma unroll
                for (int n = 0; n < 2; ++n) acc[a][b][m][n] = (f32x4){0.f, 0.f, 0.f, 0.f};
    bf16x8 At[4][2], B0[2][2], B1[2][2];
    const char* cA = (const char*)g.A + (size_t)cur.pm * tstepA; const char* cB = (const char*)g.Bt + (size_t)cur.pn * tstepB;
    S.a_ready(cur);
    if constexpr (SP2) {
        PG8_STAGE(PG8_SB(0, 0), cB, voffB); PG8_STAGE(PG8_SB(0, 1), cB + hstepB, voffB); PG8_STAGE(PG8_SA(0, 0), cA, voffA); PG8_STAGE(PG8_SA(0, 1), cA + hstepA, voffA);
        if (wr == 1) PG8_BAR;
        PG8_WAIT_V(2); PG8_BAR;
        PG8_STAGE(PG8_SB(1, 0), cB + kstep, voffB); PG8_STAGE(PG8_SA(1, 0), cA + kstep, voffA); PG8_STAGE(PG8_SB(1, 1), cB + hstepB + kstep, voffB);
        PG8_WAIT_V(6); PG8_BAR;
    } else {
        PG8_STAGE(PG8_SB(0, 0), cB, voffB); PG8_STAGE(PG8_SA(0, 0), cA, voffA); PG8_STAGE(PG8_SB(0, 1), cB + hstepB, voffB); PG8_STAGE(PG8_SA(0, 1), cA + hstepA, voffA);
        if (wr == 1) PG8_BAR;
        PG8_WAIT_V(4); PG8_BAR;
        PG8_STAGE(PG8_SB(1, 0), cB + kstep, voffB); PG8_STAGE(PG8_SA(1, 0), cA + kstep, voffA); PG8_STAGE(PG8_SB(1, 1), cB + hstepB + kstep, voffB);
        PG8_WAIT_V(6); PG8_BAR;
    }
    for (;;) {
        const bool has_next = S.next(ui + 1, nxt);
        const char* nA = has_next ? (const char*)g.A + (size_t)nxt.pm * tstepA : cA; const char* nB = has_next ? (const char*)g.Bt + (size_t)nxt.pn * tstepB : cB;
        for (int t = 0; t < nt; t += 2) {
            const bool last = (t == nt - 2);
            const char* a1 = cA + (size_t)(t + 1) * kstep;
            const char* a2 = last ? nA : cA + (size_t)(t + 2) * kstep; const char* b2 = last ? nB : cB + (size_t)(t + 2) * kstep;
            const char* a3 = a2 + kstep; const char* b3 = b2 + kstep;
            if (last && has_next) S.a_ready(nxt);
            if constexpr (SP2) {
            PG8_LDB(B0, 0, 0); PG8_LDB(B1, 0, 1); PG8_SCHED; PG8_LDA(At, 0, 0); PG8_STAGE(PG8_SA(1, 1), a1 + hstepA, voffA);
            PG8_WAIT_V(8); PG8_WAIT_L(0); PG8_BAR; PG8_MMA(0, 0, At, B0); PG8_MMA(0, 1, At, B1); PG8_BAR; PG8_SCHED;
            PG8_LDA(At, 0, 1); PG8_STAGE(PG8_SB(0, 0), b2, voffB); PG8_STAGE(PG8_SB(0, 1), b2 + hstepB, voffB); PG8_STAGE(PG8_SA(0, 0), a2, voffA);
            PG8_WAIT_V(8); PG8_WAIT_L(0); PG8_BAR; PG8_MMA(1, 0, At, B0); PG8_MMA(1, 1, At, B1); PG8_BAR; PG8_SCHED;
            PG8_LDB(B0, 1, 0); PG8_LDB(B1, 1, 1); PG8_SCHED; PG8_LDA(At, 1, 0); PG8_STAGE(PG8_SA(0, 1), a2 + hstepA, voffA);
            PG8_WAIT_V(8); PG8_WAIT_L(0); PG8_BAR; PG8_MMA(0, 0, At, B0); PG8_MMA(0, 1, At, B1); PG8_BAR; PG8_SCHED;
            PG8_LDA(At, 1, 1); PG8_STAGE(PG8_SB(1, 0), b3, voffB); PG8_STAGE(PG8_SB(1, 1), b3 + hstepB, voffB); PG8_STAGE(PG8_SA(1, 0), a3, voffA);
            PG8_WAIT_V(8); PG8_WAIT_L(0); PG8_BAR; PG8_MMA(1, 0, At, B0); PG8_MMA(1, 1, At, B1); PG8_BAR; PG8_SCHED;
            } else {
            PG8_LDB(B0, 0, 0); PG8_SCHED; PG8_LDA(At, 0, 0); PG8_STAGE(PG8_SA(1, 1), a1 + hstepA, voffA);
            PG8_WAIT_L(8); PG8_BAR; PG8_WAIT_L(0); PG8_MMA(0, 0, At, B0); PG8_BAR; PG8_SCHED;
            PG8_LDB(B1, 0, 1); PG8_STAGE(PG8_SB(0, 0), b2, voffB);
            PG8_BAR; PG8_WAIT_L(0); PG8_MMA(0, 1, At, B1); PG8_BAR;
            PG8_LDA(At, 0, 1); PG8_STAGE(PG8_SA(0, 0), a2, voffA);
            PG8_BAR; PG8_WAIT_L(0); PG8_MMA(1, 0, At, B0); PG8_BAR; PG8_SCHED;
            PG8_STAGE(PG8_SB(0, 1), b2 + hstepB, voffB);
            PG8_WAIT_V(6); PG8_BAR; PG8_MMA(1, 1, At, B1); PG8_BAR;
            PG8_LDB(B0, 1, 0); PG8_SCHED; PG8_LDA(At, 1, 0); PG8_STAGE(PG8_SA(0, 1), a2 + hstepA, voffA);
            PG8_WAIT_L(8); PG8_BAR; PG8_WAIT_L(0); PG8_MMA(0, 0, At, B0); PG8_BAR; PG8_SCHED;
            PG8_LDB(B1, 1, 1); PG8_STAGE(PG8_SB(1, 0), b3, voffB);
            PG8_BAR; PG8_WAIT_L(0); PG8_MMA(0, 1, At, B1); PG8_BAR;
            PG8_LDA(At, 1, 1); PG8_STAGE(PG8_SA(1, 0), a3, voffA);
            PG8_BAR; PG8_WAIT_L(0); PG8_MMA(1, 0, At, B0); PG8_BAR; PG8_SCHED;
            PG8_STAGE(PG8_SB(1, 1), b3 + hstepB, voffB);
            PG8_WAIT_V(6); PG8_BAR; PG8_MMA(1, 1, At, B1); PG8_BAR;
            }
        }
        if constexpr (ALIGN_EPI) { if (wr == 0) PG8_BAR; }
        if constexpr (!Epi::AFTER_DRAIN) { E(acc, cur, wr, wc, fr, fq); S.done(cur); }
        if (!has_next) break;
#pragma unroll
        for (int a = 0; a < 2; ++a)
#pragma unroll
            for (int b = 0; b < 2; ++b)
#pragma unroll
                for (int m = 0; m < 4; ++m)
#pragma unroll
                    for (int n = 0; n < 2; ++n) acc[a][b][m][n] = (f32x4){0.f, 0.f, 0.f, 0.f};
        cur = nxt; cA = nA; cB = nB; ++ui;
        if constexpr (ALIGN_EPI) { if (wr == 1) PG8_BAR; }
    }
    PG8_WAIT_V(0);
    if constexpr (!ALIGN_EPI) { if (wr == 0) PG8_BAR; }
    PG8_BAR;
    if constexpr (Epi::AFTER_DRAIN) { E.fused(acc, cur, wr, wc, fr, fq, lds, wid, lane); S.done(cur); }
#undef PG8_SA
#undef PG8_SB
#undef PG8_STAGE
#undef PG8_LDA
#undef PG8_LDB
#undef PG8_MMA
#undef PG8_WAIT_V
#undef PG8_WAIT_L
#undef PG8_BAR
#undef PG8_SCHED
}
}
#define XB_TMO      128
#define XB_XCNT(j)  (256  + 64 * (j))
#define XB_XSUB(j)  (1280 + 64 * (j))
#define XB_XGEN(j)  (2304 + 64 * (j))
#define XB_TOP      3328
#define XB_TOPGEN   3392
#define XCD_BAR_WORDS 3456
#define XB_SPIN_CAP (1u << 18)

__device__ __forceinline__ unsigned xb_ld(unsigned* p)              { return __hip_atomic_load(p, __ATOMIC_RELAXED, __HIP_MEMORY_SCOPE_AGENT); }
__device__ __forceinline__ unsigned xb_add(unsigned* p, unsigned v) { return __hip_atomic_fetch_add(p, v, __ATOMIC_RELAXED, __HIP_MEMORY_SCOPE_AGENT); }
__device__ __forceinline__ unsigned xb_xcc_id() { return (unsigned)__builtin_amdgcn_s_getreg((3 << 11) | 20) & 0xFu; }
#define XB_SPIN(cond, bar) do { unsigned _sp = 0; while (cond) { __builtin_amdgcn_s_sleep(1); \
    if ((++_sp & 255u) == 0u) { if (xb_ld(&(bar)[XB_TMO])) break; if (_sp > XB_SPIN_CAP) { atomicAdd(&(bar)[XB_TMO], 1u); break; } } } } while (0)

struct XcdBarrier {
    unsigned* bar; unsigned x;
    volatile LAS unsigned* st;
};

__device__ __forceinline__ XcdBarrier xcd_barrier_post(unsigned* bar, volatile LAS unsigned* st) {
    XcdBarrier b; b.bar = bar; b.x = xb_xcc_id(); b.st = st;
    if (threadIdx.x == 0) (void)xb_add(&bar[XB_XCNT(b.x)], 1u);
    return b;
}
__device__ __forceinline__ void xcd_barrier_complete(unsigned* bar, unsigned x, unsigned& nloc, unsigned& nx) {
    const unsigned G = gridDim.x * gridDim.y * gridDim.z;
    unsigned sum, cnt, mine, sp = 0u;
    for (;;) {
        sum = 0u; cnt = 0u; mine = 0u;
#pragma unroll
        for (unsigned j = 0; j < 16; ++j) { const unsigned c = xb_ld(&bar[XB_XCNT(j)]); sum += c; cnt += (c > 0u) ? 1u : 0u; mine = (j == x) ? c : mine; }
        if (sum == G) break;
        __builtin_amdgcn_s_sleep(1);
        if ((++sp & 255u) == 0u) { if (xb_ld(&bar[XB_TMO])) break; if (sp > XB_SPIN_CAP) { atomicAdd(&bar[XB_TMO], 1u); break; } }
    }
    nloc = mine > 0u ? mine : 1u; nx = cnt > 0u ? cnt : 1u;
}

__device__ __forceinline__ void xcd_barrier(const XcdBarrier& b) {
    asm volatile("s_waitcnt vmcnt(0)" ::: "memory");
    __syncthreads();
    if (threadIdx.x == 0) {
        unsigned* bar = b.bar;
        __builtin_amdgcn_s_waitcnt(0);
        unsigned nloc = b.st[0], nx = b.st[1];
        if (nloc == 0u) { xcd_barrier_complete(bar, b.x, nloc, nx); b.st[0] = nloc; b.st[1] = nx; }
        const unsigned old = xb_add(&bar[XB_XSUB(b.x)], 1u);
        const unsigned gen = old / nloc;
        if (old + 1u == (gen + 1u) * nloc) {
            __builtin_amdgcn_fence(__ATOMIC_RELEASE, "agent");
            asm volatile("s_waitcnt vmcnt(0)" ::: "memory");
            const unsigned og = xb_add(&bar[XB_TOP], 1u);
            const unsigned tg = og / nx;
            if (og + 1u == (tg + 1u) * nx) xb_add(&bar[XB_TOPGEN], 1u);
            else XB_SPIN(xb_ld(&bar[XB_TOPGEN]) == tg, bar);
            __builtin_amdgcn_fence(__ATOMIC_ACQUIRE, "agent");
            xb_add(&bar[XB_XGEN(b.x)], 1u);
            asm volatile("s_waitcnt vmcnt(0)" ::: "memory");
        } else {
            XB_SPIN(xb_ld(&bar[XB_XGEN(b.x)]) == gen, bar);
            __builtin_amdgcn_fence(__ATOMIC_ACQUIRE, "agent");
            asm volatile("s_waitcnt vmcnt(0)" ::: "memory");
        }
    }
    __syncthreads();
}

typedef unsigned short bf16;
typedef GAS unsigned gu32;
constexpr int D_MODEL = 1024, SEQ = 2048, D_INNER = 2048, MTOK = 16384, NWAVES = 8;
constexpr float QK_SCALE = 0.08838834764831845f;
constexpr size_t MiB = 1u << 20;
constexpr size_t WS_CTL = 0, CTL_ZERO_BYTES = 64 * 1024, WS_TAB = 1 * MiB, WS_SSQ = 3 * MiB, WS_MASK = 7 * MiB, WS_WIN = 12 * MiB, WS_WOUT = 28 * MiB, WS_U = 32 * MiB, WS_P = 64 * MiB, WS_END = 256 * MiB;
constexpr int CW_BAR = 1024;
constexpr int RING_BYTES = 131072, MISC_OFF = RING_BYTES + 320, LDS_BYTES = 147456;
__host__ __device__ constexpr int n1pad(int L) { return L == 0 ? 3584 : (L == 1 ? 6144 : (L == 2 ? 4096 : 6144)); }
__host__ __device__ constexpr int n1real(int L) { return L == 0 ? 3408 : (L == 1 ? 6144 : (L == 2 ? 4096 : 6144)); }
__host__ __device__ constexpr int nsrc(int L) { return L == 0 ? 5456 : (L == 1 ? 8192 : (L == 2 ? 6144 : 8192)); }
__host__ __device__ constexpr int ocol(int L) { return L == 0 ? 0 : (L == 1 ? 0 : (L == 2 ? 2048 : 4096)); }
constexpr int A_K = 2048, A_V = 2176, A_IQ = 2304, A_IK = 3328, A_IW = 3392;

__device__ __forceinline__ float bf2f(bf16 v) { return __uint_as_float(((unsigned)v) << 16); }
__device__ __forceinline__ bf16 f2bf(float f) { unsigned u = __float_as_uint(f); return (bf16)((u + 0x7fffu + ((u >> 16) & 1u)) >> 16); }
__device__ __forceinline__ unsigned pk2(float lo, float hi) { return (unsigned)f2bf(lo) | ((unsigned)f2bf(hi) << 16); }
template <int CTRL, int ROWMASK> __device__ __forceinline__ float dpp_f(float old, float v) { return __int_as_float(__builtin_amdgcn_update_dpp(__float_as_int(old), __float_as_int(v), CTRL, ROWMASK, 0xf, false)); }
template <int CTRL, int ROWMASK> __device__ __forceinline__ int dpp_i(int old, int v) { return __builtin_amdgcn_update_dpp(old, v, CTRL, ROWMASK, 0xf, false); }
__device__ __forceinline__ float half_sum_f(float v) {
    v += dpp_f<0x111, 0xf>(0.f, v); v += dpp_f<0x112, 0xf>(0.f, v); v += dpp_f<0x114, 0xf>(0.f, v); v += dpp_f<0x118, 0xf>(0.f, v); v += dpp_f<0x142, 0xa>(0.f, v);
    return v;
}
__device__ __forceinline__ int half_sum_i(int v) {
    v += dpp_i<0x111, 0xf>(0, v); v += dpp_i<0x112, 0xf>(0, v); v += dpp_i<0x114, 0xf>(0, v); v += dpp_i<0x118, 0xf>(0, v); v += dpp_i<0x142, 0xa>(0, v);
    return v;
}
__device__ __forceinline__ float wave_sum(float v) {
    v = half_sum_f(v); v += dpp_f<0x143, 0xc>(0.f, v);
    return __int_as_float(__builtin_amdgcn_readlane(__float_as_int(v), 63));
}
__device__ __forceinline__ float wave_max(float v) {
    v = fmaxf(v, dpp_f<0x111, 0xf>(v, v)); v = fmaxf(v, dpp_f<0x112, 0xf>(v, v)); v = fmaxf(v, dpp_f<0x114, 0xf>(v, v)); v = fmaxf(v, dpp_f<0x118, 0xf>(v, v));
    v = fmaxf(v, dpp_f<0x142, 0xa>(v, v)); v = fmaxf(v, dpp_f<0x143, 0xc>(v, v));
    return __int_as_float(__builtin_amdgcn_readlane(__float_as_int(v), 63));
}
__device__ __forceinline__ float lane_xor1(float v) { return dpp_f<0xB1, 0xf>(v, v); }
__device__ __forceinline__ float ret_lg(int h) { const float x = __builtin_amdgcn_exp2f(-5.f - (float)h); return -(x + x * x * (0.5f + x * (0.33333334f + 0.25f * x))) * 1.4426950408889634f; }
__device__ __forceinline__ float silu_f(float z) { return z * __builtin_amdgcn_rcpf(1.f + __expf(-z)); }
__device__ __forceinline__ float sigmoid_f(float z) { return __builtin_amdgcn_rcpf(1.f + __expf(-z)); }
#define LDS_WAIT() asm volatile("s_waitcnt lgkmcnt(0)" ::: "memory")
#define LDS_BARRIER() do { asm volatile("s_waitcnt lgkmcnt(0)" ::: "memory"); __builtin_amdgcn_s_barrier(); asm volatile("" ::: "memory"); } while (0)
#define PHASE_IDS() int tid_o_ = threadIdx.x; asm volatile("" : "+v"(tid_o_)); const int tid = tid_o_, lane = tid & 63, wave = __builtin_amdgcn_readfirstlane(tid >> 6); (void)lane; (void)wave

struct Frame {
    LAS unsigned char* lds; unsigned char* lds_gen; volatile LAS unsigned* MISC; unsigned* ctl;
    int G;
    const float* x; const float* norm_g; const float* final_g; const float* w_in[4]; const float* w_out[4]; const float* lb_logits;
    float* H;
    float *cos128, *sin128, *cos64, *sin64, *lb, *ssq; unsigned* mask;
    bf16 *WIN, *WOUT, *U, *P;
};

template <int L> __device__ __forceinline__ int proj_mode(int g32) {
    if (L == 0) return g32 < 68 ? 1 : (g32 < 72 ? 0 : (g32 < 106 ? 2 : 0));
    if (L == 1) return g32 < 128 ? 1 : 0;
    if (L == 2) return g32 < 32 ? 1 : (g32 < 64 ? 3 : 0);
    return g32 < 64 ? 4 : (g32 < 128 ? 5 : 0);
}
template <int L> struct EpiProj {
    static constexpr bool PERM = true, AFTER_DRAIN = false;
    bf16* P; int ldp; const float *c128, *s128, *c64, *s64, *lb;
    __device__ __forceinline__ void operator()(const pg8::f32x4 (&acc)[2][2][4][2], const pg8::Unit& u, int wr, int wc, int fr, int fq) const {
        const int row0 = u.pm * 256 + wr * 64 + fr, colb = u.pn * 256 + wc * 32 + 8 * fq;
#pragma unroll
        for (int bj = 0; bj < 2; ++bj) {
            const int col = colb + bj * 128; const int mode = proj_mode<L>(__builtin_amdgcn_readfirstlane(col >> 5));
#pragma unroll
            for (int ai = 0; ai < 2; ++ai)
#pragma unroll
                for (int m = 0; m < 4; ++m) {
                    const int row = row0 + ai * 128 + m * 16, pos = row & (SEQ - 1);
                    pg8::f32x4 v0 = acc[ai][bj][m][0], v1 = acc[ai][bj][m][1];
                    if (mode == 1 || mode == 3) { const int i0 = ((col & 127) >> 3) * 4;
                        const pg8::f32x4 c = *(const pg8::f32x4*)(c128 + pos * 64 + i0), s = *(const pg8::f32x4*)(s128 + pos * 64 + i0);
                        const pg8::f32x4 o1 = v0 * c - v1 * s, o2 = v0 * s + v1 * c; v0 = o1; v1 = o2;
                        if (L == 2) { const float lgh = ret_lg((col >> 7) & 7); const float fsc = (mode == 3) ? QK_SCALE * __builtin_amdgcn_exp2f(-(float)(pos & 127) * lgh) : __builtin_amdgcn_exp2f((float)(pos & 127) * lgh); v0 = v0 * fsc; v1 = v1 * fsc; }
                        else if (mode == 3) { v0 = v0 * QK_SCALE; v1 = v1 * QK_SCALE; } }
                    else if (mode == 2) { const int i0 = ((col & 63) >> 3) * 4;
                        const pg8::f32x4 c = *(const pg8::f32x4*)(c64 + pos * 32 + i0), s = *(const pg8::f32x4*)(s64 + pos * 32 + i0);
                        const pg8::f32x4 o1 = v0 * c - v1 * s, o2 = v0 * s + v1 * c; v0 = o1; v1 = o2; }
                    else if (mode == 4) {
#pragma unroll
                        for (int j = 0; j < 4; ++j) { v0[j] = silu_f(v0[j]) * QK_SCALE; v1[j] = silu_f(v1[j]) * QK_SCALE; } }
                    else if (mode == 5) { const pg8::f32x4 l0 = *(const pg8::f32x4*)(lb + col - 2048), l1 = *(const pg8::f32x4*)(lb + col - 2048 + 4);
#pragma unroll
                        for (int j = 0; j < 4; ++j) { v0[j] = __logf(l0[j] + (1.f - l0[j]) * sigmoid_f(v0[j])); v1[j] = __logf(l1[j] + (1.f - l1[j]) * sigmoid_f(v1[j])); } }
                    pg8::u32x4 w; w.x = pg8::cvt_pk_bf16(v0[0], v0[1]); w.y = pg8::cvt_pk_bf16(v0[2], v0[3]); w.z = pg8::cvt_pk_bf16(v1[0], v1[1]); w.w = pg8::cvt_pk_bf16(v1[2], v1[3]);
                    *(pg8::u32x4*)(P + (size_t)row * ldp + col) = w;
                }
        }
    }
};
template <int L> struct EpiGate {
    static constexpr bool PERM = true, AFTER_DRAIN = false;
    bf16* O; int ldo; const float* ssq;
    __device__ __forceinline__ void operator()(const pg8::f32x4 (&acc)[2][2][4][2], const pg8::Unit& u, int wr, int wc, int fr, int fq) const {
        const int row0 = u.pm * 256 + wr * 64 + fr, colb = u.pn * 256 + wc * 32 + 8 * fq;
#pragma unroll
        for (int ai = 0; ai < 2; ++ai)
#pragma unroll
            for (int m = 0; m < 4; ++m) {
                const int row = row0 + ai * 128 + m * 16;
#pragma unroll
                for (int bj = 0; bj < 2; ++bj) {
                    const int col = colb + bj * 128; float rs = 1.f;
                    if (L == 2) { const pg8::f32x4 q = *(const pg8::f32x4*)(ssq + ((size_t)row * 8 + (col >> 8)) * 8), q2 = *(const pg8::f32x4*)(ssq + ((size_t)row * 8 + (col >> 8)) * 8 + 4);
                        rs = rsqrtf((((q[0] + q[1]) + (q[2] + q[3])) + ((q2[0] + q2[1]) + (q2[2] + q2[3]))) * (1.f / 256.f) + 1e-6f); }
                    if (L == 3) { const pg8::f32x4 q = *(const pg8::f32x4*)(ssq + ((size_t)row * 16 + (col >> 7)) * 4); rs = rsqrtf(((q[0] + q[1]) + (q[2] + q[3])) * (1.f / 128.f) + 1e-6f); }
                    bf16* p = O + (size_t)row * ldo + col; const pg8::u32x4 r = *(const pg8::u32x4*)p;
                    const pg8::f32x4 z0 = acc[ai][bj][m][0], z1 = acc[ai][bj][m][1];
                    float o[8]; o[0] = __uint_as_float(r.x << 16); o[1] = __uint_as_float(r.x & 0xffff0000u); o[2] = __uint_as_float(r.y << 16); o[3] = __uint_as_float(r.y & 0xffff0000u);
                    o[4] = __uint_as_float(r.z << 16); o[5] = __uint_as_float(r.z & 0xffff0000u); o[6] = __uint_as_float(r.w << 16); o[7] = __uint_as_float(r.w & 0xffff0000u);
#pragma unroll
                    for (int j = 0; j < 4; ++j) { o[j] = o[j] * rs * silu_f(z0[j]); o[4 + j] = o[4 + j] * rs * silu_f(z1[j]); }
                    pg8::u32x4 w; w.x = pg8::cvt_pk_bf16(o[0], o[1]); w.y = pg8::cvt_pk_bf16(o[2], o[3]); w.z = pg8::cvt_pk_bf16(o[4], o[5]); w.w = pg8::cvt_pk_bf16(o[6], o[7]);
                    *(pg8::u32x4*)p = w;
                }
            }
    }
};
struct EpiAddF32 {
    static constexpr bool PERM = false, AFTER_DRAIN = false;
    float* C; int ldc;
    __device__ __forceinline__ void operator()(const pg8::f32x4 (&acc)[2][2][4][2], const pg8::Unit& u, int wr, int wc, int fr, int fq) const {
        const int row0 = u.pm * 256 + wr * 64 + fr, col0 = u.pn * 256 + wc * 32 + 4 * fq;
#pragma unroll
        for (int ai = 0; ai < 2; ++ai)
#pragma unroll
            for (int m = 0; m < 4; ++m) { float* rowp = C + (size_t)(row0 + ai * 128 + m * 16) * ldc + col0;
#pragma unroll
                for (int bj = 0; bj < 2; ++bj)
#pragma unroll
                    for (int n = 0; n < 2; ++n) { pg8::f32x4* p = (pg8::f32x4*)(rowp + bj * 128 + n * 16); *p = *p + acc[ai][bj][m][n]; } }
    }
};

template <int L> __device__ __forceinline__ int srccol(int n) {
    if (n >= n1pad(L)) return n1real(L) + (n - n1pad(L));
    if (n >= n1real(L)) return -1;
    const int mode = proj_mode<L>(n >> 5);
    if (mode == 1 || mode == 3) { const int w = n & 127; return (n & ~127) + 64 * ((w >> 2) & 1) + 4 * (w >> 3) + (w & 3); }
    if (mode == 2) { const int r = n - A_IQ, w = r & 63; return A_IQ + (r & ~63) + 32 * ((w >> 2) & 1) + 4 * (w >> 3) + (w & 3); }
    return n;
}
template <int L  > __device__ __forceinline__ void conv_item(const float* W, int Nsrc, bf16* WT, int Kdim, int nblk, int item, LAS float* scr, int lane) {
    const int kb = item / nblk, nb = item % nblk, k0 = 32 * kb, n0 = 64 * nb;
    int src = n0 + 4 * (lane & 15); if (L >= 0) src = srccol<(L < 0 ? 0 : L)>(src);
    pg8::f32x4 v[8];
#pragma unroll
    for (int i = 0; i < 8; ++i) { const int kk = 4 * i + (lane >> 4); v[i] = (src >= 0) ? *(const pg8::f32x4*)(W + (size_t)(k0 + kk) * Nsrc + src) : (pg8::f32x4){0.f, 0.f, 0.f, 0.f}; }
#pragma unroll
    for (int i = 0; i < 8; ++i) { const int kk = 4 * i + (lane >> 4); *(LAS pg8::f32x4*)(scr + kk * 68 + 4 * (lane & 15)) = v[i]; }
    LDS_WAIT();
    const int c = lane & 3;
#pragma unroll
    for (int j = 0; j < 4; ++j) { const int n = (lane >> 2) + 16 * j; const LAS float* s = scr + (8 * c) * 68 + n;
        pg8::u32x4 o; o.x = pk2(s[0 * 68], s[1 * 68]); o.y = pk2(s[2 * 68], s[3 * 68]); o.z = pk2(s[4 * 68], s[5 * 68]); o.w = pk2(s[6 * 68], s[7 * 68]);
        *(pg8::u32x4*)(WT + (size_t)(n0 + n) * Kdim + k0 + 8 * c) = o; }
    LDS_WAIT();
}
template <int L> __device__ __forceinline__ void conv_weights(Frame& F) {
    PHASE_IDS();
    LAS float* scr = (LAS float*)(F.lds + wave * 16384);
    const int gw = blockIdx.x * NWAVES + wave, NGW = F.G * NWAVES;
    constexpr int NB_IN = (n1pad(L) + 2048) / 64, I_IN = NB_IN * (1024 / 32), NB_OUT = 1024 / 64, I_OUT = NB_OUT * (2048 / 32);
    for (int it = gw; it < I_IN + I_OUT; it += NGW) {
        if (it < I_IN) conv_item<L>(F.w_in[L], nsrc(L), F.WIN, 1024, NB_IN, it, scr, lane);
        else conv_item<-1>(F.w_out[L], 1024, F.WOUT, 2048, NB_OUT, it - I_IN, scr, lane);
    }
}
__device__ __forceinline__ void norm_rows(Frame& F, const float* src, const float* g, float* copy_to) {
    PHASE_IDS();
    const int gw = blockIdx.x * NWAVES + wave, NGW = F.G * NWAVES;
    float4 gg[4];
#pragma unroll
    for (int j = 0; j < 4; ++j) gg[j] = ((const float4*)g)[lane + 64 * j];
    for (int row = gw; row < MTOK; row += 2 * NGW) {
        const int row2 = row + NGW;
        const float4* xa = (const float4*)(src + (size_t)row * D_MODEL) + lane; const float4* xb = (const float4*)(src + (size_t)row2 * D_MODEL) + lane;
        float4 va[4], vb[4]; float sa = 0.f, sb = 0.f;
#pragma unroll
        for (int j = 0; j < 4; ++j) { va[j] = xa[64 * j]; vb[j] = xb[64 * j]; }
#pragma unroll
        for (int j = 0; j < 4; ++j) { sa += va[j].x * va[j].x + va[j].y * va[j].y + va[j].z * va[j].z + va[j].w * va[j].w; sb += vb[j].x * vb[j].x + vb[j].y * vb[j].y + vb[j].z * vb[j].z + vb[j].w * vb[j].w; }
        const float ra = rsqrtf(wave_sum(sa) * (1.f / D_MODEL) + 1e-6f), rb = rsqrtf(wave_sum(sb) * (1.f / D_MODEL) + 1e-6f);
#pragma unroll
        for (int j = 0; j < 4; ++j) {
            if (copy_to) { ((float4*)(copy_to + (size_t)row * D_MODEL))[lane + 64 * j] = va[j]; ((float4*)(copy_to + (size_t)row2 * D_MODEL))[lane + 64 * j] = vb[j]; }
            uint2 o; o.x = pk2(va[j].x * ra * gg[j].x, va[j].y * ra * gg[j].y); o.y = pk2(va[j].z * ra * gg[j].z, va[j].w * ra * gg[j].w);
            *(uint2*)(F.U + (size_t)row * D_MODEL + (lane + 64 * j) * 4) = o;
            uint2 o2; o2.x = pk2(vb[j].x * rb * gg[j].x, vb[j].y * rb * gg[j].y); o2.y = pk2(vb[j].z * rb * gg[j].z, vb[j].w * rb * gg[j].w);
            *(uint2*)(F.U + (size_t)row2 * D_MODEL + (lane + 64 * j) * 4) = o2;
        }
    }
}
__device__ __forceinline__ void final_rows(Frame& F) {
    PHASE_IDS();
    const int gw = blockIdx.x * NWAVES + wave, NGW = F.G * NWAVES;
    for (int row = gw; row < MTOK; row += NGW) {
        float4* xr = (float4*)(F.H + (size_t)row * D_MODEL) + lane;
        float4 v[4]; float s = 0.f;
#pragma unroll
        for (int j = 0; j < 4; ++j) { v[j] = xr[64 * j]; s += v[j].x * v[j].x + v[j].y * v[j].y + v[j].z * v[j].z + v[j].w * v[j].w; }
        const float r = rsqrtf(wave_sum(s) * (1.f / D_MODEL) + 1e-6f);
#pragma unroll
        for (int j = 0; j < 4; ++j) { const float4 gg = ((const float4*)F.final_g)[lane + 64 * j]; xr[64 * j] = make_float4(v[j].x * r * gg.x, v[j].y * r * gg.y, v[j].z * r * gg.z, v[j].w * r * gg.w); }
    }
}
__device__ __forceinline__ void make_tables(Frame& F) {
    PHASE_IDS();
    const int gt = blockIdx.x * 512 + tid, NT = F.G * 512;
    for (int i = gt; i < 2048 * 64; i += NT) {
        { const int pos = i >> 6, f = i & 63; const float freq = exp2f(-((float)(2 * f) / 128.f) * 13.287712379549449f);
          double rev = (double)pos * (double)freq * 0.15915494309189535; rev -= floor(rev);
          F.cos128[i] = __builtin_amdgcn_cosf((float)rev); F.sin128[i] = __builtin_amdgcn_sinf((float)rev); }
        if (i < 2048 * 32) { const int pos = i >> 5, f = i & 31; const float freq = exp2f(-((float)(2 * f) / 64.f) * 13.287712379549449f);
          double rev = (double)pos * (double)freq * 0.15915494309189535; rev -= floor(rev);
          F.cos64[i] = __builtin_amdgcn_cosf((float)rev); F.sin64[i] = __builtin_amdgcn_sinf((float)rev); }
        if (i < 2048) { const float l0 = F.lb_logits[i], l1 = F.lb_logits[2048 + i], l2 = F.lb_logits[4096 + i], l3 = F.lb_logits[6144 + i];
          const float m = fmaxf(fmaxf(l0, l1), fmaxf(l2, l3)); const float e0 = __expf(l0 - m), e1 = __expf(l1 - m), e2 = __expf(l2 - m), e3 = __expf(l3 - m);
          F.lb[i] = (e1 + e2 + e3) / (e0 + e1 + e2 + e3); }
    }
}
namespace att {
constexpr int D = 128;
constexpr float THR = 8.f;
constexpr bool WSKIP = false;
constexpr float SCALE = 0.08838834764831845f;
constexpr int NW = 8, QBLK = 32, KVBLK = 64, QB = NW * QBLK;
constexpr int SHM_V = KVBLK * D * 2, SHM_K = KVBLK * D * 2;
constexpr int LDS_BYTES = 2 * SHM_V + 2 * SHM_K + NW * 64 * 4;
typedef short bf16x8 __attribute__((ext_vector_type(8)));
typedef short s16x4 __attribute__((ext_vector_type(4)));
typedef float f32x16 __attribute__((ext_vector_type(16)));
typedef float f32x4 __attribute__((ext_vector_type(4)));
typedef unsigned u32x4 __attribute__((ext_vector_type(4)));
template <class A, class Bt> struct same_t { static constexpr bool v = false; };
template <class A> struct same_t<A, A> { static constexpr bool v = true; };
#define KSWZ(row, colB) ((row) * 256 + ((colB) ^ (((row) & 7) << 4)))
#define SBAR() __builtin_amdgcn_sched_barrier(0)
__device__ __forceinline__ int v_st(int k, int c) { const int kk = (k & ~0xC) | ((k & 4) << 1) | ((k & 8) >> 1); return ((kk >> 3) * 4 + (c >> 5)) * 512 + ((kk & 7) * 32 + (c & 31)) * 2; }
__device__ __forceinline__ int v_rd_base(int lane) { return ((lane & 3) << 3) | (((lane >> 2) & 3) << 6) | (((lane >> 4) & 1) << 5) | (((lane >> 5) & 1) << 8); }
constexpr int v_rd_off(int d0, int ks, int half) { return d0 * 512 + ks * 4096 + half * 2048; }
__device__ __forceinline__ int crow(int r, int hi) { return (r & 3) + 8 * (r >> 2) + 4 * hi; }
__device__ __forceinline__ unsigned cvtpk(float lo, float hi) {
    unsigned r; asm volatile("v_cvt_pk_bf16_f32 %0, %1, %2" : "=v"(r) : "v"(lo), "v"(hi)); return r;
}
__device__ __forceinline__ bf16x8 pack8(f32x4 a, f32x4 b) {
    u32x4 w = {cvtpk(a[0], a[1]), cvtpk(a[2], a[3]), cvtpk(b[0], b[1]), cvtpk(b[2], b[3])};
    return *reinterpret_cast<bf16x8*>(&w);
}
template <class T> __device__ __forceinline__ bf16x8 load8(const T* p) {
    if constexpr (same_t<T, float>::v) { return pack8(*(const f32x4*)p, *(const f32x4*)(p + 4)); }
    else { return *reinterpret_cast<const bf16x8*>(p); }
}
__device__ __forceinline__ void mask_bits(f32x16& p0, f32x16& p1, unsigned w0, unsigned w1) {
    const float NEG = -__builtin_inff();
#pragma unroll
    for (int r = 0; r < 16; ++r) { const int c = (r & 3) + 8 * (r >> 2); if (!((w0 >> c) & 1u)) p0[r] = NEG; if (!((w1 >> c) & 1u)) p1[r] = NEG; }
}
__device__ __forceinline__ float wmult(float s, int d) {
    const unsigned ud = (unsigned)d; const int cnt = (ud <= 128u ? 1 : 0) + ((((d & 3) == 0) && ud <= 512u) ? 1 : 0) + ((((d & 15) == 0) && d >= 0) ? 1 : 0);
    const float add = cnt >= 3 ? 12.4293792f : (cnt == 2 ? 7.84206515f : 0.f);
    return cnt == 0 ? -__builtin_inff() : s + add;
}
__device__ __forceinline__ void mask_mult(f32x16& p0, f32x16& p1, int dq) {
#pragma unroll
    for (int r = 0; r < 16; ++r) { const int c = (r & 3) + 8 * (r >> 2); p0[r] = wmult(p0[r], dq - c); p1[r] = wmult(p1[r], dq - c - 32); }
}
__device__ __forceinline__ void mask_far(f32x16& p0, f32x16& p1, int dq) {
    const float NEG = -__builtin_inff(); const int dm = dq & 15;
#pragma unroll
    for (int r = 0; r < 16; ++r) { const int c = ((r & 3) + 8 * (r >> 2)) & 15; const float v = (dm == c) ? 0.f : NEG; p0[r] += v; p1[r] += v; }
}
__device__ __forceinline__ void mask_mid(f32x16& p0, f32x16& p1, int dq) {
    const float NEG = -__builtin_inff(); const int dm = dq & 15, d4 = dq & 3;
#pragma unroll
    for (int r = 0; r < 16; ++r) { const int c = ((r & 3) + 8 * (r >> 2)) & 15; const float v = (dm == c) ? 7.84206515f : ((d4 == (r & 3)) ? 0.f : NEG); p0[r] += v; p1[r] += v; }
}
__device__ __forceinline__ void mask_near(f32x16& p0, f32x16& p1, int dq) {
    const int dm = dq & 15, d4 = dq & 3;
#pragma unroll
    for (int r = 0; r < 16; ++r) { const int c = ((r & 3) + 8 * (r >> 2)) & 15; const float v = (dm == c) ? 12.4293792f : ((d4 == (r & 3)) ? 7.84206515f : 0.f); p0[r] += v; p1[r] += v; }
}
__device__ __forceinline__ void partialSM(f32x16& p0, f32x16& p1, float& m_reg, float& mn, float& alpha) {
    float pmax = p0[0]; for (int r = 1; r < 16; ++r) pmax = fmaxf(pmax, p0[r]); for (int r = 0; r < 16; ++r) pmax = fmaxf(pmax, p1[r]);
    { auto rr = __builtin_amdgcn_permlane32_swap(__float_as_uint(pmax), __float_as_uint(pmax), false, false);
      pmax = fmaxf(__uint_as_float(rr[0]), __uint_as_float(rr[1])); }
    constexpr float C2 = 1.4426950408889634f * SCALE;
    if (__builtin_expect(__all((pmax - m_reg) * SCALE <= THR), 1)) { mn = m_reg; alpha = 1.f; }
    else { mn = fmaxf(m_reg, pmax); alpha = __builtin_amdgcn_exp2f((m_reg - mn) * C2); m_reg = mn; }
    const float mnL = -mn * C2;
    for (int r = 0; r < 16; ++r) p0[r] = fmaf(p0[r], C2, mnL); for (int r = 0; r < 16; ++r) p1[r] = fmaf(p1[r], C2, mnL);
    for (int r = 0; r < 16; ++r) p0[r] = __builtin_amdgcn_exp2f(p0[r]);
}
__device__ __forceinline__ void finishSM(f32x16& p0, f32x16& p1, float alpha, float& l_reg, bf16x8& pa0, bf16x8& pa1, bf16x8& pa2, bf16x8& pa3) {
    for (int r = 0; r < 16; ++r) p1[r] = __builtin_amdgcn_exp2f(p1[r]);
    float ps = 0; for (int r = 0; r < 16; ++r) ps += p0[r]; for (int r = 0; r < 16; ++r) ps += p1[r];
    { auto rr = __builtin_amdgcn_permlane32_swap(__float_as_uint(ps), __float_as_uint(ps), false, false);
      ps = __uint_as_float(rr[0]) + __uint_as_float(rr[1]); }
    l_reg = l_reg * alpha + ps;
#define PK4(P, B_, OUT) do { unsigned a0 = cvtpk(P[B_+0], P[B_+1]), a1 = cvtpk(P[B_+2], P[B_+3]);                          \
        unsigned b0 = cvtpk(P[B_+4], P[B_+5]), b1 = cvtpk(P[B_+6], P[B_+7]);                                             \
        auto r0 = __builtin_amdgcn_permlane32_swap(a0, b0, false, false); auto r1 = __builtin_amdgcn_permlane32_swap(a1, b1, false, false); \
        u32x4 w = {r0[0], r1[0], r0[1], r1[1]}; OUT = *reinterpret_cast<bf16x8*>(&w); } while (0)
    PK4(p0, 0, pa0); PK4(p0, 8, pa1); PK4(p1, 0, pa2); PK4(p1, 8, pa3);
#undef PK4
}
template <int KB, bool SK>
__device__ __forceinline__ void qkt(f32x16& p0, f32x16& p1, const char* K_lds, int r32, int hi, const bf16x8* qr, bool act) {
    if (SK && !act) { const float NEG = -__builtin_inff();
#pragma unroll
        for (int r = 0; r < 16; ++r) { p0[r] = NEG; p1[r] = NEG; } return; }
    p0 = f32x16{}; p1 = f32x16{};
    const char* kb[4];
#pragma unroll
    for (int dd = 0; dd < 4; ++dd) kb[dd] = K_lds + KB * SHM_K + KSWZ(r32, (dd * 16 + hi * 8) * 2);
#pragma unroll
    for (int d0 = 0; d0 < 8; ++d0) { const char* a = kb[d0 & 3] + (d0 >> 2) * 128;
        bf16x8 b0 = *reinterpret_cast<const bf16x8*>(a);
        bf16x8 b1 = *reinterpret_cast<const bf16x8*>(a + 32 * 256);
        p0 = __builtin_amdgcn_mfma_f32_32x32x16_bf16(b0, qr[d0], p0, 0, 0, 0);
        p1 = __builtin_amdgcn_mfma_f32_32x32x16_bf16(b1, qr[d0], p1, 0, 0, 0); }
}
template <int VB, bool SK>
__device__ __forceinline__ void pv_tile(f32x16* o, int vb0, bf16x8 pa0, bf16x8 pa1, bf16x8 pa2, bf16x8 pa3, bool act) {
    if (SK && !act) return;
#define TRRD(dst, off) asm volatile("ds_read_b64_tr_b16 %0, %1 offset:%2" : "=&v"(dst) : "v"(vb0), "i"(off) : "memory")
#define PV_D0(d0) do { s16x4 l0, l1, l2, l3, h0, h1, h2, h3; constexpr int b_ = VB * SHM_V + v_rd_off(d0, 0, 0);     \
        TRRD(l0, b_); TRRD(h0, b_ + 2048); TRRD(l1, b_ + 4096); TRRD(h1, b_ + 6144); TRRD(l2, b_ + 8192); TRRD(h2, b_ + 10240); TRRD(l3, b_ + 12288); TRRD(h3, b_ + 14336); \
        asm volatile("s_waitcnt lgkmcnt(0)" ::: "memory"); SBAR();                 \
        o[d0] = __builtin_amdgcn_mfma_f32_32x32x16_bf16(pa0, (bf16x8){l0[0], l0[1], l0[2], l0[3], h0[0], h0[1], h0[2], h0[3]}, o[d0], 0, 0, 0);   \
        o[d0] = __builtin_amdgcn_mfma_f32_32x32x16_bf16(pa1, (bf16x8){l1[0], l1[1], l1[2], l1[3], h1[0], h1[1], h1[2], h1[3]}, o[d0], 0, 0, 0);   \
        o[d0] = __builtin_amdgcn_mfma_f32_32x32x16_bf16(pa2, (bf16x8){l2[0], l2[1], l2[2], l2[3], h2[0], h2[1], h2[2], h2[3]}, o[d0], 0, 0, 0);   \
        o[d0] = __builtin_amdgcn_mfma_f32_32x32x16_bf16(pa3, (bf16x8){l3[0], l3[1], l3[2], l3[3], h3[0], h3[1], h3[2], h3[3]}, o[d0], 0, 0, 0); } while (0)
    PV_D0(0); PV_D0(1); PV_D0(2); PV_D0(3);
#undef PV_D0
#undef TRRD
}
template <class TIn, class TOut> struct BlockRef { const TIn* Q; const TIn* K; const TIn* V; TOut* O; const unsigned* M; int P0; };
template <class TIn> struct Seam {
    bf16x8 qr[8];
    bf16x8 st_v0, st_v1, st_k0, st_k1; f32x4 sf0, sf1, sf2, sf3;
    f32x4 tq[16];
};
__device__ __forceinline__ int swa_jlo(int P0, int W) { const int lowk = P0 - W + 1; return lowk > 0 ? lowk / KVBLK : 0; }
#define ROW(p, k0, rr) ((p) + (size_t)((k0) + (rr)) * RSK + sc)
#define VMW() asm volatile("s_waitcnt vmcnt(0)" ::: "memory")
#define VMWN(n) asm volatile("s_waitcnt vmcnt(%0)" :: "i"(n) : "memory")
#define SLOAD_H(Kp, Vp, k0) do { S.st_v0 = load8<TIn>(ROW(Vp, k0, sr)); S.st_v1 = load8<TIn>(ROW(Vp, k0, 32 + sr));              \
                         S.st_k0 = load8<TIn>(ROW(Kp, k0, sr)); S.st_k1 = load8<TIn>(ROW(Kp, k0, 32 + sr)); } while (0)
#define SWRITE_HK(bf) do { *(bf16x8*)(K_lds + (bf) * SHM_K + kws) = S.st_k0; *(bf16x8*)(K_lds + (bf) * SHM_K + kws + 32 * 256) = S.st_k1; } while (0)
#define SWRITE_HV(bf) do { *(bf16x8*)(V_lds + (bf) * SHM_V + vst0) = S.st_v0; *(bf16x8*)(V_lds + (bf) * SHM_V + vst1) = S.st_v1; } while (0)
#define SWRITE_H(bf) do { SWRITE_HV(bf); SWRITE_HK(bf); } while (0)
#define SLOAD_F(p, k0) do { S.sf0 = *(const f32x4*)ROW(p, k0, sr); S.sf1 = *(const f32x4*)(ROW(p, k0, sr) + 4);                \
                            S.sf2 = *(const f32x4*)ROW(p, k0, 32 + sr); S.sf3 = *(const f32x4*)(ROW(p, k0, 32 + sr) + 4); } while (0)
#define SWRITE_KF(bf) do { *(bf16x8*)(K_lds + (bf) * SHM_K + kws) = pack8(S.sf0, S.sf1); *(bf16x8*)(K_lds + (bf) * SHM_K + kws + 32 * 256) = pack8(S.sf2, S.sf3); } while (0)
#define SWRITE_VF(bf) do { *(bf16x8*)(V_lds + (bf) * SHM_V + vst0) = pack8(S.sf0, S.sf1); *(bf16x8*)(V_lds + (bf) * SHM_V + vst1) = pack8(S.sf2, S.sf3); } while (0)
template <class TIn, class TOut, int RSQ, int RSK, int MK>
__device__ __forceinline__ void causal_swa_prime(const BlockRef<TIn, TOut>& cur, int W, char* lds, Seam<TIn>& S) {
    constexpr bool F32 = same_t<TIn, float>::v;
    int tid_o = threadIdx.x; asm volatile("" : "+v"(tid_o)); const int tid = tid_o, wid = __builtin_amdgcn_readfirstlane(tid >> 6), lane = tid & 63, r32 = lane & 31, hi = lane >> 5;
    const int sr = tid >> 4, sc = (tid & 15) * 8, kws = KSWZ(sr, sc * 2); char* K_lds = lds + 2 * SHM_V;
    const int kb0 = swa_jlo(cur.P0, W) * KVBLK;
    for (int d0 = 0; d0 < 8; ++d0) S.qr[d0] = load8<TIn>(cur.Q + (size_t)(wid * QBLK + r32) * RSQ + d0 * 16 + hi * 8);
    if constexpr (F32) { SLOAD_F((const float*)cur.K, kb0); VMW(); SWRITE_KF(0); SBAR(); SLOAD_F((const float*)cur.V, kb0); }
    else { SLOAD_H(cur.K, cur.V, kb0); VMW(); SWRITE_HK(0); }
    __syncthreads();
}
template <class TIn, class TOut, int RSQ, int RSK, int MK>
__device__ __forceinline__ void causal_swa_block(const BlockRef<TIn, TOut>& cur, const BlockRef<TIn, TOut>& nxt, int skv, int W, char* lds, Seam<TIn>& S) {
    constexpr bool F32 = same_t<TIn, float>::v;
    int tid_o = threadIdx.x; asm volatile("" : "+v"(tid_o)); const int tid = tid_o, wid = __builtin_amdgcn_readfirstlane(tid >> 6), lane = tid & 63, r32 = lane & 31, hi = lane >> 5;
    const int j_lo = swa_jlo(cur.P0, W);
    int j_hi = (cur.P0 + QB - 1) / KVBLK + 1; if (j_hi > skv / KVBLK) j_hi = skv / KVBLK;
    const int NT = j_hi - j_lo;
    const int kbn = swa_jlo(nxt.P0, W) * KVBLK;
    const int qlo = cur.P0 + wid * QBLK, qm = qlo + r32 - 4 * hi;
    const unsigned* mrow = (MK == 0) ? cur.M + (size_t)(wid * QBLK + r32) * 64 : nullptr; uint2 mw = make_uint2(0u, 0u); if constexpr (MK == 0) mw = *(const uint2*)(mrow + 2 * j_lo);
    char* V_lds = lds; char* K_lds = lds + 2 * SHM_V;
    float* ws = (float*)(lds + 2 * SHM_V + 2 * SHM_K) + wid * 64; float* li_l = ws, * al_l = ws + 32;
    float m_reg = -1e30f, l_reg = 0; f32x16 o[4] = {};
    const int sr = tid >> 4, sc = (tid & 15) * 8, vst0 = v_st(sr, sc), vst1 = v_st(32 + sr, sc), kws = KSWZ(sr, sc * 2);
    const int vb0 = (int)(uintptr_t)V_lds + v_rd_base(lane);
    const TIn* Kh = cur.K; const TIn* Vh = cur.V;
#define RESC(a) do { if (__any((a) < 1.f)) { if (hi == 0) al_l[r32] = (a); asm volatile("s_waitcnt lgkmcnt(0)" ::: "memory");              \
                     for (int d_ = 0; d_ < 4; ++d_) for (int r = 0; r < 16; ++r) o[d_][r] *= al_l[crow(r, hi)]; } } while (0)
#define KBASE(t) ((j_lo + (t)) * KVBLK)
#define ACT(t) (KBASE(t) <= qlo + QBLK - 1 && KBASE(t) + KVBLK - 1 >= qlo - W + 1)
#define MASKT(P0_, P1_, t) do { const int kb_ = KBASE(t); \
        if constexpr (MK == 1) { const int dmin_ = qlo - (kb_ + KVBLK - 1), dmax_ = qlo + QBLK - 1 - kb_; \
            if (dmin_ > 512) mask_far(P0_, P1_, qm - kb_); else if (dmin_ > 128 && dmax_ <= 512) mask_mid(P0_, P1_, qm - kb_); \
            else if (dmin_ >= 0 && dmax_ <= 128) mask_near(P0_, P1_, qm - kb_); else mask_mult(P0_, P1_, qm - kb_); } \
        else { mask_bits(P0_, P1_, mw.x >> (4 * hi), mw.y >> (4 * hi)); const int tn_ = ((t) + 1 < NT) ? (t) + 1 : (t); mw = *(const uint2*)(mrow + 2 * (j_lo + tn_)); } } while (0)
    constexpr int NQL = F32 ? 16 : 8;
    constexpr bool SK = WSKIP && !F32;
#define SEAM_K0() do { VMWN(NQL); if constexpr (F32) { SWRITE_KF(0); SBAR(); SLOAD_F((const float*)nxt.V, kbn); } else { SWRITE_HK(0); } SBAR(); } while (0)
    f32x16 pA0, pA1, pB0, pB1; float mnA, mnB, alA, alB; bf16x8 pa0, pa1, pa2, pa3;
    if constexpr (F32) { VMW(); SWRITE_VF(0); SBAR(); } else { SWRITE_HV(0); SBAR(); }
    if (NT > 1) { if constexpr (F32) SLOAD_F((const float*)Kh, KBASE(1)); else SLOAD_H(Kh, Vh, KBASE(1)); }
    SBAR(); qkt<0, SK>(pA0, pA1, K_lds, r32, hi, S.qr, ACT(0));
    if constexpr (F32) { if (NT > 1) { VMW(); SWRITE_KF(1); SBAR(); SLOAD_F((const float*)Vh, KBASE(1)); } }
    MASKT(pA0, pA1, 0); partialSM(pA0, pA1, m_reg, mnA, alA);
    if (NT > 1) { VMW(); if constexpr (F32) { SWRITE_VF(1); SBAR(); if (NT > 2) SLOAD_F((const float*)Kh, KBASE(2)); } else SWRITE_H(1); }
    __syncthreads();
#define HALF_STEP(PX0, PX1, mnX, alX, PY0, PY1, alY, t, KB, VB, SB) do {                                                      \
        SBAR(); qkt<KB, SK>(PX0, PX1, K_lds, r32, hi, S.qr, ACT(t));                                             \
        finishSM(PY0, PY1, alY, l_reg, pa0, pa1, pa2, pa3); SBAR();                                                           \
        if ((t) + 1 < NT) { if constexpr (F32) { VMW(); SWRITE_KF(SB); SBAR(); SLOAD_F((const float*)Vh, KBASE((t) + 1)); }  \
                            else { SLOAD_H(Kh, Vh, KBASE((t) + 1)); } SBAR(); }                                               \
        pv_tile<VB, SK>(o, vb0, pa0, pa1, pa2, pa3, ACT((t) - 1)); MASKT(PX0, PX1, (t)); partialSM(PX0, PX1, m_reg, mnX, alX);                                        \
        __syncthreads();                                                                                                      \
        if ((t) + 1 < NT) { VMW(); if constexpr (F32) { SWRITE_VF(SB); SBAR(); if ((t) + 2 < NT) SLOAD_F((const float*)Kh, KBASE((t) + 2)); } \
                            else { SWRITE_H(SB); } }                                                                          \
        RESC(alX); __syncthreads(); } while (0)
    for (int t = 1; t + 1 < NT; t += 2) {
        HALF_STEP(pB0, pB1, mnB, alB, pA0, pA1, alA, t, 1, 0, 0);
        HALF_STEP(pA0, pA1, mnA, alA, pB0, pB1, alB, t + 1, 0, 1, 1);
    }
    const bool even = (NT & 1) == 0;
    if (even) { SBAR(); qkt<1, SK>(pB0, pB1, K_lds, r32, hi, S.qr, ACT(NT - 1)); SBAR(); }
#define QROW(e) (nxt.Q + (size_t)(wid * QBLK + r32) * RSQ + ((e) >> 1) * 16 + hi * 8 + ((e) & 1) * 4)
    if constexpr (F32) { SLOAD_F((const float*)nxt.K, kbn); SBAR();
#pragma unroll
        for (int e = 0; e < 8; ++e) S.tq[e] = *(const f32x4*)QROW(e); }
    else { SLOAD_H(nxt.K, nxt.V, kbn); SBAR();
#pragma unroll
        for (int d0 = 0; d0 < 8; ++d0) S.qr[d0] = load8<TIn>(nxt.Q + (size_t)(wid * QBLK + r32) * RSQ + d0 * 16 + hi * 8); }
    SBAR();
    finishSM(pA0, pA1, alA, l_reg, pa0, pa1, pa2, pa3); SBAR();
    if constexpr (F32) {
#pragma unroll
        for (int e = 8; e < 16; ++e) S.tq[e] = *(const f32x4*)QROW(e); SBAR(); }
#undef QROW
    pv_tile<0, SK>(o, vb0, pa0, pa1, pa2, pa3, ACT(even ? NT - 2 : NT - 1));
    if (even) { MASKT(pB0, pB1, NT - 1); partialSM(pB0, pB1, m_reg, mnB, alB); __syncthreads(); RESC(alB);
        finishSM(pB0, pB1, alB, l_reg, pa0, pa1, pa2, pa3); SBAR(); pv_tile<1, SK>(o, vb0, pa0, pa1, pa2, pa3, ACT(NT - 1)); }
    SBAR(); SEAM_K0();
    if (hi == 0) li_l[r32] = l_reg; asm volatile("s_waitcnt lgkmcnt(0)" ::: "memory");
    float rli[16];
#pragma unroll
    for (int r = 0; r < 16; ++r) rli[r] = __builtin_amdgcn_rcpf(li_l[crow(r, hi)]);
    TOut* Ow = cur.O + (size_t)(wid * QBLK) * RSQ;
#pragma unroll
    for (int r = 0; r < 16; ++r) { const int orow = crow(r, hi);
#pragma unroll
        for (int d0 = 0; d0 < 4; ++d0) { const float v = o[d0][r] * rli[r];
            if constexpr (same_t<TOut, float>::v) { Ow[(size_t)orow * RSQ + d0 * 32 + r32] = v; }
            else { const float vn = __int_as_float(__builtin_amdgcn_update_dpp(__float_as_int(v), __float_as_int(v), 0xB1, 0xf, 0xf, false));
                   if ((r32 & 1) == 0) *(unsigned*)(Ow + (size_t)orow * RSQ + d0 * 32 + r32) = cvtpk(v, vn); } } }
    if constexpr (F32) {
#pragma unroll
        for (int d0 = 0; d0 < 8; ++d0) S.qr[d0] = pack8(S.tq[2 * d0], S.tq[2 * d0 + 1]); }
    __syncthreads();
#undef RESC
#undef KBASE
#undef ACT
#undef MASKT
#undef SEAM_K0
#undef HALF_STEP
}
#undef ROW
#undef VMW
#undef VMWN
#undef SLOAD_H
#undef SWRITE_HK
#undef SWRITE_HV
#undef SWRITE_H
#undef SLOAD_F
#undef SWRITE_KF
#undef SWRITE_VF
}

__device__ __forceinline__ unsigned fkey(float f) { const unsigned u = __float_as_uint(f + 0.0f); return (u & 0x80000000u) ? ~u : (u | 0x80000000u); }

__device__ __forceinline__ void naive_index_topk(Frame& F) {
    PHASE_IDS();
    const bf16* P = F.P; constexpr int ldp = n1pad(0);
    LAS float* iq = (LAS float*)F.lds; LAS float* iw = iq + 1024; LAS float* sc = iw + 16; LAS unsigned* mw = (LAS unsigned*)(sc + 2048); LAS unsigned* cnt = mw + 64;
    for (int row = blockIdx.x; row < MTOK; row += F.G) {
        const int t = row & (SEQ - 1), rb = row - t;
        for (int i = tid; i < 1024; i += 512) iq[i] = bf2f(P[(size_t)row * ldp + A_IQ + i]);
        if (tid < 16) iw[tid] = bf2f(P[(size_t)row * ldp + A_IW + tid]) * (1.f / 32.f);
        if (tid < 64) mw[tid] = 0u;
        __syncthreads();
        for (int s = tid; s <= t; s += 512) {
            const uint4* kp = (const uint4*)(P + (size_t)(rb + s) * ldp + A_IK);
            float kk[64];
#pragma unroll
            for (int c = 0; c < 8; ++c) { const uint4 r = kp[c]; const unsigned w[4] = {r.x, r.y, r.z, r.w};
#pragma unroll
                for (int j = 0; j < 4; ++j) { kk[c * 8 + 2 * j] = __uint_as_float(w[j] << 16); kk[c * 8 + 2 * j + 1] = __uint_as_float(w[j] & 0xffff0000u); } }
            float score = 0.f;
            for (int h = 0; h < 16; ++h) { float d = 0.f;
#pragma unroll
                for (int j = 0; j < 64; ++j) d = fmaf(iq[h * 64 + j], kk[j], d);
                score += fmaxf(d, 0.f) * iw[h]; }
            sc[s] = score;
        }
        __syncthreads();
        if (t + 1 <= 256) { for (int s = tid; s <= t; s += 512) atomicOr((unsigned*)&mw[s >> 5], 1u << (s & 31)); }
        else {
            unsigned myk[4];
#pragma unroll
            for (int j = 0; j < 4; ++j) { const int s = tid + 512 * j; myk[j] = (s <= t) ? fkey(sc[s]) : 0u; }
            unsigned prefix = 0u;
            for (int bit = 31; bit >= 0; --bit) {
                const unsigned cand = prefix | (1u << bit); unsigned c = 0;
#pragma unroll
                for (int j = 0; j < 4; ++j) c += (myk[j] >= cand) ? 1u : 0u;
                if (tid == 0) *cnt = 0u;
                __syncthreads(); if (c) atomicAdd((unsigned*)cnt, c); __syncthreads();
                const unsigned total = *cnt; __syncthreads();
                if (total >= 256u) prefix = cand;
            }
            unsigned cg = 0, ce = 0;
#pragma unroll
            for (int j = 0; j < 4; ++j) { cg += (myk[j] > prefix) ? 1u : 0u; ce += (myk[j] == prefix) ? 1u : 0u; }
            if (tid == 0) *cnt = 0u;
            __syncthreads(); atomicAdd((unsigned*)cnt, cg | (ce << 16)); __syncthreads();
            const unsigned tot = *cnt; const int n_gt = (int)(tot & 0xffffu), n_eq = (int)(tot >> 16); const int need = 256 - n_gt;
#pragma unroll
            for (int j = 0; j < 4; ++j) { const int s = tid + 512 * j; if (myk[j] > prefix || (myk[j] == prefix && n_eq == need)) atomicOr((unsigned*)&mw[s >> 5], 1u << (s & 31)); }
            if (n_eq != need && tid == 0) { int left = need; for (int s = 0; s <= t && left > 0; ++s) if (fkey(sc[s]) == prefix) { atomicOr((unsigned*)&mw[s >> 5], 1u << (s & 31)); --left; } }
        }
        __syncthreads();
        if (tid < 64) F.mask[(size_t)row * 64 + tid] = mw[tid];
        __syncthreads();
    }
}

template <int MODE> __device__ __forceinline__ void naive_attn(Frame& F, int ldp, int koff, int voff, int kvhs) {
    PHASE_IDS();
    bf16* P = F.P; const int wv = wave;
    LAS int* keys = (LAS int*)F.lds; LAS float* qs = (LAS float*)(keys + 400); LAS float* sc = qs + 2048; LAS float* linv = sc + 16 * 400; LAS int* pre = (LAS int*)(linv + 16); LAS int* nk_s = pre + 64;
    for (int row = blockIdx.x; row < MTOK; row += F.G) {
        const int t = row & (SEQ - 1), rb = row - t;
        for (int i = tid; i < 2048; i += 512) qs[i] = bf2f(P[(size_t)row * ldp + i]);
        if (MODE == 0) {
            unsigned w = 0; if (tid < 64) { w = F.mask[(size_t)row * 64 + tid]; pre[tid] = __popc(w); }
            __syncthreads();
            if (tid == 0) { int run = 0; for (int i = 0; i < 64; ++i) { const int x = pre[i]; pre[i] = run; run += x; } *nk_s = run; }
            __syncthreads();
            if (tid < 64) { int pos = pre[tid]; while (w) { const int b = __ffs(w) - 1; keys[pos++] = tid * 32 + b; w &= w - 1; } }
        } else {
            if (tid < 387) { const int cfg = tid / 129, j = tid % 129, dil = cfg == 0 ? 1 : (cfg == 1 ? 4 : 16); const int s = t - j * dil; keys[tid] = s >= 0 ? s : -1; }
            if (tid == 0) *nk_s = 387;
        }
        __syncthreads();
        const int nk = *nk_s;
        if (tid < nk) {
            const int e = tid, s = keys[e];
#pragma unroll 1
            for (int h = 0; h < 16; ++h) {
                float d = -__builtin_inff();
                if (s >= 0) { const uint4* kp = (const uint4*)(P + (size_t)(rb + s) * ldp + koff + h * kvhs); d = 0.f;
#pragma unroll
                    for (int c = 0; c < 16; ++c) { const uint4 r = kp[c]; const unsigned w[4] = {r.x, r.y, r.z, r.w}; const LAS float* qp = qs + h * 128 + c * 8;
#pragma unroll
                        for (int j = 0; j < 4; ++j) { d = fmaf(qp[2 * j], __uint_as_float(w[j] << 16), d); d = fmaf(qp[2 * j + 1], __uint_as_float(w[j] & 0xffff0000u), d); } }
                    d *= QK_SCALE; }
                sc[h * 400 + e] = d;
            }
        }
        __syncthreads();
        for (int hh = 0; hh < 2; ++hh) { const int h = wv * 2 + hh; float m = -__builtin_inff();
            for (int e = lane; e < nk; e += 64) m = fmaxf(m, sc[h * 400 + e]);
            m = wave_max(m); float sum = 0.f;
            for (int e = lane; e < nk; e += 64) { const float p = __expf(sc[h * 400 + e] - m); sc[h * 400 + e] = p; sum += p; }
            sum = wave_sum(sum); if (lane == 0) linv[h] = 1.f / sum; }
        __syncthreads();
        const int d = tid & 127, hg = tid >> 7; float acc[4] = {0.f, 0.f, 0.f, 0.f};
        for (int e = 0; e < nk; ++e) { const int s = keys[e]; if (s < 0) continue; const bf16* vp = P + (size_t)(rb + s) * ldp + voff + d;
#pragma unroll
            for (int j = 0; j < 4; ++j) { const int h = hg * 4 + j; acc[j] = fmaf(sc[h * 400 + e], bf2f(vp[h * kvhs]), acc[j]); } }
#pragma unroll
        for (int j = 0; j < 4; ++j) { const int h = hg * 4 + j; P[(size_t)row * ldp + h * 128 + d] = f2bf(acc[j] * linv[h]); }
        __syncthreads();
    }
}

__device__ __forceinline__ void naive_ret(Frame& F) {
    if (blockIdx.x >= 32) return;
    bf16* P = F.P; constexpr int ldp = n1pad(2);
    int tid_o_ = threadIdx.x; asm volatile("" : "+v"(tid_o_));
    const int grp = tid_o_ >> 8, tid = tid_o_ & 255, lane = tid & 63, wv = tid >> 6, item = blockIdx.x * 2 + grp, bl = item >> 3, h = item & 7;
    const float gamma = 1.f - exp2f(-5.f - (float)h);
    LAS float* base = (LAS float*)(F.lds + grp * 40960);
    LAS float* qs = base; LAS float* ks = qs + 16 * 128; LAS float* ob = ks + 16 * 128; LAS float* sq = ob + 16 * 256;
    float S[128];
#pragma unroll
    for (int i = 0; i < 128; ++i) S[i] = 0.f;
    for (int t0 = 0; t0 < SEQ; t0 += 16) {
        const size_t row0 = (size_t)bl * SEQ + t0;
        for (int i = tid; i < 16 * 128; i += 256) { const int tt = i >> 7, c = i & 127; const bf16* pr = P + (row0 + tt) * ldp + h * 128 + c; qs[i] = bf2f(pr[0]); ks[i] = bf2f(pr[1024]); }
        __syncthreads();
#pragma unroll 1
        for (int tt = 0; tt < 16; ++tt) {
            const float v = bf2f(P[(row0 + tt) * ldp + 2048 + h * 256 + tid]); float o = 0.f;
#pragma unroll
            for (int i = 0; i < 128; i += 4) { const pg8::f32x4 k4 = *(const LAS pg8::f32x4*)&ks[tt * 128 + i], q4 = *(const LAS pg8::f32x4*)&qs[tt * 128 + i];
                S[i] = fmaf(gamma, S[i], k4.x * v); o = fmaf(q4.x, S[i], o); S[i + 1] = fmaf(gamma, S[i + 1], k4.y * v); o = fmaf(q4.y, S[i + 1], o);
                S[i + 2] = fmaf(gamma, S[i + 2], k4.z * v); o = fmaf(q4.z, S[i + 2], o); S[i + 3] = fmaf(gamma, S[i + 3], k4.w * v); o = fmaf(q4.w, S[i + 3], o); }
            ob[tt * 256 + tid] = o;
        }
        __syncthreads();
        for (int j = 0; j < 4; ++j) { const int tt = wv * 4 + j; float s = 0.f; for (int c = lane; c < 256; c += 64) s += ob[tt * 256 + c] * ob[tt * 256 + c]; s = wave_sum(s);
            if (lane < 8) F.ssq[((row0 + tt) * 8 + h) * 8 + lane] = lane == 0 ? s : 0.f; }
        for (int tt = 0; tt < 16; ++tt) P[(row0 + tt) * ldp + 2048 + h * 256 + tid] = f2bf(ob[tt * 256 + tid]);
        __syncthreads();
    }
}

__device__ __forceinline__ void naive_hgrn(Frame& F) {
    if (blockIdx.x >= 32) return;
    bf16* P = F.P; constexpr int ldp = n1pad(3);
    int tid_o_ = threadIdx.x; asm volatile("" : "+v"(tid_o_));
    const int grp = tid_o_ >> 7, tid = tid_o_ & 127, lane = tid & 63, wv = tid >> 6, item = blockIdx.x * 4 + grp, bl = item >> 4, h = item & 15;
    LAS float* base = (LAS float*)(F.lds + grp * 28672);
    LAS float* qs = base; LAS float* gs = qs + 16 * 128; LAS float* ob = gs + 16 * 128;
    float S[128];
#pragma unroll
    for (int i = 0; i < 128; ++i) S[i] = 0.f;
    for (int t0 = 0; t0 < SEQ; t0 += 16) {
        const size_t row0 = (size_t)bl * SEQ + t0;
        for (int tt = 0; tt < 16; ++tt) { const bf16* pr = P + (row0 + tt) * ldp + h * 128 + tid;
            qs[tt * 128 + tid] = bf2f(pr[0]); gs[tt * 128 + tid] = __expf(bf2f(pr[2048])); }
        __syncthreads();
#pragma unroll 1
        for (int tt = 0; tt < 16; ++tt) {
            const float v = bf2f(P[(row0 + tt) * ldp + 4096 + h * 128 + tid]); float o = 0.f;
#pragma unroll
            for (int i = 0; i < 128; i += 4) { const pg8::f32x4 g4 = *(const LAS pg8::f32x4*)&gs[tt * 128 + i], q4 = *(const LAS pg8::f32x4*)&qs[tt * 128 + i];
                S[i] = fmaf(g4.x, S[i] - v, v); o = fmaf(q4.x, S[i], o); S[i + 1] = fmaf(g4.y, S[i + 1] - v, v); o = fmaf(q4.y, S[i + 1], o);
                S[i + 2] = fmaf(g4.z, S[i + 2] - v, v); o = fmaf(q4.z, S[i + 2], o); S[i + 3] = fmaf(g4.w, S[i + 3] - v, v); o = fmaf(q4.w, S[i + 3], o); }
            ob[tt * 128 + tid] = o;
        }
        __syncthreads();
        for (int j = 0; j < 8; ++j) { const int tt = wv * 8 + j; float s = ob[tt * 128 + lane] * ob[tt * 128 + lane] + ob[tt * 128 + lane + 64] * ob[tt * 128 + lane + 64]; s = wave_sum(s);
            if (lane < 4) F.ssq[((row0 + tt) * 16 + h) * 4 + lane] = lane == 0 ? s : 0.f; }
        for (int tt = 0; tt < 16; ++tt) P[(row0 + tt) * ldp + 4096 + h * 128 + tid] = f2bf(ob[tt * 128 + tid]);
        __syncthreads();
    }
}

typedef short ix_bf16x8 __attribute__((ext_vector_type(8)));
typedef float ix_f32x16 __attribute__((ext_vector_type(16)));
__device__ __forceinline__ int half_sum(int v, int hi) {
    v = half_sum_i(v);
    const int lo = __builtin_amdgcn_readlane(v, 31), up = __builtin_amdgcn_readlane(v, 63);
    return hi ? up : lo;
}
__device__ __forceinline__ void index_topk_phase(Frame& F) {
    PHASE_IDS();
    const bf16* P = F.P; constexpr int ldp = n1pad(0), ROWB = 144, BUFB = 256 * ROWB;
    const int c = lane & 31, hi = lane >> 5;
#pragma unroll 1
    for (int uu = 0; uu < 4; ++uu) {
        const int unit = (uu & 1) ? (1023 - (uu >> 1) * 256 - (int)blockIdx.x) : ((uu >> 1) * 256 + (int)blockIdx.x);
        const int row0 = unit * 16, rb = row0 & ~(SEQ - 1), tu = row0 & (SEQ - 1);
        const int t0 = tu + 2 * wave, tq = t0 + hi;
        const int nchunk = (tu + 15) / 256 + 1, jmax = (t0 + 1) >> 5;
        ix_bf16x8 afr[4];
        { const bf16* ap = P + (size_t)(row0 + 2 * wave + (c >> 4)) * ldp + A_IQ + (c & 15) * 64 + 8 * hi;
#pragma unroll
          for (int s = 0; s < 4; ++s) afr[s] = *(const ix_bf16x8*)(ap + 16 * s); }
        float w0[8], w1[8];
        { const bf16* wp = P + (size_t)(row0 + 2 * wave) * ldp + A_IW;
#pragma unroll
          for (int j = 0; j < 8; ++j) { const int hd = (j & 3) + 8 * (j >> 2) + 4 * hi; w0[j] = bf2f(wp[hd]) * (1.f / 32.f); w1[j] = bf2f(wp[ldp + hd]) * (1.f / 32.f); } }
        unsigned uk[64];
#pragma unroll
        for (int j = 0; j < 64; ++j) uk[j] = 0u;
        pg8::u32x4 st[4];
        { const bf16* gp = P + (size_t)rb * ldp + A_IK;
#pragma unroll
          for (int i = 0; i < 4; ++i) { const int p = tid + 512 * i; st[i] = *(const pg8::u32x4*)(gp + (size_t)(p >> 3) * ldp + (p & 7) * 8); }
#pragma unroll
          for (int i = 0; i < 4; ++i) { const int p = tid + 512 * i; *(LAS pg8::u32x4*)(F.lds + (p >> 3) * ROWB + (p & 7) * 16) = st[i]; } }
        __syncthreads();
#pragma unroll
        for (int ch = 0; ch < 8; ++ch) {
            if (ch < nchunk) {
                const bool more = ch + 1 < nchunk;
                if (more) { const bf16* gp = P + (size_t)(rb + 256 * (ch + 1)) * ldp + A_IK;
#pragma unroll
                    for (int i = 0; i < 4; ++i) { const int p = tid + 512 * i; st[i] = *(const pg8::u32x4*)(gp + (size_t)(p >> 3) * ldp + (p & 7) * 8); } }
                const LAS unsigned char* buf = F.lds + (ch & 1) * BUFB + c * ROWB + 16 * hi;
#pragma unroll
                for (int jj = 0; jj < 8; ++jj) {
                    const int j = 8 * ch + jj;
                    if (j <= jmax) {
                        ix_f32x16 acc = {};
#pragma unroll
                        for (int s = 0; s < 4; ++s) { const ix_bf16x8 bfr = *(const LAS ix_bf16x8*)(buf + jj * 32 * ROWB + 32 * s); acc = __builtin_amdgcn_mfma_f32_32x32x16_bf16(afr[s], bfr, acc, 0, 0, 0); }
                        float s0 = 0.f, s1 = 0.f;
#pragma unroll
                        for (int x = 0; x < 8; ++x) { s0 = fmaf(fmaxf(acc[x], 0.f), w0[x], s0); s1 = fmaf(fmaxf(acc[8 + x], 0.f), w1[x], s1); }
                        const auto rr = __builtin_amdgcn_permlane32_swap(__float_as_uint(s0), __float_as_uint(s1), false, false);
                        const float tot = __uint_as_float(rr[0]) + __uint_as_float(rr[1]);
                        uk[j] = (32 * j + c <= tq) ? fkey(tot) : 0u;
                    }
                }
                if (more) {
#pragma unroll
                    for (int i = 0; i < 4; ++i) { const int p = tid + 512 * i; *(LAS pg8::u32x4*)(F.lds + ((ch + 1) & 1) * BUFB + (p >> 3) * ROWB + (p & 7) * 16) = st[i]; } }
                __syncthreads();
            }
        }
        unsigned thr = 0u;
        if (t0 >= 256) {
#pragma unroll 1
            for (int bit = 31; bit >= 0; --bit) {
                const unsigned cand = thr | (1u << bit); int cnt = 0;
#pragma unroll
                for (int g = 0; g < 8; ++g) if (8 * g <= jmax) {
#pragma unroll
                    for (int x = 0; x < 8; ++x) cnt += (uk[8 * g + x] >= cand) ? 1 : 0; }
                if (half_sum(cnt, hi) >= 256) thr = cand;
            }
        }
        int ngt = 0, neq = 0;
#pragma unroll
        for (int j = 0; j < 64; ++j) { ngt += (uk[j] > thr) ? 1 : 0; neq += (uk[j] == thr) ? 1 : 0; }
        ngt = half_sum(ngt, hi); neq = half_sum(neq, hi);
        const int need = 256 - ngt; const bool ties = (thr != 0u) && (neq != need);
        unsigned long long okm = ~0ull;
        if (__any(ties)) { okm = 0ull; int run = 0;
#pragma unroll
            for (int j = 0; j < 64; ++j) { const unsigned long long m = __ballot(uk[j] == thr); const unsigned mh = hi ? (unsigned)(m >> 32) : (unsigned)m;
                const int below = __popc(mh & ((1u << c) - 1u)); if (!ties || run + below < need) okm |= 1ull << j; run += __popc(mh); } }
        unsigned mw0 = 0u, mw1 = 0u;
#pragma unroll
        for (int j = 0; j < 64; ++j) { const bool sel = (uk[j] > thr) || (thr != 0u && uk[j] == thr && ((okm >> j) & 1ull));
            const unsigned long long m = __ballot(sel);
            mw0 = (lane == j) ? (unsigned)m : mw0; mw1 = (lane == j) ? (unsigned)(m >> 32) : mw1; }
        unsigned* mp = F.mask + (size_t)(row0 + 2 * wave) * 64 + lane;
        mp[0] = mw0; mp[64] = mw1;
    }
}

struct AttItem { int bh, qb0, qb1; };
__device__ __forceinline__ AttItem att_decode(int Lc, int Gq  ) {
    AttItem it; const int xcd = Lc & 7, k = Lc >> 3, per = Gq * 4, gi = k / per, r = k - gi * per;
    it.bh = (gi * 8 + xcd) * Gq + r / 4; const int x = r & 3; it.qb0 = x; it.qb1 = 7 - x; return it;
}
template <int L> __device__ __forceinline__ att::BlockRef<bf16, bf16> att_ref(const AttItem& it, int pass, bf16* P, const unsigned* mask) {
    constexpr int LDP = n1pad(L), KOFF = (L == 0) ? A_K : 2048, VOFF = (L == 0) ? A_V : 4096, KVHS = (L == 0) ? 0 : 128;
    const int qb = pass ? it.qb1 : it.qb0, b = it.bh >> 4, h = it.bh & 15;
    att::BlockRef<bf16, bf16> r;
    r.Q = P + (size_t)(b * SEQ + qb * 256) * LDP + h * 128; r.O = P + (size_t)(b * SEQ + qb * 256) * LDP + h * 128;
    r.K = P + (size_t)(b * SEQ) * LDP + KOFF + h * KVHS; r.V = P + (size_t)(b * SEQ) * LDP + VOFF + h * KVHS;
    r.M = mask + (size_t)(b * SEQ + qb * 256) * 64; r.P0 = qb * 256;
    return r;
}
template <int L> __device__ __forceinline__ void attn_phase(bf16* P, const unsigned* mask, char* lds, int G) {
    constexpr int LDP = n1pad(L), MK = (L == 0) ? 0 : 1, GQ = (L == 0) ? 16 : 1, TOTAL = 512, W = 1 << 28;
    int Lc = blockIdx.x; if (Lc >= TOTAL) return;
    AttItem it = att_decode(Lc, GQ); int pass = 0;
    att::BlockRef<bf16, bf16> cur = att_ref<L>(it, 0, P, mask);
    att::Seam<bf16> S;
    att::causal_swa_prime<bf16, bf16, LDP, LDP, MK>(cur, W, lds, S);
    for (;;) {
        const bool more_pass = pass == 0, more_item = Lc + G < TOTAL, last = !more_pass && !more_item;
        AttItem itn = it; int passn = pass + 1, Ln = Lc;
        if (!more_pass) { passn = 0; Ln = more_item ? Lc + G : Lc; itn = att_decode(Ln, GQ); }
        const att::BlockRef<bf16, bf16> nxt = last ? cur : att_ref<L>(itn, passn, P, mask);
        att::causal_swa_block<bf16, bf16, LDP, LDP, MK>(cur, nxt, SEQ, W, lds, S);
        if (last) break;
        cur = nxt; it = itn; pass = passn; Lc = Ln;
    }
}

namespace ret {
typedef short bf16x8 __attribute__((ext_vector_type(8)));
typedef short s16x4 __attribute__((ext_vector_type(4)));
typedef float f32x16 __attribute__((ext_vector_type(16)));
__device__ __forceinline__ unsigned off_b(unsigned row, unsigned ch) { return 256u * row + 16u * (ch ^ (((row & 3) << 2) | ((row >> 2) & 3))); }
__device__ __forceinline__ unsigned img_off(unsigned row, unsigned ch) { return 8192u * (row >> 5) + off_b(row & 31, ch); }
__device__ __forceinline__ unsigned addr_row(unsigned lane, unsigned rblk, unsigned s) { return 8192u * rblk + off_b(lane & 31, 2 * s + (lane >> 5)); }
__device__ __forceinline__ unsigned addr_tr(unsigned lane, unsigned row4, unsigned c) {
    const unsigned blk = (lane >> 4) & 1, q = (lane & 15) >> 2, p = lane & 3;
    return img_off(row4 + q, 4 * c + 2 * blk + (p >> 1)) + 8 * (p & 1);
}
__device__ __forceinline__ s16x4 tr_read(unsigned a) { s16x4 r; asm volatile("ds_read_b64_tr_b16 %0, %1" : "=&v"(r) : "v"(a) : "memory"); return r; }
__device__ __forceinline__ bf16x8 cat8(s16x4 lo, s16x4 hi) { return (bf16x8){lo[0], lo[1], lo[2], lo[3], hi[0], hi[1], hi[2], hi[3]}; }
__device__ __forceinline__ unsigned cvtpk(float lo, float hi) { unsigned r; asm volatile("v_cvt_pk_bf16_f32 %0, %1, %2" : "=v"(r) : "v"(lo), "v"(hi)); return r; }
__device__ __forceinline__ bf16x8 pack_acc8(const f32x16& a, int s) {
    pg8::u32x4 w = {cvtpk(a[8 * s + 0], a[8 * s + 1]), cvtpk(a[8 * s + 2], a[8 * s + 3]), cvtpk(a[8 * s + 4], a[8 * s + 5]), cvtpk(a[8 * s + 6], a[8 * s + 7])};
    return *reinterpret_cast<bf16x8*>(&w);
}
#define RET_LGKM0() do { asm volatile("s_waitcnt lgkmcnt(0)" ::: "memory"); __builtin_amdgcn_sched_barrier(0); } while (0)
constexpr int OFF_Q = 0, OFF_K = 32768, OFF_V = 65536, OFF_S = 98304;
}

__device__ __forceinline__ void ret_phase(Frame& F) {
    using namespace ret;
    PHASE_IDS();
    bf16* P = F.P; constexpr int ldp = n1pad(2);
    const int xcd = blockIdx.x & 7, kk = blockIdx.x >> 3, bh = xcd * 8 + (kk >> 2), dvq = kk & 3, b = bh >> 3, h = bh & 7;
    const int ib = (wave < 4) ? wave : 7 - wave, dh = wave >> 2;
    const int dkb = wave & 3, dvb = wave >> 2;
    const int c = lane & 31, hi = lane >> 5;
    const float lg = ret_lg(h);
    const float g128 = __builtin_amdgcn_exp2f(128.f * lg), g127 = __builtin_amdgcn_exp2f(127.f * lg), g1 = __builtin_amdgcn_exp2f(lg);
    const unsigned lbase = (unsigned)(size_t)F.lds_gen;
    const size_t rowg0 = (size_t)b * SEQ;
    const bf16* qg = P + rowg0 * ldp + h * 128; const bf16* vg = P + rowg0 * ldp + 2048 + h * 256 + dvq * 64;
    for (int i = tid; i < 32768 / 16; i += 512) *(LAS pg8::u32x4*)(F.lds + OFF_S + i * 16) = (pg8::u32x4){0u, 0u, 0u, 0u};
    f32x16 st = {};
    pg8::u32x4 rq[4], rk[4], rv[2];
#define RET_LOAD(n) do { const size_t r0_ = (size_t)(n) * 128; \
        _Pragma("unroll") for (int i = 0; i < 4; ++i) { const int p = tid + 512 * i; const bf16* g_ = qg + (r0_ + (p >> 4)) * ldp + (p & 15) * 8; rq[i] = *(const pg8::u32x4*)g_; rk[i] = *(const pg8::u32x4*)(g_ + 1024); } \
        _Pragma("unroll") for (int i = 0; i < 2; ++i) { const int p = tid + 512 * i; rv[i] = *(const pg8::u32x4*)(vg + (r0_ + (p >> 3)) * ldp + (p & 7) * 8); } } while (0)
#define RET_WRITE() do { \
        _Pragma("unroll") for (int i = 0; i < 4; ++i) { const int p = tid + 512 * i; const unsigned o_ = img_off(p >> 4, p & 15); *(LAS pg8::u32x4*)(F.lds + OFF_Q + o_) = rq[i]; *(LAS pg8::u32x4*)(F.lds + OFF_K + o_) = rk[i]; } \
        _Pragma("unroll") for (int i = 0; i < 2; ++i) { const int p = tid + 512 * i; *(LAS pg8::u32x4*)(F.lds + OFF_V + img_off(p >> 3, p & 7)) = rv[i]; } } while (0)
    RET_LOAD(0); RET_WRITE();
    __syncthreads();
#pragma unroll 1
    for (int n = 0; n < 16; ++n) {
        if (n + 1 < 16) RET_LOAD(n + 1);
        f32x16 o = {};
#pragma unroll
        for (int sp = 0; sp < 2; ++sp) {
            s16x4 br[8]; bf16x8 a[4];
#pragma unroll
            for (int u = 0; u < 4; ++u) { const int s = 4 * sp + u; a[u] = *(const LAS bf16x8*)(F.lds + OFF_Q + addr_row(lane, ib, s));
                br[2 * u] = tr_read(lbase + OFF_S + addr_tr(lane, 16 * s + 8 * hi, dh)); br[2 * u + 1] = tr_read(lbase + OFF_S + addr_tr(lane, 16 * s + 8 * hi + 4, dh)); }
            RET_LGKM0();
#pragma unroll
            for (int u = 0; u < 4; ++u) o = __builtin_amdgcn_mfma_f32_32x32x16_bf16(a[u], cat8(br[2 * u], br[2 * u + 1]), o, 0, 0, 0);
        }
#pragma unroll
        for (int jb = 0; jb < 4; ++jb) {
            if (jb <= ib) {
                s16x4 vr[4];
#pragma unroll
                for (int s = 0; s < 2; ++s) { vr[2 * s] = tr_read(lbase + OFF_V + addr_tr(lane, 32 * jb + 16 * s + 4 * hi, dh)); vr[2 * s + 1] = tr_read(lbase + OFF_V + addr_tr(lane, 32 * jb + 16 * s + 8 + 4 * hi, dh)); }
                f32x16 sacc = {};
#pragma unroll
                for (int s = 0; s < 8; ++s) {
                    const bf16x8 a = *(const LAS bf16x8*)(F.lds + OFF_K + addr_row(lane, jb, s)), bq = *(const LAS bf16x8*)(F.lds + OFF_Q + addr_row(lane, ib, s));
                    sacc = __builtin_amdgcn_mfma_f32_32x32x16_bf16(a, bq, sacc, 0, 0, 0);
                }
                if (jb == ib) {
#pragma unroll
                    for (int r = 0; r < 16; ++r) { const int jl = (r & 3) + 8 * (r >> 2) + 4 * hi; if (jl > c) sacc[r] = 0.f; }
                }
                RET_LGKM0();
#pragma unroll
                for (int s = 0; s < 2; ++s) o = __builtin_amdgcn_mfma_f32_32x32x16_bf16(pack_acc8(sacc, s), cat8(vr[2 * s], vr[2 * s + 1]), o, 0, 0, 0);
            }
        }
        f32x16 xs = {};
#pragma unroll
        for (int sp = 0; sp < 4; ++sp) {
            s16x4 ar[4], br[4];
#pragma unroll
            for (int u = 0; u < 2; ++u) { const int s = 2 * sp + u;
                ar[2 * u] = tr_read(lbase + OFF_K + addr_tr(lane, 16 * s + 8 * hi, dkb)); ar[2 * u + 1] = tr_read(lbase + OFF_K + addr_tr(lane, 16 * s + 8 * hi + 4, dkb));
                br[2 * u] = tr_read(lbase + OFF_V + addr_tr(lane, 16 * s + 8 * hi, dvb)); br[2 * u + 1] = tr_read(lbase + OFF_V + addr_tr(lane, 16 * s + 8 * hi + 4, dvb)); }
            RET_LGKM0();
#pragma unroll
            for (int u = 0; u < 2; ++u) xs = __builtin_amdgcn_mfma_f32_32x32x16_bf16(cat8(ar[2 * u], ar[2 * u + 1]), cat8(br[2 * u], br[2 * u + 1]), xs, 0, 0, 0);
        }
#pragma unroll
        for (int r = 0; r < 16; ++r) st[r] = g128 * st[r] + g127 * xs[r];
        {
            const size_t rowb = rowg0 + (size_t)n * 128 + ib * 32;
#pragma unroll
            for (int r = 0; r < 16; ++r) {
                const int il = (r & 3) + 8 * (r >> 2) + 4 * hi; const float v = o[r];
                const float q = half_sum_f(v * v);
                if (c == 31) F.ssq[((rowb + il) * 8 + h) * 8 + dvq * 2 + dh] = q;
                const float vn = lane_xor1(v);
                if ((c & 1) == 0) *(unsigned*)(P + (rowb + il) * ldp + 2048 + h * 256 + dvq * 64 + dh * 32 + c) = cvtpk(v, vn);
            }
        }
        LDS_BARRIER();
#pragma unroll
        for (int r = 0; r < 16; r += 2) { const int dk = 32 * dkb + (r & 3) + 8 * (r >> 2) + 4 * hi, dv = 32 * dvb + c; const unsigned w = cvtpk(g1 * st[r], g1 * st[r + 1]);
            *(LAS bf16*)(F.lds + OFF_S + img_off(dk, dv >> 3) + (dv & 7) * 2) = (bf16)(w & 0xffffu); *(LAS bf16*)(F.lds + OFF_S + img_off(dk + 1, dv >> 3) + (dv & 7) * 2) = (bf16)(w >> 16); }
        if (n + 1 < 16) RET_WRITE();
        LDS_BARRIER();
    }
#undef RET_LOAD
#undef RET_WRITE
}

namespace hg {
constexpr int PITCH = 132;
constexpr int OFF_Q = 0, OFF_K = 16384, OFF_V = 32768, OFF_T0 = 49152, OFF_T1 = 81920, OFF_C = 114688;
}
__device__ __forceinline__ void hgrn_prep_phase(Frame& F) {
    PHASE_IDS();
    bf16* P = F.P; constexpr int ldp = n1pad(3);
    float* tab = (float*)F.mask;
    LAS float* Lt = (LAS float*)F.lds; LAS float* segt = Lt + 64 * hg::PITCH;
    const int tok = tid >> 3, c16 = tid & 7, ch = tid & 127, seg = tid >> 7;
#pragma unroll 1
    for (int i = 0; i < 16; ++i) {
        const int it = blockIdx.x + 256 * i, bh = it >> 5, n = it & 31;
        bf16* gp = P + ((size_t)(bh >> 4) * SEQ + n * 64 + tok) * ldp + (bh & 15) * 128 + c16 * 16;
        const pg8::u32x4 q0 = *(const pg8::u32x4*)gp, q1 = *(const pg8::u32x4*)(gp + 8), f0 = *(const pg8::u32x4*)(gp + 2048), f1 = *(const pg8::u32x4*)(gp + 2056);
        float lf[16];
        { const unsigned w[8] = {f0.x, f0.y, f0.z, f0.w, f1.x, f1.y, f1.z, f1.w};
#pragma unroll
          for (int j = 0; j < 8; ++j) { lf[2 * j] = __uint_as_float(w[j] << 16); lf[2 * j + 1] = __uint_as_float(w[j] & 0xffff0000u); } }
#pragma unroll
        for (int j = 0; j < 4; ++j) *(LAS pg8::f32x4*)(Lt + tok * hg::PITCH + c16 * 16 + 4 * j) = (pg8::f32x4){lf[4 * j], lf[4 * j + 1], lf[4 * j + 2], lf[4 * j + 3]};
        __syncthreads();
        float bl[16]; float run = 0.f;
#pragma unroll
        for (int t = 0; t < 16; ++t) { run += Lt[(seg * 16 + t) * hg::PITCH + ch]; bl[t] = run; }
        segt[seg * 128 + ch] = run;
        __syncthreads();
        { const float s0 = segt[ch], s1 = segt[128 + ch], s2 = segt[256 + ch], s3 = segt[384 + ch];
          const float pre = (seg == 0) ? 0.f : (seg == 1 ? s0 : (seg == 2 ? s0 + s1 : s0 + s1 + s2)), bref = s0 + s1;
          if (seg == 0) { tab[(size_t)it * 256 + ch] = bref; tab[(size_t)it * 256 + 128 + ch] = s2 + s3; }
#pragma unroll
          for (int t = 0; t < 16; ++t) Lt[(seg * 16 + t) * hg::PITCH + ch] = __expf(pre + bl[t] - bref); }
        __syncthreads();
        float e[16];
#pragma unroll
        for (int j = 0; j < 4; ++j) { const pg8::f32x4 v = *(const LAS pg8::f32x4*)(Lt + tok * hg::PITCH + c16 * 16 + 4 * j); e[4 * j] = v[0]; e[4 * j + 1] = v[1]; e[4 * j + 2] = v[2]; e[4 * j + 3] = v[3]; }
        float qv[16];
        { const unsigned w[8] = {q0.x, q0.y, q0.z, q0.w, q1.x, q1.y, q1.z, q1.w};
#pragma unroll
          for (int j = 0; j < 8; ++j) { qv[2 * j] = __uint_as_float(w[j] << 16); qv[2 * j + 1] = __uint_as_float(w[j] & 0xffff0000u); } }
        unsigned qo[8], ko[8];
#pragma unroll
        for (int j = 0; j < 8; ++j) {
            const float ea = e[2 * j], eb = e[2 * j + 1];
            qo[j] = pg8::cvt_pk_bf16(qv[2 * j] * ea, qv[2 * j + 1] * eb);
            ko[j] = pg8::cvt_pk_bf16((1.f - __expf(lf[2 * j])) * __builtin_amdgcn_rcpf(ea), (1.f - __expf(lf[2 * j + 1])) * __builtin_amdgcn_rcpf(eb));
        }
        *(pg8::u32x4*)gp = (pg8::u32x4){qo[0], qo[1], qo[2], qo[3]}; *(pg8::u32x4*)(gp + 8) = (pg8::u32x4){qo[4], qo[5], qo[6], qo[7]};
        *(pg8::u32x4*)(gp + 2048) = (pg8::u32x4){ko[0], ko[1], ko[2], ko[3]}; *(pg8::u32x4*)(gp + 2056) = (pg8::u32x4){ko[4], ko[5], ko[6], ko[7]};
        __syncthreads();
    }
}
__device__ __forceinline__ void hgrn_seq_phase(Frame& F) {
    using namespace ret;
    PHASE_IDS();
    bf16* P = F.P; constexpr int ldp = n1pad(3);
    const float* tab = (const float*)F.mask;
    const int xcd = blockIdx.x & 7, kk = blockIdx.x >> 3, bh = xcd * 16 + (kk >> 1), dvh = kk & 1, b = bh >> 4, h = bh & 15;
    const int c = lane & 31, hi = lane >> 5;
    const unsigned lbase = (unsigned)(size_t)F.lds_gen;
    const size_t rowg0 = (size_t)b * SEQ;
    const bf16* qg = P + rowg0 * ldp + h * 128; const bf16* vg = P + rowg0 * ldp + 4096 + h * 128 + dvh * 64;
    const float* tg = tab + (size_t)bh * 32 * 256;
    LAS float* ctab = (LAS float*)(F.lds + hg::OFF_C);
    for (int i = tid; i < 65536 / 16; i += 512) *(LAS pg8::u32x4*)(F.lds + hg::OFF_T0 + i * 16) = (pg8::u32x4){0u, 0u, 0u, 0u};
    f32x16 t0 = {}, t1 = {};
    pg8::u32x4 rq[2], rk[2], rv; pg8::f32x4 ru, rb;
#define HG_LOAD(n) do { const size_t r0_ = (size_t)(n) * 64; \
        _Pragma("unroll") for (int i = 0; i < 2; ++i) { const int p = tid + 512 * i; const bf16* g_ = qg + (r0_ + (p >> 4)) * ldp + (p & 15) * 8; rq[i] = *(const pg8::u32x4*)g_; rk[i] = *(const pg8::u32x4*)(g_ + 2048); } \
        rv = *(const pg8::u32x4*)(vg + (r0_ + (tid >> 3)) * ldp + (tid & 7) * 8); \
        if (tid < 32) { ru = *(const pg8::f32x4*)(tg + (size_t)(n) * 256 + 128 + 4 * tid); rb = ((n) + 1 < 32) ? *(const pg8::f32x4*)(tg + (size_t)((n) + 1) * 256 + 4 * tid) : (pg8::f32x4){0.f, 0.f, 0.f, 0.f}; } } while (0)
#define HG_WRITE() do { \
        _Pragma("unroll") for (int i = 0; i < 2; ++i) { const int p = tid + 512 * i; const unsigned o_ = img_off(p >> 4, p & 15); *(LAS pg8::u32x4*)(F.lds + hg::OFF_Q + o_) = rq[i]; *(LAS pg8::u32x4*)(F.lds + hg::OFF_K + o_) = rk[i]; } \
        *(LAS pg8::u32x4*)(F.lds + hg::OFF_V + img_off(tid >> 3, tid & 7)) = rv; \
        if (tid < 32) *(LAS pg8::f32x4*)(ctab + 4 * tid) = (pg8::f32x4){__expf(ru[0] + rb[0]), __expf(ru[1] + rb[1]), __expf(ru[2] + rb[2]), __expf(ru[3] + rb[3])}; } while (0)
    HG_LOAD(0); HG_WRITE();
    __syncthreads();
#pragma unroll 1
    for (int n = 0; n < 32; ++n) {
        if (n + 1 < 32) HG_LOAD(n + 1);
        const int tcur = (n & 1) ? hg::OFF_T1 : hg::OFF_T0, tnxt = (n & 1) ? hg::OFF_T0 : hg::OFF_T1;
        if (wave >= 4) {
            const int dkb = wave - 4;
#pragma unroll
            for (int sp = 0; sp < 2; ++sp) {
                s16x4 ar[4], br[4], dr[4];
#pragma unroll
                for (int u = 0; u < 2; ++u) { const int s = 2 * sp + u;
                    ar[2 * u] = tr_read(lbase + hg::OFF_K + addr_tr(lane, 16 * s + 8 * hi, dkb)); ar[2 * u + 1] = tr_read(lbase + hg::OFF_K + addr_tr(lane, 16 * s + 8 * hi + 4, dkb));
                    br[2 * u] = tr_read(lbase + hg::OFF_V + addr_tr(lane, 16 * s + 8 * hi, 0)); br[2 * u + 1] = tr_read(lbase + hg::OFF_V + addr_tr(lane, 16 * s + 8 * hi + 4, 0));
                    dr[2 * u] = tr_read(lbase + hg::OFF_V + addr_tr(lane, 16 * s + 8 * hi, 1)); dr[2 * u + 1] = tr_read(lbase + hg::OFF_V + addr_tr(lane, 16 * s + 8 * hi + 4, 1)); }
                RET_LGKM0();
#pragma unroll
                for (int u = 0; u < 2; ++u) { const bf16x8 a = cat8(ar[2 * u], ar[2 * u + 1]);
                    t0 = __builtin_amdgcn_mfma_f32_32x32x16_bf16(a, cat8(br[2 * u], br[2 * u + 1]), t0, 0, 0, 0);
                    t1 = __builtin_amdgcn_mfma_f32_32x32x16_bf16(a, cat8(dr[2 * u], dr[2 * u + 1]), t1, 0, 0, 0); }
            }
#pragma unroll
            for (int g = 0; g < 4; ++g) { const pg8::f32x4 cv = *(const LAS pg8::f32x4*)(ctab + 32 * dkb + 8 * g + 4 * hi);
#pragma unroll
                for (int x = 0; x < 4; ++x) { const int r = 4 * g + x; t0[r] *= cv[x]; t1[r] *= cv[x]; } }
#pragma unroll
            for (int r = 0; r < 16; r += 2) { const int dk = 32 * dkb + (r & 3) + 8 * (r >> 2) + 4 * hi;
                const unsigned w0 = cvtpk(t0[r], t0[r + 1]), w1 = cvtpk(t1[r], t1[r + 1]);
                *(LAS bf16*)(F.lds + tnxt + img_off(dk, c >> 3) + (c & 7) * 2) = (bf16)(w0 & 0xffffu); *(LAS bf16*)(F.lds + tnxt + img_off(dk + 1, c >> 3) + (c & 7) * 2) = (bf16)(w0 >> 16);
                *(LAS bf16*)(F.lds + tnxt + img_off(dk, (32 + c) >> 3) + (c & 7) * 2) = (bf16)(w1 & 0xffffu); *(LAS bf16*)(F.lds + tnxt + img_off(dk + 1, (32 + c) >> 3) + (c & 7) * 2) = (bf16)(w1 >> 16); }
        } else {
            const int tb = wave & 1, dvb = wave >> 1;
            f32x16 o = {};
#pragma unroll
            for (int sp = 0; sp < 2; ++sp) {
                s16x4 br[8]; bf16x8 a[4];
#pragma unroll
                for (int u = 0; u < 4; ++u) { const int s = 4 * sp + u; a[u] = *(const LAS bf16x8*)(F.lds + hg::OFF_Q + addr_row(lane, tb, s));
                    br[2 * u] = tr_read(lbase + tcur + addr_tr(lane, 16 * s + 8 * hi, dvb)); br[2 * u + 1] = tr_read(lbase + tcur + addr_tr(lane, 16 * s + 8 * hi + 4, dvb)); }
                RET_LGKM0();
#pragma unroll
                for (int u = 0; u < 4; ++u) o = __builtin_amdgcn_mfma_f32_32x32x16_bf16(a[u], cat8(br[2 * u], br[2 * u + 1]), o, 0, 0, 0);
            }
#pragma unroll
            for (int sb = 0; sb < 2; ++sb) {
                if (sb <= tb) {
                    f32x16 sacc = {};
                    s16x4 vr[4];
#pragma unroll
                    for (int s = 0; s < 2; ++s) { vr[2 * s] = tr_read(lbase + hg::OFF_V + addr_tr(lane, 32 * sb + 16 * s + 4 * hi, dvb)); vr[2 * s + 1] = tr_read(lbase + hg::OFF_V + addr_tr(lane, 32 * sb + 16 * s + 8 + 4 * hi, dvb)); }
#pragma unroll
                    for (int s = 0; s < 8; ++s) {
                        const bf16x8 a = *(const LAS bf16x8*)(F.lds + hg::OFF_K + addr_row(lane, sb, s)), bq = *(const LAS bf16x8*)(F.lds + hg::OFF_Q + addr_row(lane, tb, s));
                        sacc = __builtin_amdgcn_mfma_f32_32x32x16_bf16(a, bq, sacc, 0, 0, 0);
                    }
                    if (sb == tb) {
#pragma unroll
                        for (int r = 0; r < 16; ++r) { const int sl = (r & 3) + 8 * (r >> 2) + 4 * hi; if (sl > c) sacc[r] = 0.f; }
                    }
                    RET_LGKM0();
#pragma unroll
                    for (int s = 0; s < 2; ++s) o = __builtin_amdgcn_mfma_f32_32x32x16_bf16(pack_acc8(sacc, s), cat8(vr[2 * s], vr[2 * s + 1]), o, 0, 0, 0);
                }
            }
            const size_t rowb = rowg0 + (size_t)n * 64 + tb * 32;
#pragma unroll
            for (int r = 0; r < 16; ++r) {
                const int il = (r & 3) + 8 * (r >> 2) + 4 * hi; const float v = o[r];
                const float q = half_sum_f(v * v);
                if (c == 31) F.ssq[((rowb + il) * 16 + h) * 4 + dvh * 2 + dvb] = q;
                const float vn = lane_xor1(v);
                if ((c & 1) == 0) *(unsigned*)(P + (rowb + il) * ldp + 4096 + h * 128 + dvh * 64 + dvb * 32 + c) = cvtpk(v, vn);
            }
        }
        LDS_BARRIER();
        if (n + 1 < 32) HG_WRITE();
        LDS_BARRIER();
    }
#undef HG_LOAD
#undef HG_WRITE
}

struct Args { const float* in[12]; float* out; unsigned char* ws; };
template <int L> __device__ __forceinline__ void mixer_phase(Frame& F, const XcdBarrier& bar) {
    if (L == 0) { index_topk_phase(F); xcd_barrier(bar); attn_phase<0>(F.P, F.mask, (char*)F.lds_gen, F.G); }
    if (L == 1) attn_phase<1>(F.P, F.mask, (char*)F.lds_gen, F.G);
    if (L == 2) ret_phase(F);
    if (L == 3) { hgrn_prep_phase(F); xcd_barrier(bar); hgrn_seq_phase(F); }
}
template <int L> __device__ __forceinline__ void layer_phases(Frame& F, const XcdBarrier& bar) {
    constexpr int N1 = n1pad(L);
    {
        pg8::Gemm g{F.U, F.WIN, MTOK, N1, D_MODEL, D_MODEL}; pg8::StaticOrder S; S.init(MTOK, N1, F.G, (int)blockIdx.x);
        EpiProj<L> E{F.P, N1, F.cos128, F.sin128, F.cos64, F.sin64, F.lb};
        pg8::gemm_phase<EpiProj<L>, pg8::StaticOrder, true, true>(F.lds, g, S, E);
    }
    xcd_barrier(bar);
    mixer_phase<L>(F, bar);
    xcd_barrier(bar);
    {
        pg8::Gemm g{F.U, F.WIN + (size_t)N1 * D_MODEL, MTOK, D_INNER, D_MODEL, D_MODEL}; pg8::StaticOrder S; S.init(MTOK, D_INNER, F.G, (int)blockIdx.x);
        EpiGate<L> E{F.P + ocol(L), N1, F.ssq};
        pg8::gemm_phase<EpiGate<L>, pg8::StaticOrder, true, true>(F.lds, g, S, E);
    }
    xcd_barrier(bar);
    {
        pg8::Gemm g{F.P + ocol(L), F.WOUT, MTOK, D_MODEL, D_INNER, N1}; pg8::StaticOrder S; S.init(MTOK, D_MODEL, F.G, (int)blockIdx.x);
        EpiAddF32 E{F.H, D_MODEL};
        pg8::gemm_phase<EpiAddF32, pg8::StaticOrder, true, true>(F.lds, g, S, E);
    }
    xcd_barrier(bar);
    if (L < 3) { norm_rows(F, F.H, F.norm_g + (L + 1) * D_MODEL, nullptr); conv_weights<(L < 3 ? L + 1 : 3)>(F); xcd_barrier(bar); }
    else final_rows(F);
}
__global__ void __launch_bounds__(NWAVES * 64, 2) mega_fwd(Args args) {
    extern __shared__ __attribute__((aligned(16))) unsigned char lds_raw[];
    Frame F;
    F.lds = (LAS unsigned char*)lds_raw; F.lds_gen = lds_raw; F.MISC = (volatile LAS unsigned*)(F.lds + MISC_OFF);
    F.G = gridDim.x;
    unsigned char* ws = args.ws;
    F.ctl = (unsigned*)(ws + WS_CTL);
    F.x = args.in[0]; F.norm_g = args.in[1]; F.final_g = args.in[2];
    F.w_in[0] = args.in[3]; F.w_out[0] = args.in[4]; F.w_in[1] = args.in[5]; F.w_out[1] = args.in[6]; F.w_in[2] = args.in[7]; F.w_out[2] = args.in[8]; F.w_in[3] = args.in[9]; F.w_out[3] = args.in[10];
    F.lb_logits = args.in[11]; F.H = args.out;
    F.cos128 = (float*)(ws + WS_TAB); F.sin128 = F.cos128 + 2048 * 64; F.cos64 = F.sin128 + 2048 * 64; F.sin64 = F.cos64 + 2048 * 32; F.lb = F.sin64 + 2048 * 32;
    F.ssq = (float*)(ws + WS_SSQ); F.mask = (unsigned*)(ws + WS_MASK);
    F.WIN = (bf16*)(ws + WS_WIN); F.WOUT = (bf16*)(ws + WS_WOUT); F.U = (bf16*)(ws + WS_U); F.P = (bf16*)(ws + WS_P);
    for (int u = threadIdx.x; u < (LDS_BYTES - RING_BYTES) / 4; u += NWAVES * 64) ((LAS unsigned*)(F.lds + RING_BYTES))[u] = 0u;
    __syncthreads();
    const XcdBarrier bar = xcd_barrier_post(F.ctl + CW_BAR, F.MISC + 8);
    make_tables(F); norm_rows(F, F.x, F.norm_g, F.H); conv_weights<0>(F);
    xcd_barrier(bar);
    layer_phases<0>(F, bar);
    layer_phases<1>(F, bar);
    layer_phases<2>(F, bar);
    layer_phases<3>(F, bar);
}

extern "C" void kernel_launch(void* const* d_in, const int* in_sizes, int n_in, void* d_out, int out_size, void* d_ws, size_t ws_size, hipStream_t stream) {
    static int grid = 0;
    if (grid == 0) {
        int dev = 0, cus = 0;
        if (hipGetDevice(&dev) != hipSuccess || hipDeviceGetAttribute(&cus, hipDeviceAttributeMultiprocessorCount, dev) != hipSuccess) { grid = -1; return; }
        if (hipFuncSetAttribute((const void*)mega_fwd, hipFuncAttributeMaxDynamicSharedMemorySize, LDS_BYTES) != hipSuccess) { grid = -1; return; }
        int per_cu = 0; (void)hipOccupancyMaxActiveBlocksPerMultiprocessor(&per_cu, (const void*)mega_fwd, NWAVES * 64, LDS_BYTES); (void)hipGetLastError();
        if (cus < 256) { fprintf(stderr, "kernel_launch: needs 256 CUs\n"); grid = -1; return; }
        grid = 256;
        if (ws_size < WS_END || n_in != 12) { fprintf(stderr, "kernel_launch: unexpected workspace / inputs\n"); grid = -1; return; }
    }
    if (grid < 0) return;
    (void)hipMemsetAsync((char*)d_ws + WS_CTL, 0, CTL_ZERO_BYTES, stream);
    Args a; for (int i = 0; i < 12; ++i) a.in[i] = (const float*)d_in[i];
    a.out = (float*)d_out; a.ws = (unsigned char*)d_ws;
    hipLaunchKernelGGL(mega_fwd, dim3(grid), dim3(NWAVES * 64), LDS_BYTES, stream, a);
}
```

```cpp
#include <hip/hip_runtime.h>
#include <cstdio>
#include <cstdint>
#define GAS __attribute__((address_space(1)))
#define LAS __attribute__((address_space(3)))
namespace pg8 {
#define PG8_LAS __attribute__((address_space(3)))
typedef unsigned short bf16_t;
typedef short bf16x8 __attribute__((ext_vector_type(8)));
typedef float f32x4 __attribute__((ext_vector_type(4)));
typedef unsigned u32x4 __attribute__((ext_vector_type(4)));
constexpr int BM = 256, BK = 64, HALF = 128, HTB = HALF * BK * 2  , STAGE_BYTES = 8 * HTB, NXCD = 8, WGM = 8;

__host__ __device__ __forceinline__ int lds_byte(int r, int c) { const int st = (r >> 4) * 2 + (c >> 5), rr = r & 15, cc = c & 31, ob = rr * 64 + cc * 2; return st * 1024 + (ob ^ (((ob >> 9) & 1) << 5)); }
__host__ __device__ __forceinline__ void stage_rc(int b, int& R, int& C) { const int st = b / 1024, sb = b % 1024, swz = sb ^ (((sb >> 9) & 1) << 5); R = (st >> 1) * 16 + swz / 64; C = (st & 1) * 32 + (swz % 64) / 2; }
__host__ __device__ __forceinline__ int perm32(int rho) { const int n = rho >> 4, i = rho & 15; return 8 * (i >> 2) + 4 * n + (i & 3); }

struct Unit { int pm, pn; };
struct Gemm { const bf16_t* A; const bf16_t* Bt; int M, N, K, lda; };

struct StaticOrder {
    int nM, nN, nwg, G, c;
    __host__ __device__ void init(int M, int N, int G_, int c_) { nM = M / BM; nN = N / BM; nwg = nM * nN; G = G_; c = c_; }
    __host__ __device__ bool next(int i, Unit& u) const {
        const long L = (long)i * G + c; if (L >= nwg) return false;
        int wgid = (int)L; { const int q = nwg / NXCD, r = nwg % NXCD, xcd = wgid % NXCD, off = wgid / NXCD; wgid = (xcd < r ? xcd * (q + 1) : r * (q + 1) + (xcd - r) * q) + off; }
        const int nig = WGM * nN, gid = wgid / nig, fm = gid * WGM, gsz = (nM - fm) < WGM ? (nM - fm) : WGM;
        u.pm = fm + ((wgid % nig) % gsz); u.pn = (wgid % nig) / gsz; return true;
    }
    __device__ __forceinline__ void a_ready(const Unit&) const {}
    __device__ __forceinline__ void done(const Unit&) const {}
};

typedef float f32x2v_t __attribute__((ext_vector_type(2)));
typedef __bf16 bf16x2v_t __attribute__((ext_vector_type(2)));
__device__ __forceinline__ unsigned cvt_pk_bf16(float lo, float hi) { const f32x2v_t v = {lo, hi}; const bf16x2v_t b = __builtin_convertvector(v, bf16x2v_t); return __builtin_bit_cast(unsigned, b); }
typedef float f32x2 __attribute__((ext_vector_type(2)));
template <class Epi, class Sched, bool ALIGN_EPI = false, bool SP2 = false>
__device__ __forceinline__ void gemm_phase(PG8_LAS unsigned char* lds, const Gemm g, const Sched& S, const Epi& E) {
    int tid_o = threadIdx.x; asm volatile("" : "+v"(tid_o));
    const int tid = tid_o, wid = __builtin_amdgcn_readfirstlane(tid >> 6), lane = tid & 63, wr = wid >> 2, wc = wid & 3, fr = lane & 15, fq = lane >> 4;
    const int K = g.K, nt = K / BK;
    unsigned voffA[2], voffB[2];
#pragma unroll
    for (int i = 0; i < 2; ++i) { int R, C; stage_rc(tid * 16 + i * 8192, R, C); const int Rb = Epi::PERM ? ((R & ~31) + perm32(R & 31)) : R;
        voffA[i] = (unsigned)(R * g.lda + C) * 2u; voffB[i] = (unsigned)(Rb * K + C) * 2u; }
    const size_t kstep = (size_t)(BK * 2);
    const size_t hstepA = (size_t)HALF * g.lda * 2, hstepB = (size_t)HALF * K * 2;
    const size_t tstepA = 2 * hstepA, tstepB = 2 * hstepB;
    const unsigned ldsw = (unsigned)wid * 1024u;
    const int aoff = lds_byte(wr * 64 + fr, fq * 8), boff = lds_byte(wc * 32 + fr, fq * 8);
#define PG8_SA(b, h) (((b) * 2 + (h)) * HTB)
#define PG8_SB(b, h) ((4 + (b) * 2 + (h)) * HTB)
#define PG8_STAGE(bufoff, gbase, voff) do { _Pragma("unroll") for (int _i = 0; _i < 2; ++_i) \
        __builtin_amdgcn_global_load_lds((const unsigned*)((const char*)(gbase) + (voff)[_i]), (PG8_LAS unsigned*)(lds + (bufoff) + ldsw + _i * 8192), 16, 0, 0); } while (0)
#define PG8_LDA(dst, b, h) do { _Pragma("unroll") for (int m = 0; m < 4; ++m) _Pragma("unroll") for (int k = 0; k < 2; ++k) dst[m][k] = *(const PG8_LAS bf16x8*)(lds + PG8_SA(b, h) + aoff + m * 2048 + k * 1024); } while (0)
#define PG8_LDB(dst, b, h) do { _Pragma("unroll") for (int n = 0; n < 2; ++n) _Pragma("unroll") for (int k = 0; k < 2; ++k) dst[n][k] = *(const PG8_LAS bf16x8*)(lds + PG8_SB(b, h) + boff + n * 2048 + k * 1024); } while (0)
#define PG8_MMA(ai, bj, At, Bt) do { __builtin_amdgcn_s_setprio(1); _Pragma("unroll") for (int m = 0; m < 4; ++m) _Pragma("unroll") for (int n = 0; n < 2; ++n) _Pragma("unroll") for (int k = 0; k < 2; ++k) \
        acc[ai][bj][m][n] = __builtin_amdgcn_mfma_f32_16x16x32_bf16(Bt[n][k], At[m][k], acc[ai][bj][m][n], 0, 0, 0); __builtin_amdgcn_s_setprio(0); } while (0)
#define PG8_WAIT_V(n) asm volatile("s_waitcnt vmcnt(" #n ")" ::: "memory")
#define PG8_WAIT_L(n) asm volatile("s_waitcnt lgkmcnt(" #n ")" ::: "memory")
#define PG8_BAR __builtin_amdgcn_s_barrier()
#define PG8_SCHED __builtin_amdgcn_sched_barrier(0)
    Unit cur, nxt; int ui = 0;
    if (!S.next(0, cur)) return;
    f32x4 acc[2][2][4][2];
#pragma unroll
    for (int a = 0; a < 2; ++a)
#pragma unroll
        for (int b = 0; b < 2; ++b)
#pragma unroll
            for (int m = 0; m < 4; ++m)
#pragma unroll
                for (int n = 0; n < 2; ++n) acc[a][b][m][n] = (f32x4){0.f, 0.f, 0.f, 0.f};
    bf16x8 At[4][2], B0[2][2], B1[2][2];
    const char* cA = (const char*)g.A + (size_t)cur.pm * tstepA; const char* cB = (const char*)g.Bt + (size_t)cur.pn * tstepB;
    S.a_ready(cur);
    if constexpr (SP2) {
        PG8_STAGE(PG8_SB(0, 0), cB, voffB); PG8_STAGE(PG8_SB(0, 1), cB + hstepB, voffB); PG8_STAGE(PG8_SA(0, 0), cA, voffA); PG8_STAGE(PG8_SA(0, 1), cA + hstepA, voffA);
        if (wr == 1) PG8_BAR;
        PG8_WAIT_V(2); PG8_BAR;
        PG8_STAGE(PG8_SB(1, 0), cB + kstep, voffB); PG8_STAGE(PG8_SA(1, 0), cA + kstep, voffA); PG8_STAGE(PG8_SB(1, 1), cB + hstepB + kstep, voffB);
        PG8_WAIT_V(6); PG8_BAR;
    } else {
        PG8_STAGE(PG8_SB(0, 0), cB, voffB); PG8_STAGE(PG8_SA(0, 0), cA, voffA); PG8_STAGE(PG8_SB(0, 1), cB + hstepB, voffB); PG8_STAGE(PG8_SA(0, 1), cA + hstepA, voffA);
        if (wr == 1) PG8_BAR;
        PG8_WAIT_V(4); PG8_BAR;
        PG8_STAGE(PG8_SB(1, 0), cB + kstep, voffB); PG8_STAGE(PG8_SA(1, 0), cA + kstep, voffA); PG8_STAGE(PG8_SB(1, 1), cB + hstepB + kstep, voffB);
        PG8_WAIT_V(6); PG8_BAR;
    }
    for (;;) {
        const bool has_next = S.next(ui + 1, nxt);
        const char* nA = has_next ? (const char*)g.A + (size_t)nxt.pm * tstepA : cA; const char* nB = has_next ? (const char*)g.Bt + (size_t)nxt.pn * tstepB : cB;
        for (int t = 0; t < nt; t += 2) {
            const bool last = (t == nt - 2);
            const char* a1 = cA + (size_t)(t + 1) * kstep;
            const char* a2 = last ? nA : cA + (size_t)(t + 2) * kstep; const char* b2 = last ? nB : cB + (size_t)(t + 2) * kstep;
            const char* a3 = a2 + kstep; const char* b3 = b2 + kstep;
            if (last && has_next) S.a_ready(nxt);
            if constexpr (SP2) {
            PG8_LDB(B0, 0, 0); PG8_LDB(B1, 0, 1); PG8_SCHED; PG8_LDA(At, 0, 0); PG8_STAGE(PG8_SA(1, 1), a1 + hstepA, voffA);
            PG8_WAIT_V(8); PG8_WAIT_L(0); PG8_BAR; PG8_MMA(0, 0, At, B0); PG8_MMA(0, 1, At, B1); PG8_BAR; PG8_SCHED;
            PG8_LDA(At, 0, 1); PG8_STAGE(PG8_SB(0, 0), b2, voffB); PG8_STAGE(PG8_SB(0, 1), b2 + hstepB, voffB); PG8_STAGE(PG8_SA(0, 0), a2, voffA);
            PG8_WAIT_V(8); PG8_WAIT_L(0); PG8_BAR; PG8_MMA(1, 0, At, B0); PG8_MMA(1, 1, At, B1); PG8_BAR; PG8_SCHED;
            PG8_LDB(B0, 1, 0); PG8_LDB(B1, 1, 1); PG8_SCHED; PG8_LDA(At, 1, 0); PG8_STAGE(PG8_SA(0, 1), a2 + hstepA, voffA);
            PG8_WAIT_V(8); PG8_WAIT_L(0); PG8_BAR; PG8_MMA(0, 0, At, B0); PG8_MMA(0, 1, At, B1); PG8_BAR; PG8_SCHED;
            PG8_LDA(At, 1, 1); PG8_STAGE(PG8_SB(1, 0), b3, voffB); PG8_STAGE(PG8_SB(1, 1), b3 + hstepB, voffB); PG8_STAGE(PG8_SA(1, 0), a3, voffA);
            PG8_WAIT_V(8); PG8_WAIT_L(0); PG8_BAR; PG8_MMA(1, 0, At, B0); PG8_MMA(1, 1, At, B1); PG8_BAR; PG8_SCHED;
            } else {
            PG8_LDB(B0, 0, 0); PG8_SCHED; PG8_LDA(At, 0, 0); PG8_STAGE(PG8_SA(1, 1), a1 + hstepA, voffA);
            PG8_WAIT_L(8); PG8_BAR; PG8_WAIT_L(0); PG8_MMA(0, 0, At, B0); PG8_BAR; PG8_SCHED;
            PG8_LDB(B1, 0, 1); PG8_STAGE(PG8_SB(0, 0), b2, voffB);
            PG8_BAR; PG8_WAIT_L(0); PG8_MMA(0, 1, At, B1); PG8_BAR;
            PG8_LDA(At, 0, 1); PG8_STAGE(PG8_SA(0, 0), a2, voffA);
            PG8_BAR; PG8_WAIT_L(0); PG8_MMA(1, 0, At, B0); PG8_BAR; PG8_SCHED;
            PG8_STAGE(PG8_SB(0, 1), b2 + hstepB, voffB);
            PG8_WAIT_V(6); PG8_BAR; PG8_MMA(1, 1, At, B1); PG8_BAR;
            PG8_LDB(B0, 1, 0); PG8_SCHED; PG8_LDA(At, 1, 0); PG8_STAGE(PG8_SA(0, 1), a2 + hstepA, voffA);
            PG8_WAIT_L(8); PG8_BAR; PG8_WAIT_L(0); PG8_MMA(0, 0, At, B0); PG8_BAR; PG8_SCHED;
            PG8_LDB(B1, 1, 1); PG8_STAGE(PG8_SB(1, 0), b3, voffB);
            PG8_BAR; PG8_WAIT_L(0); PG8_MMA(0, 1, At, B1); PG8_BAR;
            PG8_LDA(At, 1, 1); PG8_STAGE(PG8_SA(1, 0), a3, voffA);
            PG8_BAR; PG8_WAIT_L(0); PG8_MMA(1, 0, At, B0); PG8_BAR; PG8_SCHED;
            PG8_STAGE(PG8_SB(1, 1), b3 + hstepB, voffB);
            PG8_WAIT_V(6); PG8_BAR; PG8_MMA(1, 1, At, B1); PG8_BAR;
            }
        }
        if constexpr (ALIGN_EPI) { if (wr == 0) PG8_BAR; }
        if constexpr (!Epi::AFTER_DRAIN) { E(acc, cur, wr, wc, fr, fq); S.done(cur); }
        if (!has_next) break;
#pragma unroll
        for (int a = 0; a < 2; ++a)
#pragma unroll
            for (int b = 0; b < 2; ++b)
#pragma unroll
                for (int m = 0; m < 4; ++m)
#pragma unroll
                    for (int n = 0; n < 2; ++n) acc[a][b][m][n] = (f32x4){0.f, 0.f, 0.f, 0.f};
        cur = nxt; cA = nA; cB = nB; ++ui;
        if constexpr (ALIGN_EPI) { if (wr == 1) PG8_BAR; }
    }
    PG8_WAIT_V(0);
    if constexpr (!ALIGN_EPI) { if (wr == 0) PG8_BAR; }
    PG8_BAR;
    if constexpr (Epi::AFTER_DRAIN) { E.fused(acc, cur, wr, wc, fr, fq, lds, wid, lane); S.done(cur); }
#undef PG8_SA
#undef PG8_SB
#undef PG8_STAGE
#undef PG8_LDA
#undef PG8_LDB
#undef PG8_MMA
#undef PG8_WAIT_V
#undef PG8_WAIT_L
#undef PG8_BAR
#undef PG8_SCHED
}
}
#define XB_TMO      128
#define XB_XCNT(j)  (256  + 64 * (j))
#define XB_XSUB(j)  (1280 + 64 * (j))
#define XB_XGEN(j)  (2304 + 64 * (j))
#define XB_TOP      3328
#define XB_TOPGEN   3392
#define XCD_BAR_WORDS 3456
#define XB_SPIN_CAP (1u << 18)

__device__ __forceinline__ unsigned xb_ld(unsigned* p)              { return __hip_atomic_load(p, __ATOMIC_RELAXED, __HIP_MEMORY_SCOPE_AGENT); }
__device__ __forceinline__ unsigned xb_add(unsigned* p, unsigned v) { return __hip_atomic_fetch_add(p, v, __ATOMIC_RELAXED, __HIP_MEMORY_SCOPE_AGENT); }
__device__ __forceinline__ unsigned xb_xcc_id() { return (unsigned)__builtin_amdgcn_s_getreg((3 << 11) | 20) & 0xFu; }
#define XB_SPIN(cond, bar) do { unsigned _sp = 0; while (cond) { __builtin_amdgcn_s_sleep(1); \
    if ((++_sp & 255u) == 0u) { if (xb_ld(&(bar)[XB_TMO])) break; if (_sp > XB_SPIN_CAP) { atomicAdd(&(bar)[XB_TMO], 1u); break; } } } } while (0)

struct XcdBarrier {
    unsigned* bar; unsigned x;
    volatile LAS unsigned* st;
};

__device__ __forceinline__ XcdBarrier xcd_barrier_post(unsigned* bar, volatile LAS unsigned* st) {
    XcdBarrier b; b.bar = bar; b.x = xb_xcc_id(); b.st = st;
    if (threadIdx.x == 0) (void)xb_add(&bar[XB_XCNT(b.x)], 1u);
    return b;
}
__device__ __forceinline__ void xcd_barrier_complete(unsigned* bar, unsigned x, unsigned& nloc, unsigned& nx) {
    const unsigned G = gridDim.x * gridDim.y * gridDim.z;
    unsigned sum, cnt, mine, sp = 0u;
    for (;;) {
        sum = 0u; cnt = 0u; mine = 0u;
#pragma unroll
        for (unsigned j = 0; j < 16; ++j) { const unsigned c = xb_ld(&bar[XB_XCNT(j)]); sum += c; cnt += (c > 0u) ? 1u : 0u; mine = (j == x) ? c : mine; }
        if (sum == G) break;
        __builtin_amdgcn_s_sleep(1);
        if ((++sp & 255u) == 0u) { if (xb_ld(&bar[XB_TMO])) break; if (sp > XB_SPIN_CAP) { atomicAdd(&bar[XB_TMO], 1u); break; } }
    }
    nloc = mine > 0u ? mine : 1u; nx = cnt > 0u ? cnt : 1u;
}

__device__ __forceinline__ void xcd_barrier(const XcdBarrier& b) {
    asm volatile("s_waitcnt vmcnt(0)" ::: "memory");
    __syncthreads();
    if (threadIdx.x == 0) {
        unsigned* bar = b.bar;
        __builtin_amdgcn_s_waitcnt(0);
        unsigned nloc = b.st[0], nx = b.st[1];
        if (nloc == 0u) { xcd_barrier_complete(bar, b.x, nloc, nx); b.st[0] = nloc; b.st[1] = nx; }
        const unsigned old = xb_add(&bar[XB_XSUB(b.x)], 1u);
        const unsigned gen = old / nloc;
        if (old + 1u == (gen + 1u) * nloc) {
            __builtin_amdgcn_fence(__ATOMIC_RELEASE, "agent");
            asm volatile("s_waitcnt vmcnt(0)" ::: "memory");
            const unsigned og = xb_add(&bar[XB_TOP], 1u);
            const unsigned tg = og / nx;
            if (og + 1u == (tg + 1u) * nx) xb_add(&bar[XB_TOPGEN], 1u);
            else XB_SPIN(xb_ld(&bar[XB_TOPGEN]) == tg, bar);
            __builtin_amdgcn_fence(__ATOMIC_ACQUIRE, "agent");
            xb_add(&bar[XB_XGEN(b.x)], 1u);
            asm volatile("s_waitcnt vmcnt(0)" ::: "memory");
        } else {
            XB_SPIN(xb_ld(&bar[XB_XGEN(b.x)]) == gen, bar);
            __builtin_amdgcn_fence(__ATOMIC_ACQUIRE, "agent");
            asm volatile("s_waitcnt vmcnt(0)" ::: "memory");
        }
    }
    __syncthreads();
}

typedef unsigned short bf16;
typedef GAS unsigned gu32;
constexpr int D_MODEL = 1024, SEQ = 2048, D_INNER = 2048, MTOK = 16384, NWAVES = 8;
constexpr float QK_SCALE = 0.08838834764831845f;
constexpr size_t MiB = 1u << 20;
constexpr size_t WS_CTL = 0, CTL_ZERO_BYTES = 64 * 1024, WS_TAB = 1 * MiB, WS_SSQ = 3 * MiB, WS_MASK = 7 * MiB, WS_WIN = 12 * MiB, WS_WOUT = 28 * MiB, WS_U = 32 * MiB, WS_P = 64 * MiB, WS_END = 256 * MiB;
constexpr int CW_BAR = 1024;
constexpr int RING_BYTES = 131072, MISC_OFF = RING_BYTES + 320, LDS_BYTES = 163840, STG_OFF = 133120;
__host__ __device__ constexpr int n1pad(int L) { return L == 0 ? 3584 : (L == 1 ? 6144 : (L == 2 ? 4096 : 6144)); }
__host__ __device__ constexpr int n1real(int L) { return L == 0 ? 3408 : (L == 1 ? 6144 : (L == 2 ? 4096 : 6144)); }
__host__ __device__ constexpr int nsrc(int L) { return L == 0 ? 5456 : (L == 1 ? 8192 : (L == 2 ? 6144 : 8192)); }
__host__ __device__ constexpr int ocol(int L) { return L == 0 ? 0 : (L == 1 ? 0 : (L == 2 ? 2048 : 4096)); }
constexpr int A_K = 2048, A_V = 2176, A_IQ = 2304, A_IK = 3328, A_IW = 3392;

__device__ __forceinline__ float bf2f(bf16 v) { return __uint_as_float(((unsigned)v) << 16); }
__device__ __forceinline__ bf16 f2bf(float f) { unsigned u = __float_as_uint(f); return (bf16)((u + 0x7fffu + ((u >> 16) & 1u)) >> 16); }
__device__ __forceinline__ unsigned pk2(float lo, float hi) { return (unsigned)f2bf(lo) | ((unsigned)f2bf(hi) << 16); }
template <int CTRL, int ROWMASK> __device__ __forceinline__ float dpp_f(float old, float v) { return __int_as_float(__builtin_amdgcn_update_dpp(__float_as_int(old), __float_as_int(v), CTRL, ROWMASK, 0xf, false)); }
template <int CTRL, int ROWMASK> __device__ __forceinline__ int dpp_i(int old, int v) { return __builtin_amdgcn_update_dpp(old, v, CTRL, ROWMASK, 0xf, false); }
__device__ __forceinline__ float half_sum_f(float v) {
    v += dpp_f<0x111, 0xf>(0.f, v); v += dpp_f<0x112, 0xf>(0.f, v); v += dpp_f<0x114, 0xf>(0.f, v); v += dpp_f<0x118, 0xf>(0.f, v); v += dpp_f<0x142, 0xa>(0.f, v);
    return v;
}
__device__ __forceinline__ int half_sum_i(int v) {
    v += dpp_i<0x111, 0xf>(0, v); v += dpp_i<0x112, 0xf>(0, v); v += dpp_i<0x114, 0xf>(0, v); v += dpp_i<0x118, 0xf>(0, v); v += dpp_i<0x142, 0xa>(0, v);
    return v;
}
__device__ __forceinline__ float wave_sum(float v) {
    v = half_sum_f(v); v += dpp_f<0x143, 0xc>(0.f, v);
    return __int_as_float(__builtin_amdgcn_readlane(__float_as_int(v), 63));
}
__device__ __forceinline__ float wave_max(float v) {
    v = fmaxf(v, dpp_f<0x111, 0xf>(v, v)); v = fmaxf(v, dpp_f<0x112, 0xf>(v, v)); v = fmaxf(v, dpp_f<0x114, 0xf>(v, v)); v = fmaxf(v, dpp_f<0x118, 0xf>(v, v));
    v = fmaxf(v, dpp_f<0x142, 0xa>(v, v)); v = fmaxf(v, dpp_f<0x143, 0xc>(v, v));
    return __int_as_float(__builtin_amdgcn_readlane(__float_as_int(v), 63));
}
__device__ __forceinline__ float lane_xor1(float v) { return dpp_f<0xB1, 0xf>(v, v); }
__device__ __forceinline__ float ret_lg(int h) { const float x = __builtin_amdgcn_exp2f(-5.f - (float)h); return -(x + x * x * (0.5f + x * (0.33333334f + 0.25f * x))) * 1.4426950408889634f; }
__device__ __forceinline__ float silu_f(float z) { return z * __builtin_amdgcn_rcpf(1.f + __expf(-z)); }
__device__ __forceinline__ float sigmoid_f(float z) { return __builtin_amdgcn_rcpf(1.f + __expf(-z)); }
#define LDS_WAIT() asm volatile("s_waitcnt lgkmcnt(0)" ::: "memory")
#define LDS_BARRIER() do { asm volatile("s_waitcnt lgkmcnt(0)" ::: "memory"); __builtin_amdgcn_s_barrier(); asm volatile("" ::: "memory"); } while (0)
#define PHASE_IDS() int tid_o_ = threadIdx.x; asm volatile("" : "+v"(tid_o_)); const int tid = tid_o_, lane = tid & 63, wave = __builtin_amdgcn_readfirstlane(tid >> 6); (void)lane; (void)wave

struct Frame {
    LAS unsigned char* lds; unsigned char* lds_gen; volatile LAS unsigned* MISC; unsigned* ctl;
    int G;
    const float* x; const float* norm_g; const float* final_g; const float* w_in[4]; const float* w_out[4]; const float* lb_logits;
    float* H;
    float *cos128, *sin128, *cos64, *sin64, *lb, *ssq; unsigned* mask;
    bf16 *WIN, *WOUT, *U, *P;
};

template <int L> __device__ __forceinline__ int proj_mode(int g32) {
    if (L == 0) return g32 < 68 ? 1 : (g32 < 72 ? 0 : (g32 < 106 ? 2 : 0));
    if (L == 1) return g32 < 128 ? 1 : 0;
    if (L == 2) return g32 < 32 ? 1 : (g32 < 64 ? 3 : 0);
    return 0;
}
__device__ __forceinline__ void epi_hgrn_prep(const pg8::f32x4 (&acc)[2][2][4][2], const pg8::Unit& u, int wr, int wc, int fr, int fq, bf16* P, const float* lb, float* tab) {
    constexpr int ldp = n1pad(3); const int h = u.pn, kc = wc * 32 + 8 * fq;
    pg8::f32x4 lbv[2]; lbv[0] = *(const pg8::f32x4*)(lb + h * 128 + kc); lbv[1] = *(const pg8::f32x4*)(lb + h * 128 + kc + 4);
#pragma unroll
    for (int ai = 0; ai < 2; ++ai) {
        const int rowc = u.pm * 256 + ai * 128 + wr * 64;
        pg8::f32x4 qh[4][2], kk[4][2], bb[4][2], pre[2], bref[2];
        pre[0] = (pg8::f32x4){0.f, 0.f, 0.f, 0.f}; pre[1] = pre[0];
#pragma unroll
        for (int m = 0; m < 4; ++m) {
#pragma unroll
            for (int n = 0; n < 2; ++n) {
                const pg8::f32x4 fv = acc[ai][1][m][n], qv = acc[ai][0][m][n]; pg8::f32x4 p, t;
#pragma unroll
                for (int j = 0; j < 4; ++j) { const float g = lbv[n][j] + (1.f - lbv[n][j]) * sigmoid_f(fv[j]); const float lf = __logf(g); kk[m][n][j] = 1.f - g; qh[m][n][j] = silu_f(qv[j]) * QK_SCALE;
                    float x = lf;
                    x += dpp_f<0x111, 0xf>(0.f, x); x += dpp_f<0x112, 0xf>(0.f, x); x += dpp_f<0x114, 0xf>(0.f, x); x += dpp_f<0x118, 0xf>(0.f, x);
                    float s = lf;
                    s += dpp_f<0xB1, 0xf>(0.f, s); s += dpp_f<0x4E, 0xf>(0.f, s); s += dpp_f<0x141, 0xf>(0.f, s); s += dpp_f<0x140, 0xf>(0.f, s);
                    p[j] = x; t[j] = s; }
                bb[m][n] = p + pre[n]; pre[n] = pre[n] + t;
                if (m == 1) bref[n] = pre[n];
            }
        }
#pragma unroll
        for (int m = 0; m < 4; ++m) {
            unsigned qo[4], ko[4];
#pragma unroll
            for (int n = 0; n < 2; ++n) {
                float qt[4], kt[4];
#pragma unroll
                for (int j = 0; j < 4; ++j) { const float e = __expf(bb[m][n][j] - bref[n][j]); qt[j] = qh[m][n][j] * e; kt[j] = kk[m][n][j] * __builtin_amdgcn_rcpf(e); }
                qo[2 * n] = pg8::cvt_pk_bf16(qt[0], qt[1]); qo[2 * n + 1] = pg8::cvt_pk_bf16(qt[2], qt[3]); ko[2 * n] = pg8::cvt_pk_bf16(kt[0], kt[1]); ko[2 * n + 1] = pg8::cvt_pk_bf16(kt[2], kt[3]);
            }
            bf16* rp = P + (size_t)(rowc + 16 * m + fr) * ldp + h * 128 + kc;
            *(pg8::u32x4*)rp = (pg8::u32x4){qo[0], qo[1], qo[2], qo[3]}; *(pg8::u32x4*)(rp + 2048) = (pg8::u32x4){ko[0], ko[1], ko[2], ko[3]};
        }
        if (fr == 0) { float* tp = tab + ((size_t)(((rowc >> 11) * 16 + h) * 32 + ((rowc & (SEQ - 1)) >> 6))) * 256 + kc;
            *(pg8::f32x4*)tp = bref[0]; *(pg8::f32x4*)(tp + 4) = bref[1]; *(pg8::f32x4*)(tp + 128) = pre[0] - bref[0]; *(pg8::f32x4*)(tp + 132) = pre[1] - bref[1]; }
    }
}
template <int L> struct EpiProj {
    static constexpr bool PERM = true, AFTER_DRAIN = false;
    bf16* P; int ldp; const float *c128, *s128, *c64, *s64, *lb; float* tab;
    __device__ __forceinline__ void operator()(const pg8::f32x4 (&acc)[2][2][4][2], const pg8::Unit& u, int wr, int wc, int fr, int fq) const {
        if (L == 3 && u.pn < 16) { epi_hgrn_prep(acc, u, wr, wc, fr, fq, P, lb, tab); return; }
        const int row0 = u.pm * 256 + wr * 64 + fr, colb = u.pn * 256 + wc * 32 + 8 * fq;
#pragma unroll
        for (int bj = 0; bj < 2; ++bj) {
            const int col = colb + bj * 128; const int mode = proj_mode<L>(__builtin_amdgcn_readfirstlane(col >> 5));
#pragma unroll
            for (int ai = 0; ai < 2; ++ai)
#pragma unroll
                for (int m = 0; m < 4; ++m) {
                    const int row = row0 + ai * 128 + m * 16, pos = row & (SEQ - 1);
                    pg8::f32x4 v0 = acc[ai][bj][m][0], v1 = acc[ai][bj][m][1];
                    if (mode == 1 || mode == 3) { const int i0 = ((col & 127) >> 3) * 4;
                        const pg8::f32x4 c = *(const pg8::f32x4*)(c128 + pos * 64 + i0), s = *(const pg8::f32x4*)(s128 + pos * 64 + i0);
                        const pg8::f32x4 o1 = v0 * c - v1 * s, o2 = v0 * s + v1 * c; v0 = o1; v1 = o2;
                        if (L == 2) { const float lgh = ret_lg((col >> 7) & 7); const float fsc = (mode == 3) ? QK_SCALE * __builtin_amdgcn_exp2f(-(float)(pos & 127) * lgh) : __builtin_amdgcn_exp2f((float)(pos & 127) * lgh); v0 = v0 * fsc; v1 = v1 * fsc; }
                        else if (mode == 3) { v0 = v0 * QK_SCALE; v1 = v1 * QK_SCALE; } }
                    else if (mode == 2) { const int i0 = ((col & 63) >> 3) * 4;
                        const pg8::f32x4 c = *(const pg8::f32x4*)(c64 + pos * 32 + i0), s = *(const pg8::f32x4*)(s64 + pos * 32 + i0);
                        const pg8::f32x4 o1 = v0 * c - v1 * s, o2 = v0 * s + v1 * c; v0 = o1; v1 = o2; }
                    else if (mode == 4) {
#pragma unroll
                        for (int j = 0; j < 4; ++j) { v0[j] = silu_f(v0[j]) * QK_SCALE; v1[j] = silu_f(v1[j]) * QK_SCALE; } }
                    else if (mode == 5) { const pg8::f32x4 l0 = *(const pg8::f32x4*)(lb + col - 2048), l1 = *(const pg8::f32x4*)(lb + col - 2048 + 4);
#pragma unroll
                        for (int j = 0; j < 4; ++j) { v0[j] = __logf(l0[j] + (1.f - l0[j]) * sigmoid_f(v0[j])); v1[j] = __logf(l1[j] + (1.f - l1[j]) * sigmoid_f(v1[j])); } }
                    pg8::u32x4 w; w.x = pg8::cvt_pk_bf16(v0[0], v0[1]); w.y = pg8::cvt_pk_bf16(v0[2], v0[3]); w.z = pg8::cvt_pk_bf16(v1[0], v1[1]); w.w = pg8::cvt_pk_bf16(v1[2], v1[3]);
                    *(pg8::u32x4*)(P + (size_t)row * ldp + col) = w;
                }
        }
    }
};
template <int L> struct EpiGate {
    static constexpr bool PERM = true, AFTER_DRAIN = false;
    bf16* O; int ldo; const float* ssq;
    __device__ __forceinline__ void operator()(const pg8::f32x4 (&acc)[2][2][4][2], const pg8::Unit& u, int wr, int wc, int fr, int fq) const {
        const int row0 = u.pm * 256 + wr * 64 + fr, colb = u.pn * 256 + wc * 32 + 8 * fq;
#pragma unroll
        for (int ai = 0; ai < 2; ++ai)
#pragma unroll
            for (int m = 0; m < 4; ++m) {
                const int row = row0 + ai * 128 + m * 16;
#pragma unroll
                for (int bj = 0; bj < 2; ++bj) {
                    const int col = colb + bj * 128; float rs = 1.f;
                    if (L == 2) { const pg8::f32x4 q = *(const pg8::f32x4*)(ssq + ((size_t)row * 8 + (col >> 8)) * 8), q2 = *(const pg8::f32x4*)(ssq + ((size_t)row * 8 + (col >> 8)) * 8 + 4);
                        rs = rsqrtf((((q[0] + q[1]) + (q[2] + q[3])) + ((q2[0] + q2[1]) + (q2[2] + q2[3]))) * (1.f / 256.f) + 1e-6f); }
                    if (L == 3) { const pg8::f32x4 q = *(const pg8::f32x4*)(ssq + ((size_t)row * 16 + (col >> 7)) * 4); rs = rsqrtf(((q[0] + q[1]) + (q[2] + q[3])) * (1.f / 128.f) + 1e-6f); }
                    bf16* p = O + (size_t)row * ldo + col; const pg8::u32x4 r = *(const pg8::u32x4*)p;
                    const pg8::f32x4 z0 = acc[ai][bj][m][0], z1 = acc[ai][bj][m][1];
                    float o[8]; o[0] = __uint_as_float(r.x << 16); o[1] = __uint_as_float(r.x & 0xffff0000u); o[2] = __uint_as_float(r.y << 16); o[3] = __uint_as_float(r.y & 0xffff0000u);
                    o[4] = __uint_as_float(r.z << 16); o[5] = __uint_as_float(r.z & 0xffff0000u); o[6] = __uint_as_float(r.w << 16); o[7] = __uint_as_float(r.w & 0xffff0000u);
#pragma unroll
                    for (int j = 0; j < 4; ++j) { o[j] = o[j] * rs * silu_f(z0[j]); o[4 + j] = o[4 + j] * rs * silu_f(z1[j]); }
                    pg8::u32x4 w; w.x = pg8::cvt_pk_bf16(o[0], o[1]); w.y = pg8::cvt_pk_bf16(o[2], o[3]); w.z = pg8::cvt_pk_bf16(o[4], o[5]); w.w = pg8::cvt_pk_bf16(o[6], o[7]);
                    *(pg8::u32x4*)p = w;
                }
            }
    }
};
struct EpiAddF32 {
    static constexpr bool PERM = false, AFTER_DRAIN = false;
    float* C; int ldc; const float* S;
    __device__ __forceinline__ void operator()(const pg8::f32x4 (&acc)[2][2][4][2], const pg8::Unit& u, int wr, int wc, int fr, int fq) const {
        const int row0 = u.pm * 256 + wr * 64 + fr, col0 = u.pn * 256 + wc * 32 + 4 * fq;
#pragma unroll
        for (int ai = 0; ai < 2; ++ai)
#pragma unroll
            for (int m = 0; m < 4; ++m) { float* rowp = C + (size_t)(row0 + ai * 128 + m * 16) * ldc + col0;
#pragma unroll
                for (int bj = 0; bj < 2; ++bj)
#pragma unroll
                    for (int n = 0; n < 2; ++n) { pg8::f32x4* p = (pg8::f32x4*)(rowp + bj * 128 + n * 16); *p = *(const pg8::f32x4*)(S + (p - (pg8::f32x4*)C) * 4) + acc[ai][bj][m][n]; } }
    }
};

template <int L> __device__ __forceinline__ int srccol(int n) {
    if (n >= n1pad(L)) return n1real(L) + (n - n1pad(L));
    if (L == 3) { if (n >= 4096) return n; const int t = n >> 8, w = n & 255; return w < 128 ? t * 128 + w : 2048 + t * 128 + (w - 128); }
    if (n >= n1real(L)) return -1;
    const int mode = proj_mode<L>(n >> 5);
    if (mode == 1 || mode == 3) { const int w = n & 127; return (n & ~127) + 64 * ((w >> 2) & 1) + 4 * (w >> 3) + (w & 3); }
    if (mode == 2) { const int r = n - A_IQ, w = r & 63; return A_IQ + (r & ~63) + 32 * ((w >> 2) & 1) + 4 * (w >> 3) + (w & 3); }
    return n;
}
template <int L  > __device__ __forceinline__ void conv_item(const float* W, int Nsrc, bf16* WT, int Kdim, int nblk, int item, LAS float* scr, int lane) {
    const int kb = item / nblk, nb = item % nblk, k0 = 32 * kb, n0 = 64 * nb;
    int src = n0 + 4 * (lane & 15); if (L >= 0) src = srccol<(L < 0 ? 0 : L)>(src);
    pg8::f32x4 v[8];
#pragma unroll
    for (int i = 0; i < 8; ++i) { const int kk = 4 * i + (lane >> 4); v[i] = (src >= 0) ? *(const pg8::f32x4*)(W + (size_t)(k0 + kk) * Nsrc + src) : (pg8::f32x4){0.f, 0.f, 0.f, 0.f}; }
#pragma unroll
    for (int i = 0; i < 8; ++i) { const int kk = 4 * i + (lane >> 4); *(LAS pg8::f32x4*)(scr + kk * 68 + 4 * (lane & 15)) = v[i]; }
    LDS_WAIT();
    const int c = lane & 3;
#pragma unroll
    for (int j = 0; j < 4; ++j) { const int n = (lane >> 2) + 16 * j; const LAS float* s = scr + (8 * c) * 68 + n;
        pg8::u32x4 o; o.x = pk2(s[0 * 68], s[1 * 68]); o.y = pk2(s[2 * 68], s[3 * 68]); o.z = pk2(s[4 * 68], s[5 * 68]); o.w = pk2(s[6 * 68], s[7 * 68]);
        *(pg8::u32x4*)(WT + (size_t)(n0 + n) * Kdim + k0 + 8 * c) = o; }
    LDS_WAIT();
}
template <int L> __device__ __forceinline__ void conv_weights(Frame& F) {
    PHASE_IDS();
    LAS float* scr = (LAS float*)(F.lds + wave * 16384);
    const int gw = blockIdx.x * NWAVES + wave, NGW = F.G * NWAVES;
    constexpr int NB_IN = (n1pad(L) + 2048) / 64, I_IN = NB_IN * (1024 / 32), NB_OUT = 1024 / 64, I_OUT = NB_OUT * (2048 / 32);
    for (int it = gw; it < I_IN + I_OUT; it += NGW) {
        if (it < I_IN) conv_item<L>(F.w_in[L], nsrc(L), F.WIN, 1024, NB_IN, it, scr, lane);
        else conv_item<-1>(F.w_out[L], 1024, F.WOUT, 2048, NB_OUT, it - I_IN, scr, lane);
    }
}
__device__ __forceinline__ void norm_rows(Frame& F, const float* src, const float* g, float* copy_to) {
    PHASE_IDS();
    const int gw = blockIdx.x * NWAVES + wave, NGW = F.G * NWAVES;
    float4 gg[4];
#pragma unroll
    for (int j = 0; j < 4; ++j) gg[j] = ((const float4*)g)[lane + 64 * j];
    for (int row = gw; row < MTOK; row += 2 * NGW) {
        const int row2 = row + NGW;
        const float4* xa = (const float4*)(src + (size_t)row * D_MODEL) + lane; const float4* xb = (const float4*)(src + (size_t)row2 * D_MODEL) + lane;
        float4 va[4], vb[4]; float sa = 0.f, sb = 0.f;
#pragma unroll
        for (int j = 0; j < 4; ++j) { va[j] = xa[64 * j]; vb[j] = xb[64 * j]; }
#pragma unroll
        for (int j = 0; j < 4; ++j) { sa += va[j].x * va[j].x + va[j].y * va[j].y + va[j].z * va[j].z + va[j].w * va[j].w; sb += vb[j].x * vb[j].x + vb[j].y * vb[j].y + vb[j].z * vb[j].z + vb[j].w * vb[j].w; }
        const float ra = rsqrtf(wave_sum(sa) * (1.f / D_MODEL) + 1e-6f), rb = rsqrtf(wave_sum(sb) * (1.f / D_MODEL) + 1e-6f);
#pragma unroll
        for (int j = 0; j < 4; ++j) {
            if (copy_to) { ((float4*)(copy_to + (size_t)row * D_MODEL))[lane + 64 * j] = va[j]; ((float4*)(copy_to + (size_t)row2 * D_MODEL))[lane + 64 * j] = vb[j]; }
            uint2 o; o.x = pk2(va[j].x * ra * gg[j].x, va[j].y * ra * gg[j].y); o.y = pk2(va[j].z * ra * gg[j].z, va[j].w * ra * gg[j].w);
            *(uint2*)(F.U + (size_t)row * D_MODEL + (lane + 64 * j) * 4) = o;
            uint2 o2; o2.x = pk2(vb[j].x * rb * gg[j].x, vb[j].y * rb * gg[j].y); o2.y = pk2(vb[j].z * rb * gg[j].z, vb[j].w * rb * gg[j].w);
            *(uint2*)(F.U + (size_t)row2 * D_MODEL + (lane + 64 * j) * 4) = o2;
        }
    }
}
__device__ __forceinline__ void final_rows(Frame& F) {
    PHASE_IDS();
    const int gw = blockIdx.x * NWAVES + wave, NGW = F.G * NWAVES;
    for (int row = gw; row < MTOK; row += NGW) {
        float4* xr = (float4*)(F.H + (size_t)row * D_MODEL) + lane;
        float4 v[4]; float s = 0.f;
#pragma unroll
        for (int j = 0; j < 4; ++j) { v[j] = xr[64 * j]; s += v[j].x * v[j].x + v[j].y * v[j].y + v[j].z * v[j].z + v[j].w * v[j].w; }
        const float r = rsqrtf(wave_sum(s) * (1.f / D_MODEL) + 1e-6f);
#pragma unroll
        for (int j = 0; j < 4; ++j) { const float4 gg = ((const float4*)F.final_g)[lane + 64 * j]; xr[64 * j] = make_float4(v[j].x * r * gg.x, v[j].y * r * gg.y, v[j].z * r * gg.z, v[j].w * r * gg.w); }
    }
}
__device__ __forceinline__ void make_tables(Frame& F) {
    PHASE_IDS();
    const int gt = blockIdx.x * 512 + tid, NT = F.G * 512;
    for (int i = gt; i < 2048 * 64; i += NT) {
        { const int pos = i >> 6, f = i & 63; const float freq = exp2f(-((float)(2 * f) / 128.f) * 13.287712379549449f);
          double rev = (double)pos * (double)freq * 0.15915494309189535; rev -= floor(rev);
          F.cos128[i] = __builtin_amdgcn_cosf((float)rev); F.sin128[i] = __builtin_amdgcn_sinf((float)rev); }
        if (i < 2048 * 32) { const int pos = i >> 5, f = i & 31; const float freq = exp2f(-((float)(2 * f) / 64.f) * 13.287712379549449f);
          double rev = (double)pos * (double)freq * 0.15915494309189535; rev -= floor(rev);
          F.cos64[i] = __builtin_amdgcn_cosf((float)rev); F.sin64[i] = __builtin_amdgcn_sinf((float)rev); }
        if (i < 2048) { const float l0 = F.lb_logits[i], l1 = F.lb_logits[2048 + i], l2 = F.lb_logits[4096 + i], l3 = F.lb_logits[6144 + i];
          const float m = fmaxf(fmaxf(l0, l1), fmaxf(l2, l3)); const float e0 = __expf(l0 - m), e1 = __expf(l1 - m), e2 = __expf(l2 - m), e3 = __expf(l3 - m);
          F.lb[i] = (e1 + e2 + e3) / (e0 + e1 + e2 + e3); }
    }
}
namespace att {
constexpr int D = 128;
constexpr float THR = 8.f;
constexpr bool WSKIP = false;
constexpr float SCALE = 0.08838834764831845f;
constexpr int NW = 8, QBLK = 32, KVBLK = 64, QB = NW * QBLK;
constexpr int SHM_V = KVBLK * D * 2, SHM_K = KVBLK * D * 2;
constexpr int LDS_BYTES = 2 * SHM_V + 2 * SHM_K + NW * 64 * 4;
typedef short bf16x8 __attribute__((ext_vector_type(8)));
typedef short s16x4 __attribute__((ext_vector_type(4)));
typedef float f32x16 __attribute__((ext_vector_type(16)));
typedef float f32x4 __attribute__((ext_vector_type(4)));
typedef unsigned u32x4 __attribute__((ext_vector_type(4)));
template <class A, class Bt> struct same_t { static constexpr bool v = false; };
template <class A> struct same_t<A, A> { static constexpr bool v = true; };
#define KSWZ(row, colB) ((row) * 256 + ((colB) ^ (((row) & 7) << 4)))
#define SBAR() __builtin_amdgcn_sched_barrier(0)
__device__ __forceinline__ int v_st(int k, int c) { const int kk = (k & ~0xC) | ((k & 4) << 1) | ((k & 8) >> 1); return ((kk >> 3) * 4 + (c >> 5)) * 512 + ((kk & 7) * 32 + (c & 31)) * 2; }
__device__ __forceinline__ int v_rd_base(int lane) { return ((lane & 3) << 3) | (((lane >> 2) & 3) << 6) | (((lane >> 4) & 1) << 5) | (((lane >> 5) & 1) << 8); }
constexpr int v_rd_off(int d0, int ks, int half) { return d0 * 512 + ks * 4096 + half * 2048; }
__device__ __forceinline__ int crow(int r, int hi) { return (r & 3) + 8 * (r >> 2) + 4 * hi; }
__device__ __forceinline__ unsigned cvtpk(float lo, float hi) {
    unsigned r; asm volatile("v_cvt_pk_bf16_f32 %0, %1, %2" : "=v"(r) : "v"(lo), "v"(hi)); return r;
}
__device__ __forceinline__ bf16x8 pack8(f32x4 a, f32x4 b) {
    u32x4 w = {cvtpk(a[0], a[1]), cvtpk(a[2], a[3]), cvtpk(b[0], b[1]), cvtpk(b[2], b[3])};
    return *reinterpret_cast<bf16x8*>(&w);
}
template <class T> __device__ __forceinline__ bf16x8 load8(const T* p) {
    if constexpr (same_t<T, float>::v) { return pack8(*(const f32x4*)p, *(const f32x4*)(p + 4)); }
    else { return *reinterpret_cast<const bf16x8*>(p); }
}
__device__ __forceinline__ void mask_bits(f32x16& p0, f32x16& p1, unsigned w0, unsigned w1) {
    const float NEG = -__builtin_inff();
#pragma unroll
    for (int r = 0; r < 16; ++r) { const int c = (r & 3) + 8 * (r >> 2); if (!((w0 >> c) & 1u)) p0[r] = NEG; if (!((w1 >> c) & 1u)) p1[r] = NEG; }
}
__device__ __forceinline__ float wmult(float s, int d) {
    const unsigned ud = (unsigned)d; const int cnt = (ud <= 128u ? 1 : 0) + ((((d & 3) == 0) && ud <= 512u) ? 1 : 0) + ((((d & 15) == 0) && d >= 0) ? 1 : 0);
    const float add = cnt >= 3 ? 12.4293792f : (cnt == 2 ? 7.84206515f : 0.f);
    return cnt == 0 ? -__builtin_inff() : s + add;
}
__device__ __forceinline__ void mask_mult(f32x16& p0, f32x16& p1, int dq) {
#pragma unroll
    for (int r = 0; r < 16; ++r) { const int c = (r & 3) + 8 * (r >> 2); p0[r] = wmult(p0[r], dq - c); p1[r] = wmult(p1[r], dq - c - 32); }
}
__device__ __forceinline__ void mask_far(f32x16& p0, f32x16& p1, int dq) {
    const float NEG = -__builtin_inff(); const int dm = dq & 15;
#pragma unroll
    for (int r = 0; r < 16; ++r) { const int c = ((r & 3) + 8 * (r >> 2)) & 15; const float v = (dm == c) ? 0.f : NEG; p0[r] += v; p1[r] += v; }
}
__device__ __forceinline__ void mask_mid(f32x16& p0, f32x16& p1, int dq) {
    const float NEG = -__builtin_inff(); const int dm = dq & 15, d4 = dq & 3;
#pragma unroll
    for (int r = 0; r < 16; ++r) { const int c = ((r & 3) + 8 * (r >> 2)) & 15; const float v = (dm == c) ? 7.84206515f : ((d4 == (r & 3)) ? 0.f : NEG); p0[r] += v; p1[r] += v; }
}
__device__ __forceinline__ void mask_near(f32x16& p0, f32x16& p1, int dq) {
    const int dm = dq & 15, d4 = dq & 3;
#pragma unroll
    for (int r = 0; r < 16; ++r) { const int c = ((r & 3) + 8 * (r >> 2)) & 15; const float v = (dm == c) ? 12.4293792f : ((d4 == (r & 3)) ? 7.84206515f : 0.f); p0[r] += v; p1[r] += v; }
}
__device__ __forceinline__ void partialSM(f32x16& p0, f32x16& p1, float& m_reg, float& mn, float& alpha) {
    float pmax = p0[0]; for (int r = 1; r < 16; ++r) pmax = fmaxf(pmax, p0[r]); for (int r = 0; r < 16; ++r) pmax = fmaxf(pmax, p1[r]);
    { auto rr = __builtin_amdgcn_permlane32_swap(__float_as_uint(pmax), __float_as_uint(pmax), false, false);
      pmax = fmaxf(__uint_as_float(rr[0]), __uint_as_float(rr[1])); }
    constexpr float C2 = 1.4426950408889634f * SCALE;
    if (__builtin_expect(__all((pmax - m_reg) * SCALE <= THR), 1)) { mn = m_reg; alpha = 1.f; }
    else { mn = fmaxf(m_reg, pmax); alpha = __builtin_amdgcn_exp2f((m_reg - mn) * C2); m_reg = mn; }
    const float mnL = -mn * C2;
    for (int r = 0; r < 16; ++r) p0[r] = fmaf(p0[r], C2, mnL); for (int r = 0; r < 16; ++r) p1[r] = fmaf(p1[r], C2, mnL);
    for (int r = 0; r < 16; ++r) p0[r] = __builtin_amdgcn_exp2f(p0[r]);
}
__device__ __forceinline__ void finishSM(f32x16& p0, f32x16& p1, float alpha, float& l_reg, bf16x8& pa0, bf16x8& pa1, bf16x8& pa2, bf16x8& pa3) {
    for (int r = 0; r < 16; ++r) p1[r] = __builtin_amdgcn_exp2f(p1[r]);
    float ps = 0; for (int r = 0; r < 16; ++r) ps += p0[r]; for (int r = 0; r < 16; ++r) ps += p1[r];
    { auto rr = __builtin_amdgcn_permlane32_swap(__float_as_uint(ps), __float_as_uint(ps), false, false);
      ps = __uint_as_float(rr[0]) + __uint_as_float(rr[1]); }
    l_reg = l_reg * alpha + ps;
#define PK4(P, B_, OUT) do { unsigned a0 = cvtpk(P[B_+0], P[B_+1]), a1 = cvtpk(P[B_+2], P[B_+3]);                          \
        unsigned b0 = cvtpk(P[B_+4], P[B_+5]), b1 = cvtpk(P[B_+6], P[B_+7]);                                             \
        auto r0 = __builtin_amdgcn_permlane32_swap(a0, b0, false, false); auto r1 = __builtin_amdgcn_permlane32_swap(a1, b1, false, false); \
        u32x4 w = {r0[0], r1[0], r0[1], r1[1]}; OUT = *reinterpret_cast<bf16x8*>(&w); } while (0)
    PK4(p0, 0, pa0); PK4(p0, 8, pa1); PK4(p1, 0, pa2); PK4(p1, 8, pa3);
#undef PK4
}
template <int KB, bool SK>
__device__ __forceinline__ void qkt(f32x16& p0, f32x16& p1, const char* K_lds, int r32, int hi, const bf16x8* qr, bool act) {
    if (SK && !act) { const float NEG = -__builtin_inff();
#pragma unroll
        for (int r = 0; r < 16; ++r) { p0[r] = NEG; p1[r] = NEG; } return; }
    p0 = f32x16{}; p1 = f32x16{};
    const char* kb[4];
#pragma unroll
    for (int dd = 0; dd < 4; ++dd) kb[dd] = K_lds + KB * SHM_K + KSWZ(r32, (dd * 16 + hi * 8) * 2);
#pragma unroll
    for (int d0 = 0; d0 < 8; ++d0) { const char* a = kb[d0 & 3] + (d0 >> 2) * 128;
        bf16x8 b0 = *reinterpret_cast<const bf16x8*>(a);
        bf16x8 b1 = *reinterpret_cast<const bf16x8*>(a + 32 * 256);
        p0 = __builtin_amdgcn_mfma_f32_32x32x16_bf16(b0, qr[d0], p0, 0, 0, 0);
        p1 = __builtin_amdgcn_mfma_f32_32x32x16_bf16(b1, qr[d0], p1, 0, 0, 0); }
}
template <int VB, bool SK>
__device__ __forceinline__ void pv_tile(f32x16* o, int vb0, bf16x8 pa0, bf16x8 pa1, bf16x8 pa2, bf16x8 pa3, bool act) {
    if (SK && !act) return;
#define TRRD(dst, off) asm volatile("ds_read_b64_tr_b16 %0, %1 offset:%2" : "=&v"(dst) : "v"(vb0), "i"(off) : "memory")
#define PV_D0(d0) do { s16x4 l0, l1, l2, l3, h0, h1, h2, h3; constexpr int b_ = VB * SHM_V + v_rd_off(d0, 0, 0);     \
        TRRD(l0, b_); TRRD(h0, b_ + 2048); TRRD(l1, b_ + 4096); TRRD(h1, b_ + 6144); TRRD(l2, b_ + 8192); TRRD(h2, b_ + 10240); TRRD(l3, b_ + 12288); TRRD(h3, b_ + 14336); \
        asm volatile("s_waitcnt lgkmcnt(0)" ::: "memory"); SBAR();                 \
        o[d0] = __builtin_amdgcn_mfma_f32_32x32x16_bf16(pa0, (bf16x8){l0[0], l0[1], l0[2], l0[3], h0[0], h0[1], h0[2], h0[3]}, o[d0], 0, 0, 0);   \
        o[d0] = __builtin_amdgcn_mfma_f32_32x32x16_bf16(pa1, (bf16x8){l1[0], l1[1], l1[2], l1[3], h1[0], h1[1], h1[2], h1[3]}, o[d0], 0, 0, 0);   \
        o[d0] = __builtin_amdgcn_mfma_f32_32x32x16_bf16(pa2, (bf16x8){l2[0], l2[1], l2[2], l2[3], h2[0], h2[1], h2[2], h2[3]}, o[d0], 0, 0, 0);   \
        o[d0] = __builtin_amdgcn_mfma_f32_32x32x16_bf16(pa3, (bf16x8){l3[0], l3[1], l3[2], l3[3], h3[0], h3[1], h3[2], h3[3]}, o[d0], 0, 0, 0); } while (0)
    PV_D0(0); PV_D0(1); PV_D0(2); PV_D0(3);
#undef PV_D0
#undef TRRD
}
template <class TIn, class TOut> struct BlockRef { const TIn* Q; const TIn* K; const TIn* V; TOut* O; const unsigned* M; int P0; };
template <class TIn> struct Seam {
    bf16x8 qr[8];
    bf16x8 st_v0, st_v1, st_k0, st_k1; f32x4 sf0, sf1, sf2, sf3;
    f32x4 tq[16];
};
__device__ __forceinline__ int swa_jlo(int P0, int W) { const int lowk = P0 - W + 1; return lowk > 0 ? lowk / KVBLK : 0; }
#define ROW(p, k0, rr) ((p) + (size_t)((k0) + (rr)) * RSK + sc)
#define VMW() asm volatile("s_waitcnt vmcnt(0)" ::: "memory")
#define VMWN(n) asm volatile("s_waitcnt vmcnt(%0)" :: "i"(n) : "memory")
#define SLOAD_H(Kp, Vp, k0) do { S.st_v0 = load8<TIn>(ROW(Vp, k0, sr)); S.st_v1 = load8<TIn>(ROW(Vp, k0, 32 + sr));              \
                         S.st_k0 = load8<TIn>(ROW(Kp, k0, sr)); S.st_k1 = load8<TIn>(ROW(Kp, k0, 32 + sr)); } while (0)
#define SWRITE_HK(bf) do { *(bf16x8*)(K_lds + (bf) * SHM_K + kws) = S.st_k0; *(bf16x8*)(K_lds + (bf) * SHM_K + kws + 32 * 256) = S.st_k1; } while (0)
#define SWRITE_HV(bf) do { *(bf16x8*)(V_lds + (bf) * SHM_V + vst0) = S.st_v0; *(bf16x8*)(V_lds + (bf) * SHM_V + vst1) = S.st_v1; } while (0)
#define SWRITE_H(bf) do { SWRITE_HV(bf); SWRITE_HK(bf); } while (0)
#define SLOAD_F(p, k0) do { S.sf0 = *(const f32x4*)ROW(p, k0, sr); S.sf1 = *(const f32x4*)(ROW(p, k0, sr) + 4);                \
                            S.sf2 = *(const f32x4*)ROW(p, k0, 32 + sr); S.sf3 = *(const f32x4*)(ROW(p, k0, 32 + sr) + 4); } while (0)
#define SWRITE_KF(bf) do { *(bf16x8*)(K_lds + (bf) * SHM_K + kws) = pack8(S.sf0, S.sf1); *(bf16x8*)(K_lds + (bf) * SHM_K + kws + 32 * 256) = pack8(S.sf2, S.sf3); } while (0)
#define SWRITE_VF(bf) do { *(bf16x8*)(V_lds + (bf) * SHM_V + vst0) = pack8(S.sf0, S.sf1); *(bf16x8*)(V_lds + (bf) * SHM_V + vst1) = pack8(S.sf2, S.sf3); } while (0)
template <class TIn, class TOut, int RSQ, int RSK, int MK>
__device__ __forceinline__ void causal_swa_prime(const BlockRef<TIn, TOut>& cur, int W, char* lds, Seam<TIn>& S) {
    constexpr bool F32 = same_t<TIn, float>::v;
    int tid_o = threadIdx.x; asm volatile("" : "+v"(tid_o)); const int tid = tid_o, wid = __builtin_amdgcn_readfirstlane(tid >> 6), lane = tid & 63, r32 = lane & 31, hi = lane >> 5;
    const int sr = tid >> 4, sc = (tid & 15) * 8, kws = KSWZ(sr, sc * 2); char* K_lds = lds + 2 * SHM_V;
    const int kb0 = swa_jlo(cur.P0, W) * KVBLK;
    for (int d0 = 0; d0 < 8; ++d0) S.qr[d0] = load8<TIn>(cur.Q + (size_t)(wid * QBLK + r32) * RSQ + d0 * 16 + hi * 8);
    if constexpr (F32) { SLOAD_F((const float*)cur.K, kb0); VMW(); SWRITE_KF(0); SBAR(); SLOAD_F((const float*)cur.V, kb0); }
    else { SLOAD_H(cur.K, cur.V, kb0); VMW(); SWRITE_HK(0); }
    __syncthreads();
}
template <class TIn, class TOut, int RSQ, int RSK, int MK>
__device__ __forceinline__ void causal_swa_block(const BlockRef<TIn, TOut>& cur, const BlockRef<TIn, TOut>& nxt, int skv, int W, char* lds, Seam<TIn>& S) {
    constexpr bool F32 = same_t<TIn, float>::v;
    int tid_o = threadIdx.x; asm volatile("" : "+v"(tid_o)); const int tid = tid_o, wid = __builtin_amdgcn_readfirstlane(tid >> 6), lane = tid & 63, r32 = lane & 31, hi = lane >> 5;
    const int j_lo = swa_jlo(cur.P0, W);
    int j_hi = (cur.P0 + QB - 1) / KVBLK + 1; if (j_hi > skv / KVBLK) j_hi = skv / KVBLK;
    const int NT = j_hi - j_lo;
    const int kbn = swa_jlo(nxt.P0, W) * KVBLK;
    const int qlo = cur.P0 + wid * QBLK, qm = qlo + r32 - 4 * hi;
    const unsigned* mrow = (MK == 0) ? cur.M + (size_t)(wid * QBLK + r32) * 64 : nullptr; uint2 mw = make_uint2(0u, 0u); if constexpr (MK == 0) mw = *(const uint2*)(mrow + 2 * j_lo);
    char* V_lds = lds; char* K_lds = lds + 2 * SHM_V;
    float* ws = (float*)(lds + 2 * SHM_V + 2 * SHM_K) + wid * 64; float* li_l = ws, * al_l = ws + 32;
    float m_reg = -1e30f, l_reg = 0; f32x16 o[4] = {};
    const int sr = tid >> 4, sc = (tid & 15) * 8, vst0 = v_st(sr, sc), vst1 = v_st(32 + sr, sc), kws = KSWZ(sr, sc * 2);
    const int vb0 = (int)(uintptr_t)V_lds + v_rd_base(lane);
    const TIn* Kh = cur.K; const TIn* Vh = cur.V;
#define RESC(a) do { if (__any((a) < 1.f)) { if (hi == 0) al_l[r32] = (a); asm volatile("s_waitcnt lgkmcnt(0)" ::: "memory");              \
                     for (int d_ = 0; d_ < 4; ++d_) for (int r = 0; r < 16; ++r) o[d_][r] *= al_l[crow(r, hi)]; } } while (0)
#define KBASE(t) ((j_lo + (t)) * KVBLK)
#define ACT(t) (KBASE(t) <= qlo + QBLK - 1 && KBASE(t) + KVBLK - 1 >= qlo - W + 1)
#define MASKT(P0_, P1_, t) do { const int kb_ = KBASE(t); \
        if constexpr (MK == 1) { const int dmin_ = qlo - (kb_ + KVBLK - 1), dmax_ = qlo + QBLK - 1 - kb_; \
            if (dmin_ > 512) mask_far(P0_, P1_, qm - kb_); else if (dmin_ > 128 && dmax_ <= 512) mask_mid(P0_, P1_, qm - kb_); \
            else if (dmin_ >= 0 && dmax_ <= 128) mask_near(P0_, P1_, qm - kb_); else mask_mult(P0_, P1_, qm - kb_); } \
        else { mask_bits(P0_, P1_, mw.x >> (4 * hi), mw.y >> (4 * hi)); const int tn_ = ((t) + 1 < NT) ? (t) + 1 : (t); mw = *(const uint2*)(mrow + 2 * (j_lo + tn_)); } } while (0)
    constexpr int NQL = F32 ? 16 : 8;
    constexpr bool SK = WSKIP && !F32;
#define SEAM_K0() do { VMWN(NQL); if constexpr (F32) { SWRITE_KF(0); SBAR(); SLOAD_F((const float*)nxt.V, kbn); } else { SWRITE_HK(0); } SBAR(); } while (0)
    f32x16 pA0, pA1, pB0, pB1; float mnA, mnB, alA, alB; bf16x8 pa0, pa1, pa2, pa3;
    if constexpr (F32) { VMW(); SWRITE_VF(0); SBAR(); } else { SWRITE_HV(0); SBAR(); }
    if (NT > 1) { if constexpr (F32) SLOAD_F((const float*)Kh, KBASE(1)); else SLOAD_H(Kh, Vh, KBASE(1)); }
    SBAR(); qkt<0, SK>(pA0, pA1, K_lds, r32, hi, S.qr, ACT(0));
    if constexpr (F32) { if (NT > 1) { VMW(); SWRITE_KF(1); SBAR(); SLOAD_F((const float*)Vh, KBASE(1)); } }
    MASKT(pA0, pA1, 0); partialSM(pA0, pA1, m_reg, mnA, alA);
    if (NT > 1) { VMW(); if constexpr (F32) { SWRITE_VF(1); SBAR(); if (NT > 2) SLOAD_F((const float*)Kh, KBASE(2)); } else SWRITE_H(1); }
    __syncthreads();
#define HALF_STEP(PX0, PX1, mnX, alX, PY0, PY1, alY, t, KB, VB, SB) do {                                                      \
        SBAR(); qkt<KB, SK>(PX0, PX1, K_lds, r32, hi, S.qr, ACT(t));                                             \
        finishSM(PY0, PY1, alY, l_reg, pa0, pa1, pa2, pa3); SBAR();                                                           \
        if ((t) + 1 < NT) { if constexpr (F32) { VMW(); SWRITE_KF(SB); SBAR(); SLOAD_F((const float*)Vh, KBASE((t) + 1)); }  \
                            else { SLOAD_H(Kh, Vh, KBASE((t) + 1)); } SBAR(); }                                               \
        pv_tile<VB, SK>(o, vb0, pa0, pa1, pa2, pa3, ACT((t) - 1)); MASKT(PX0, PX1, (t)); partialSM(PX0, PX1, m_reg, mnX, alX);                                        \
        __syncthreads();                                                                                                      \
        if ((t) + 1 < NT) { VMW(); if constexpr (F32) { SWRITE_VF(SB); SBAR(); if ((t) + 2 < NT) SLOAD_F((const float*)Kh, KBASE((t) + 2)); } \
                            else { SWRITE_H(SB); } }                                                                          \
        RESC(alX); __syncthreads(); } while (0)
    for (int t = 1; t + 1 < NT; t += 2) {
        HALF_STEP(pB0, pB1, mnB, alB, pA0, pA1, alA, t, 1, 0, 0);
        HALF_STEP(pA0, pA1, mnA, alA, pB0, pB1, alB, t + 1, 0, 1, 1);
    }
    const bool even = (NT & 1) == 0;
    if (even) { SBAR(); qkt<1, SK>(pB0, pB1, K_lds, r32, hi, S.qr, ACT(NT - 1)); SBAR(); }
#define QROW(e) (nxt.Q + (size_t)(wid * QBLK + r32) * RSQ + ((e) >> 1) * 16 + hi * 8 + ((e) & 1) * 4)
    if constexpr (F32) { SLOAD_F((const float*)nxt.K, kbn); SBAR();
#pragma unroll
        for (int e = 0; e < 8; ++e) S.tq[e] = *(const f32x4*)QROW(e); }
    else { SLOAD_H(nxt.K, nxt.V, kbn); SBAR();
#pragma unroll
        for (int d0 = 0; d0 < 8; ++d0) S.qr[d0] = load8<TIn>(nxt.Q + (size_t)(wid * QBLK + r32) * RSQ + d0 * 16 + hi * 8); }
    SBAR();
    finishSM(pA0, pA1, alA, l_reg, pa0, pa1, pa2, pa3); SBAR();
    if constexpr (F32) {
#pragma unroll
        for (int e = 8; e < 16; ++e) S.tq[e] = *(const f32x4*)QROW(e); SBAR(); }
#undef QROW
    pv_tile<0, SK>(o, vb0, pa0, pa1, pa2, pa3, ACT(even ? NT - 2 : NT - 1));
    if (even) { MASKT(pB0, pB1, NT - 1); partialSM(pB0, pB1, m_reg, mnB, alB); __syncthreads(); RESC(alB);
        finishSM(pB0, pB1, alB, l_reg, pa0, pa1, pa2, pa3); SBAR(); pv_tile<1, SK>(o, vb0, pa0, pa1, pa2, pa3, ACT(NT - 1)); }
    SBAR(); SEAM_K0();
    if (hi == 0) li_l[r32] = l_reg; asm volatile("s_waitcnt lgkmcnt(0)" ::: "memory");
    float rli[16];
#pragma unroll
    for (int r = 0; r < 16; ++r) rli[r] = __builtin_amdgcn_rcpf(li_l[crow(r, hi)]);
    TOut* Ow = cur.O + (size_t)(wid * QBLK) * RSQ;
#pragma unroll
    for (int r = 0; r < 16; ++r) { const int orow = crow(r, hi);
#pragma unroll
        for (int d0 = 0; d0 < 4; ++d0) { const float v = o[d0][r] * rli[r];
            if constexpr (same_t<TOut, float>::v) { Ow[(size_t)orow * RSQ + d0 * 32 + r32] = v; }
            else { const float vn = __int_as_float(__builtin_amdgcn_update_dpp(__float_as_int(v), __float_as_int(v), 0xB1, 0xf, 0xf, false));
                   if ((r32 & 1) == 0) *(unsigned*)(Ow + (size_t)orow * RSQ + d0 * 32 + r32) = cvtpk(v, vn); } } }
    if constexpr (F32) {
#pragma unroll
        for (int d0 = 0; d0 < 8; ++d0) S.qr[d0] = pack8(S.tq[2 * d0], S.tq[2 * d0 + 1]); }
    __syncthreads();
#undef RESC
#undef KBASE
#undef ACT
#undef MASKT
#undef SEAM_K0
#undef HALF_STEP
}
#undef ROW
#undef VMW
#undef VMWN
#undef SLOAD_H
#undef SWRITE_HK
#undef SWRITE_HV
#undef SWRITE_H
#undef SLOAD_F
#undef SWRITE_KF
#undef SWRITE_VF
}

__device__ __forceinline__ unsigned fkey(float f) { const unsigned u = __float_as_uint(f + 0.0f); return (u & 0x80000000u) ? ~u : (u | 0x80000000u); }

__device__ __forceinline__ void naive_index_topk(Frame& F) {
    PHASE_IDS();
    const bf16* P = F.P; constexpr int ldp = n1pad(0);
    LAS float* iq = (LAS float*)F.lds; LAS float* iw = iq + 1024; LAS float* sc = iw + 16; LAS unsigned* mw = (LAS unsigned*)(sc + 2048); LAS unsigned* cnt = mw + 64;
    for (int row = blockIdx.x; row < MTOK; row += F.G) {
        const int t = row & (SEQ - 1), rb = row - t;
        for (int i = tid; i < 1024; i += 512) iq[i] = bf2f(P[(size_t)row * ldp + A_IQ + i]);
        if (tid < 16) iw[tid] = bf2f(P[(size_t)row * ldp + A_IW + tid]) * (1.f / 32.f);
        if (tid < 64) mw[tid] = 0u;
        __syncthreads();
        for (int s = tid; s <= t; s += 512) {
            const uint4* kp = (const uint4*)(P + (size_t)(rb + s) * ldp + A_IK);
            float kk[64];
#pragma unroll
            for (int c = 0; c < 8; ++c) { const uint4 r = kp[c]; const unsigned w[4] = {r.x, r.y, r.z, r.w};
#pragma unroll
                for (int j = 0; j < 4; ++j) { kk[c * 8 + 2 * j] = __uint_as_float(w[j] << 16); kk[c * 8 + 2 * j + 1] = __uint_as_float(w[j] & 0xffff0000u); } }
            float score = 0.f;
            for (int h = 0; h < 16; ++h) { float d = 0.f;
#pragma unroll
                for (int j = 0; j < 64; ++j) d = fmaf(iq[h * 64 + j], kk[j], d);
                score += fmaxf(d, 0.f) * iw[h]; }
            sc[s] = score;
        }
        __syncthreads();
        if (t + 1 <= 256) { for (int s = tid; s <= t; s += 512) atomicOr((unsigned*)&mw[s >> 5], 1u << (s & 31)); }
        else {
            unsigned myk[4];
#pragma unroll
            for (int j = 0; j < 4; ++j) { const int s = tid + 512 * j; myk[j] = (s <= t) ? fkey(sc[s]) : 0u; }
            unsigned prefix = 0u;
            for (int bit = 31; bit >= 0; --bit) {
                const unsigned cand = prefix | (1u << bit); unsigned c = 0;
#pragma unroll
                for (int j = 0; j < 4; ++j) c += (myk[j] >= cand) ? 1u : 0u;
                if (tid == 0) *cnt = 0u;
                __syncthreads(); if (c) atomicAdd((unsigned*)cnt, c); __syncthreads();
                const unsigned total = *cnt; __syncthreads();
                if (total >= 256u) prefix = cand;
            }
            unsigned cg = 0, ce = 0;
#pragma unroll
            for (int j = 0; j < 4; ++j) { cg += (myk[j] > prefix) ? 1u : 0u; ce += (myk[j] == prefix) ? 1u : 0u; }
            if (tid == 0) *cnt = 0u;
            __syncthreads(); atomicAdd((unsigned*)cnt, cg | (ce << 16)); __syncthreads();
            const unsigned tot = *cnt; const int n_gt = (int)(tot & 0xffffu), n_eq = (int)(tot >> 16); const int need = 256 - n_gt;
#pragma unroll
            for (int j = 0; j < 4; ++j) { const int s = tid + 512 * j; if (myk[j] > prefix || (myk[j] == prefix && n_eq == need)) atomicOr((unsigned*)&mw[s >> 5], 1u << (s & 31)); }
            if (n_eq != need && tid == 0) { int left = need; for (int s = 0; s <= t && left > 0; ++s) if (fkey(sc[s]) == prefix) { atomicOr((unsigned*)&mw[s >> 5], 1u << (s & 31)); --left; } }
        }
        __syncthreads();
        if (tid < 64) F.mask[(size_t)row * 64 + tid] = mw[tid];
        __syncthreads();
    }
}

template <int MODE> __device__ __forceinline__ void naive_attn(Frame& F, int ldp, int koff, int voff, int kvhs) {
    PHASE_IDS();
    bf16* P = F.P; const int wv = wave;
    LAS int* keys = (LAS int*)F.lds; LAS float* qs = (LAS float*)(keys + 400); LAS float* sc = qs + 2048; LAS float* linv = sc + 16 * 400; LAS int* pre = (LAS int*)(linv + 16); LAS int* nk_s = pre + 64;
    for (int row = blockIdx.x; row < MTOK; row += F.G) {
        const int t = row & (SEQ - 1), rb = row - t;
        for (int i = tid; i < 2048; i += 512) qs[i] = bf2f(P[(size_t)row * ldp + i]);
        if (MODE == 0) {
            unsigned w = 0; if (tid < 64) { w = F.mask[(size_t)row * 64 + tid]; pre[tid] = __popc(w); }
            __syncthreads();
            if (tid == 0) { int run = 0; for (int i = 0; i < 64; ++i) { const int x = pre[i]; pre[i] = run; run += x; } *nk_s = run; }
            __syncthreads();
            if (tid < 64) { int pos = pre[tid]; while (w) { const int b = __ffs(w) - 1; keys[pos++] = tid * 32 + b; w &= w - 1; } }
        } else {
            if (tid < 387) { const int cfg = tid / 129, j = tid % 129, dil = cfg == 0 ? 1 : (cfg == 1 ? 4 : 16); const int s = t - j * dil; keys[tid] = s >= 0 ? s : -1; }
            if (tid == 0) *nk_s = 387;
        }
        __syncthreads();
        const int nk = *nk_s;
        if (tid < nk) {
            const int e = tid, s = keys[e];
#pragma unroll 1
            for (int h = 0; h < 16; ++h) {
                float d = -__builtin_inff();
                if (s >= 0) { const uint4* kp = (const uint4*)(P + (size_t)(rb + s) * ldp + koff + h * kvhs); d = 0.f;
#pragma unroll
                    for (int c = 0; c < 16; ++c) { const uint4 r = kp[c]; const unsigned w[4] = {r.x, r.y, r.z, r.w}; const LAS float* qp = qs + h * 128 + c * 8;
#pragma unroll
                        for (int j = 0; j < 4; ++j) { d = fmaf(qp[2 * j], __uint_as_float(w[j] << 16), d); d = fmaf(qp[2 * j + 1], __uint_as_float(w[j] & 0xffff0000u), d); } }
                    d *= QK_SCALE; }
                sc[h * 400 + e] = d;
            }
        }
        __syncthreads();
        for (int hh = 0; hh < 2; ++hh) { const int h = wv * 2 + hh; float m = -__builtin_inff();
            for (int e = lane; e < nk; e += 64) m = fmaxf(m, sc[h * 400 + e]);
            m = wave_max(m); float sum = 0.f;
            for (int e = lane; e < nk; e += 64) { const float p = __expf(sc[h * 400 + e] - m); sc[h * 400 + e] = p; sum += p; }
            sum = wave_sum(sum); if (lane == 0) linv[h] = 1.f / sum; }
        __syncthreads();
        const int d = tid & 127, hg = tid >> 7; float acc[4] = {0.f, 0.f, 0.f, 0.f};
        for (int e = 0; e < nk; ++e) { const int s = keys[e]; if (s < 0) continue; const bf16* vp = P + (size_t)(rb + s) * ldp + voff + d;
#pragma unroll
            for (int j = 0; j < 4; ++j) { const int h = hg * 4 + j; acc[j] = fmaf(sc[h * 400 + e], bf2f(vp[h * kvhs]), acc[j]); } }
#pragma unroll
        for (int j = 0; j < 4; ++j) { const int h = hg * 4 + j; P[(size_t)row * ldp + h * 128 + d] = f2bf(acc[j] * linv[h]); }
        __syncthreads();
    }
}

__device__ __forceinline__ void naive_ret(Frame& F) {
    if (blockIdx.x >= 32) return;
    bf16* P = F.P; constexpr int ldp = n1pad(2);
    int tid_o_ = threadIdx.x; asm volatile("" : "+v"(tid_o_));
    const int grp = tid_o_ >> 8, tid = tid_o_ & 255, lane = tid & 63, wv = tid >> 6, item = blockIdx.x * 2 + grp, bl = item >> 3, h = item & 7;
    const float gamma = 1.f - exp2f(-5.f - (float)h);
    LAS float* base = (LAS float*)(F.lds + grp * 40960);
    LAS float* qs = base; LAS float* ks = qs + 16 * 128; LAS float* ob = ks + 16 * 128; LAS float* sq = ob + 16 * 256;
    float S[128];
#pragma unroll
    for (int i = 0; i < 128; ++i) S[i] = 0.f;
    for (int t0 = 0; t0 < SEQ; t0 += 16) {
        const size_t row0 = (size_t)bl * SEQ + t0;
        for (int i = tid; i < 16 * 128; i += 256) { const int tt = i >> 7, c = i & 127; const bf16* pr = P + (row0 + tt) * ldp + h * 128 + c; qs[i] = bf2f(pr[0]); ks[i] = bf2f(pr[1024]); }
        __syncthreads();
#pragma unroll 1
        for (int tt = 0; tt < 16; ++tt) {
            const float v = bf2f(P[(row0 + tt) * ldp + 2048 + h * 256 + tid]); float o = 0.f;
#pragma unroll
            for (int i = 0; i < 128; i += 4) { const pg8::f32x4 k4 = *(const LAS pg8::f32x4*)&ks[tt * 128 + i], q4 = *(const LAS pg8::f32x4*)&qs[tt * 128 + i];
                S[i] = fmaf(gamma, S[i], k4.x * v); o = fmaf(q4.x, S[i], o); S[i + 1] = fmaf(gamma, S[i + 1], k4.y * v); o = fmaf(q4.y, S[i + 1], o);
                S[i + 2] = fmaf(gamma, S[i + 2], k4.z * v); o = fmaf(q4.z, S[i + 2], o); S[i + 3] = fmaf(gamma, S[i + 3], k4.w * v); o = fmaf(q4.w, S[i + 3], o); }
            ob[tt * 256 + tid] = o;
        }
        __syncthreads();
        for (int j = 0; j < 4; ++j) { const int tt = wv * 4 + j; float s = 0.f; for (int c = lane; c < 256; c += 64) s += ob[tt * 256 + c] * ob[tt * 256 + c]; s = wave_sum(s);
            if (lane < 8) F.ssq[((row0 + tt) * 8 + h) * 8 + lane] = lane == 0 ? s : 0.f; }
        for (int tt = 0; tt < 16; ++tt) P[(row0 + tt) * ldp + 2048 + h * 256 + tid] = f2bf(ob[tt * 256 + tid]);
        __syncthreads();
    }
}

__device__ __forceinline__ void naive_hgrn(Frame& F) {
    if (blockIdx.x >= 32) return;
    bf16* P = F.P; constexpr int ldp = n1pad(3);
    int tid_o_ = threadIdx.x; asm volatile("" : "+v"(tid_o_));
    const int grp = tid_o_ >> 7, tid = tid_o_ & 127, lane = tid & 63, wv = tid >> 6, item = blockIdx.x * 4 + grp, bl = item >> 4, h = item & 15;
    LAS float* base = (LAS float*)(F.lds + grp * 28672);
    LAS float* qs = base; LAS float* gs = qs + 16 * 128; LAS float* ob = gs + 16 * 128;
    float S[128];
#pragma unroll
    for (int i = 0; i < 128; ++i) S[i] = 0.f;
    for (int t0 = 0; t0 < SEQ; t0 += 16) {
        const size_t row0 = (size_t)bl * SEQ + t0;
        for (int tt = 0; tt < 16; ++tt) { const bf16* pr = P + (row0 + tt) * ldp + h * 128 + tid;
            qs[tt * 128 + tid] = bf2f(pr[0]); gs[tt * 128 + tid] = __expf(bf2f(pr[2048])); }
        __syncthreads();
#pragma unroll 1
        for (int tt = 0; tt < 16; ++tt) {
            const float v = bf2f(P[(row0 + tt) * ldp + 4096 + h * 128 + tid]); float o = 0.f;
#pragma unroll
            for (int i = 0; i < 128; i += 4) { const pg8::f32x4 g4 = *(const LAS pg8::f32x4*)&gs[tt * 128 + i], q4 = *(const LAS pg8::f32x4*)&qs[tt * 128 + i];
                S[i] = fmaf(g4.x, S[i] - v, v); o = fmaf(q4.x, S[i], o); S[i + 1] = fmaf(g4.y, S[i + 1] - v, v); o = fmaf(q4.y, S[i + 1], o);
                S[i + 2] = fmaf(g4.z, S[i + 2] - v, v); o = fmaf(q4.z, S[i + 2], o); S[i + 3] = fmaf(g4.w, S[i + 3] - v, v); o = fmaf(q4.w, S[i + 3], o); }
            ob[tt * 128 + tid] = o;
        }
        __syncthreads();
        for (int j = 0; j < 8; ++j) { const int tt = wv * 8 + j; float s = ob[tt * 128 + lane] * ob[tt * 128 + lane] + ob[tt * 128 + lane + 64] * ob[tt * 128 + lane + 64]; s = wave_sum(s);
            if (lane < 4) F.ssq[((row0 + tt) * 16 + h) * 4 + lane] = lane == 0 ? s : 0.f; }
        for (int tt = 0; tt < 16; ++tt) P[(row0 + tt) * ldp + 4096 + h * 128 + tid] = f2bf(ob[tt * 128 + tid]);
        __syncthreads();
    }
}

typedef short ix_bf16x8 __attribute__((ext_vector_type(8)));
typedef float ix_f32x16 __attribute__((ext_vector_type(16)));
__device__ __forceinline__ int half_sum(int v, int hi) {
    v = half_sum_i(v);
    const int lo = __builtin_amdgcn_readlane(v, 31), up = __builtin_amdgcn_readlane(v, 63);
    return hi ? up : lo;
}
__device__ __forceinline__ void index_topk_phase(Frame& F) {
    PHASE_IDS();
    const bf16* P = F.P; constexpr int ldp = n1pad(0), ROWB = 144, BUFB = 256 * ROWB;
    const int c = lane & 31, hi = lane >> 5;
#pragma unroll 1
    for (int uu = 0; uu < 4; ++uu) {
        const int unit = (uu & 1) ? (1023 - (uu >> 1) * 256 - (int)blockIdx.x) : ((uu >> 1) * 256 + (int)blockIdx.x);
        const int row0 = unit * 16, rb = row0 & ~(SEQ - 1), tu = row0 & (SEQ - 1);
        const int t0 = tu + 2 * wave, tq = t0 + hi;
        const int nchunk = (tu + 15) / 256 + 1, jmax = (t0 + 1) >> 5;
        ix_bf16x8 afr[4];
        { const bf16* ap = P + (size_t)(row0 + 2 * wave + (c >> 4)) * ldp + A_IQ + (c & 15) * 64 + 8 * hi;
#pragma unroll
          for (int s = 0; s < 4; ++s) afr[s] = *(const ix_bf16x8*)(ap + 16 * s); }
        float w0[8], w1[8];
        { const bf16* wp = P + (size_t)(row0 + 2 * wave) * ldp + A_IW;
#pragma unroll
          for (int j = 0; j < 8; ++j) { const int hd = (j & 3) + 8 * (j >> 2) + 4 * hi; w0[j] = bf2f(wp[hd]) * (1.f / 32.f); w1[j] = bf2f(wp[ldp + hd]) * (1.f / 32.f); } }
        unsigned uk[64];
#pragma unroll
        for (int j = 0; j < 64; ++j) uk[j] = 0u;
        pg8::u32x4 st[4];
        { const bf16* gp = P + (size_t)rb * ldp + A_IK;
#pragma unroll
          for (int i = 0; i < 4; ++i) { const int p = tid + 512 * i; st[i] = *(const pg8::u32x4*)(gp + (size_t)(p >> 3) * ldp + (p & 7) * 8); }
#pragma unroll
          for (int i = 0; i < 4; ++i) { const int p = tid + 512 * i; *(LAS pg8::u32x4*)(F.lds + (p >> 3) * ROWB + (p & 7) * 16) = st[i]; } }
        __syncthreads();
#pragma unroll
        for (int ch = 0; ch < 8; ++ch) {
            if (ch < nchunk) {
                const bool more = ch + 1 < nchunk;
                if (more) { const bf16* gp = P + (size_t)(rb + 256 * (ch + 1)) * ldp + A_IK;
#pragma unroll
                    for (int i = 0; i < 4; ++i) { const int p = tid + 512 * i; st[i] = *(const pg8::u32x4*)(gp + (size_t)(p >> 3) * ldp + (p & 7) * 8); } }
                const LAS unsigned char* buf = F.lds + (ch & 1) * BUFB + c * ROWB + 16 * hi;
#define IX_TILE(JJ, ACC) do { _Pragma("unroll") for (int s = 0; s < 4; ++s) { const ix_bf16x8 bfr = *(const LAS ix_bf16x8*)(buf + (JJ) * 32 * ROWB + 32 * s); ACC = __builtin_amdgcn_mfma_f32_32x32x16_bf16(afr[s], bfr, ACC, 0, 0, 0); } } while (0)
#define IX_SCORE(J, ACC) do { float s0 = 0.f, s1 = 0.f; \
        _Pragma("unroll") for (int x = 0; x < 8; x += 2) { s0 = fmaf(fmaxf(ACC[x], 0.f), w0[x], s0); s1 = fmaf(fmaxf(ACC[8 + x], 0.f), w1[x], s1); } \
        float s0b = 0.f, s1b = 0.f; \
        _Pragma("unroll") for (int x = 1; x < 8; x += 2) { s0b = fmaf(fmaxf(ACC[x], 0.f), w0[x], s0b); s1b = fmaf(fmaxf(ACC[8 + x], 0.f), w1[x], s1b); } \
        s0 += s0b; s1 += s1b; \
        const auto rr = __builtin_amdgcn_permlane32_swap(__float_as_uint(s0), __float_as_uint(s1), false, false); \
        const float tot = __uint_as_float(rr[0]) + __uint_as_float(rr[1]);           \
        uk[J] = (32 * (J) + c <= tq) ? fkey(tot) : 0u; } while (0)
#pragma unroll
                for (int jj = 0; jj < 8; jj += 2) {
                    const int j = 8 * ch + jj;
                    if (j + 1 <= jmax) { ix_f32x16 acc0 = {}, acc1 = {}; IX_TILE(jj, acc0); IX_TILE(jj + 1, acc1); IX_SCORE(j, acc0); IX_SCORE(j + 1, acc1); }
                    else if (j <= jmax) { ix_f32x16 acc0 = {}; IX_TILE(jj, acc0); IX_SCORE(j, acc0); }
                }
#undef IX_TILE
#undef IX_SCORE
                if (more) {
#pragma unroll
                    for (int i = 0; i < 4; ++i) { const int p = tid + 512 * i; *(LAS pg8::u32x4*)(F.lds + ((ch + 1) & 1) * BUFB + (p >> 3) * ROWB + (p & 7) * 16) = st[i]; } }
                __syncthreads();
            }
        }
        unsigned thr = 0u;
        if (t0 >= 256) {
            bool done = false;
#pragma unroll 1
            for (int bit = 31; bit >= 0; --bit) {
                const unsigned cand = thr | (1u << bit); int cnt = 0;
#pragma unroll
                for (int g = 0; g < 8; ++g) if (8 * g <= jmax) {
#pragma unroll
                    for (int x = 0; x < 8; ++x) cnt += (uk[8 * g + x] >= cand) ? 1 : 0; }
                cnt = half_sum_i(cnt);
                const int lo = __builtin_amdgcn_readlane(cnt, 31), up = __builtin_amdgcn_readlane(cnt, 63);
                const int tot = hi ? up : lo;
                if (!done && tot >= 256) thr = cand;
                if (tot == 256) done = true;
                const bool dlo = __builtin_amdgcn_readlane(done ? 1 : 0, 0) != 0, dup = __builtin_amdgcn_readlane(done ? 1 : 0, 32) != 0;
                if (dlo && dup) break;
            }
        }
        int ngt = 0, neq = 0;
#pragma unroll
        for (int j = 0; j < 64; ++j) { ngt += (uk[j] > thr) ? 1 : 0; neq += (uk[j] == thr) ? 1 : 0; }
        ngt = half_sum(ngt, hi); neq = half_sum(neq, hi);
        const int need = 256 - ngt; const bool ties = (thr != 0u) && (neq != need);
        unsigned long long okm = ~0ull;
        if (__any(ties)) { okm = 0ull; int run = 0;
#pragma unroll
            for (int j = 0; j < 64; ++j) { const unsigned long long m = __ballot(uk[j] == thr); const unsigned mh = hi ? (unsigned)(m >> 32) : (unsigned)m;
                const int below = __popc(mh & ((1u << c) - 1u)); if (!ties || run + below < need) okm |= 1ull << j; run += __popc(mh); } }
        unsigned mw0 = 0u, mw1 = 0u;
#pragma unroll
        for (int j = 0; j < 64; ++j) { const bool sel = (uk[j] > thr) || (thr != 0u && uk[j] == thr && ((okm >> j) & 1ull));
            const unsigned long long m = __ballot(sel);
            mw0 = (lane == j) ? (unsigned)m : mw0; mw1 = (lane == j) ? (unsigned)(m >> 32) : mw1; }
        unsigned* mp = F.mask + (size_t)(row0 + 2 * wave) * 64 + lane;
        mp[0] = mw0; mp[64] = mw1;
    }
}

struct AttItem { int bh, qb0, qb1; };
__device__ __forceinline__ AttItem att_decode(int Lc, int Gq  ) {
    AttItem it; const int xcd = Lc & 7, k = Lc >> 3, per = Gq * 4, gi = k / per, r = k - gi * per;
    it.bh = (gi * 8 + xcd) * Gq + r / 4; const int x = r & 3; it.qb0 = x; it.qb1 = 7 - x; return it;
}
template <int L> __device__ __forceinline__ att::BlockRef<bf16, bf16> att_ref(const AttItem& it, int pass, bf16* P, const unsigned* mask) {
    constexpr int LDP = n1pad(L), KOFF = (L == 0) ? A_K : 2048, VOFF = (L == 0) ? A_V : 4096, KVHS = (L == 0) ? 0 : 128;
    const int qb = pass ? it.qb1 : it.qb0, b = it.bh >> 4, h = it.bh & 15;
    att::BlockRef<bf16, bf16> r;
    r.Q = P + (size_t)(b * SEQ + qb * 256) * LDP + h * 128; r.O = P + (size_t)(b * SEQ + qb * 256) * LDP + h * 128;
    r.K = P + (size_t)(b * SEQ) * LDP + KOFF + h * KVHS; r.V = P + (size_t)(b * SEQ) * LDP + VOFF + h * KVHS;
    r.M = mask + (size_t)(b * SEQ + qb * 256) * 64; r.P0 = qb * 256;
    return r;
}
template <int L> __device__ __forceinline__ void attn_phase(bf16* P, const unsigned* mask, char* lds, int G) {
    constexpr int LDP = n1pad(L), MK = (L == 0) ? 0 : 1, GQ = (L == 0) ? 16 : 1, TOTAL = 512, W = 1 << 28;
    int Lc = blockIdx.x; if (Lc >= TOTAL) return;
    AttItem it = att_decode(Lc, GQ); int pass = 0;
    att::BlockRef<bf16, bf16> cur = att_ref<L>(it, 0, P, mask);
    att::Seam<bf16> S;
    att::causal_swa_prime<bf16, bf16, LDP, LDP, MK>(cur, W, lds, S);
    for (;;) {
        const bool more_pass = pass == 0, more_item = Lc + G < TOTAL, last = !more_pass && !more_item;
        AttItem itn = it; int passn = pass + 1, Ln = Lc;
        if (!more_pass) { passn = 0; Ln = more_item ? Lc + G : Lc; itn = att_decode(Ln, GQ); }
        const att::BlockRef<bf16, bf16> nxt = last ? cur : att_ref<L>(itn, passn, P, mask);
        att::causal_swa_block<bf16, bf16, LDP, LDP, MK>(cur, nxt, SEQ, W, lds, S);
        if (last) break;
        cur = nxt; it = itn; pass = passn; Lc = Ln;
    }
}

namespace ret {
typedef short bf16x8 __attribute__((ext_vector_type(8)));
typedef short s16x4 __attribute__((ext_vector_type(4)));
typedef float f32x16 __attribute__((ext_vector_type(16)));
__device__ __forceinline__ unsigned off_b(unsigned row, unsigned ch) { return 256u * row + 16u * (ch ^ (((row & 3) << 2) | ((row >> 2) & 3))); }
__device__ __forceinline__ unsigned img_off(unsigned row, unsigned ch) { return 8192u * (row >> 5) + off_b(row & 31, ch); }
__device__ __forceinline__ unsigned addr_row(unsigned lane, unsigned rblk, unsigned s) { return 8192u * rblk + off_b(lane & 31, 2 * s + (lane >> 5)); }
__device__ __forceinline__ unsigned addr_tr(unsigned lane, unsigned row4, unsigned c) {
    const unsigned blk = (lane >> 4) & 1, q = (lane & 15) >> 2, p = lane & 3;
    return img_off(row4 + q, 4 * c + 2 * blk + (p >> 1)) + 8 * (p & 1);
}
__device__ __forceinline__ s16x4 tr_read(unsigned a) { s16x4 r; asm volatile("ds_read_b64_tr_b16 %0, %1" : "=&v"(r) : "v"(a) : "memory"); return r; }
__device__ __forceinline__ bf16x8 cat8(s16x4 lo, s16x4 hi) { return (bf16x8){lo[0], lo[1], lo[2], lo[3], hi[0], hi[1], hi[2], hi[3]}; }
typedef float f32x2_t __attribute__((ext_vector_type(2)));
typedef __bf16 bf16x2_t __attribute__((ext_vector_type(2)));
__device__ __forceinline__ unsigned cvtpk(float lo, float hi) { const f32x2_t v = {lo, hi}; const bf16x2_t b = __builtin_convertvector(v, bf16x2_t); return __builtin_bit_cast(unsigned, b); }
__device__ __forceinline__ bf16x8 pack_acc8(const f32x16& a, int s) {
    pg8::u32x4 w = {cvtpk(a[8 * s + 0], a[8 * s + 1]), cvtpk(a[8 * s + 2], a[8 * s + 3]), cvtpk(a[8 * s + 4], a[8 * s + 5]), cvtpk(a[8 * s + 6], a[8 * s + 7])};
    return *reinterpret_cast<bf16x8*>(&w);
}
__device__ __forceinline__ void epi_tile_store(const f32x16& o, LAS unsigned char* stg, bf16* gtile, size_t ldp, float* ssq0, size_t ssq_stride, int lane) {
    const int c = lane & 31, hi = lane >> 5;
#pragma unroll
    for (int r = 0; r < 16; r += 2) { const int il = (r & 3) + 8 * (r >> 2) + 4 * hi; const unsigned w = cvtpk(o[r], o[r + 1]);
        *(LAS bf16*)(stg + il * 80 + 2 * c) = (bf16)(w & 0xffffu); *(LAS bf16*)(stg + (il + 1) * 80 + 2 * c) = (bf16)(w >> 16); }
    asm volatile("s_waitcnt lgkmcnt(0)" ::: "memory");
    const int row = lane >> 1, half = lane & 1;
    const pg8::u32x4 v0 = *(const LAS pg8::u32x4*)(stg + row * 80 + half * 32), v1 = *(const LAS pg8::u32x4*)(stg + row * 80 + half * 32 + 16);
    const unsigned w[8] = {v0.x, v0.y, v0.z, v0.w, v1.x, v1.y, v1.z, v1.w}; float q = 0.f;
#pragma unroll
    for (int j = 0; j < 8; ++j) { const float a = __uint_as_float(w[j] << 16), b = __uint_as_float(w[j] & 0xffff0000u); q = fmaf(a, a, q); q = fmaf(b, b, q); }
    q += lane_xor1(q);
    bf16* gp = gtile + (size_t)row * ldp + half * 16;
    *(pg8::u32x4*)gp = v0; *(pg8::u32x4*)(gp + 8) = v1;
    if (half == 0) ssq0[(size_t)row * ssq_stride] = q;
    asm volatile("s_waitcnt lgkmcnt(0)" ::: "memory");
}
#define RET_LGKM0() do { asm volatile("s_waitcnt lgkmcnt(0)" ::: "memory"); __builtin_amdgcn_sched_barrier(0); } while (0)
constexpr int OFF_Q = 0, OFF_K = 32768, OFF_V = 65536, OFF_S = 98304;
}

__device__ __forceinline__ void ret_phase(Frame& F) {
    using namespace ret;
    PHASE_IDS();
    bf16* P = F.P; constexpr int ldp = n1pad(2);
    const int xcd = blockIdx.x & 7, kk = blockIdx.x >> 3, bh = xcd * 8 + (kk >> 2), dvq = kk & 3, b = bh >> 3, h = bh & 7;
    const int ib = (wave < 4) ? wave : 7 - wave, dh = wave >> 2;
    const int dkb = wave & 3, dvb = wave >> 2;
    const int c = lane & 31, hi = lane >> 5;
    const float lg = ret_lg(h);
    const float g128 = __builtin_amdgcn_exp2f(128.f * lg), g127 = __builtin_amdgcn_exp2f(127.f * lg), g1 = __builtin_amdgcn_exp2f(lg);
    const unsigned lbase = (unsigned)(size_t)F.lds_gen;
    const size_t rowg0 = (size_t)b * SEQ;
    const bf16* qg = P + rowg0 * ldp + h * 128; const bf16* vg = P + rowg0 * ldp + 2048 + h * 256 + dvq * 64;
    for (int i = tid; i < 32768 / 16; i += 512) *(LAS pg8::u32x4*)(F.lds + OFF_S + i * 16) = (pg8::u32x4){0u, 0u, 0u, 0u};
    f32x16 st = {};
    pg8::u32x4 rq[4], rk[4], rv[2];
#define RET_LOAD(n) do { const size_t r0_ = (size_t)(n) * 128; \
        _Pragma("unroll") for (int i = 0; i < 4; ++i) { const int p = tid + 512 * i; const bf16* g_ = qg + (r0_ + (p >> 4)) * ldp + (p & 15) * 8; rq[i] = *(const pg8::u32x4*)g_; rk[i] = *(const pg8::u32x4*)(g_ + 1024); } \
        _Pragma("unroll") for (int i = 0; i < 2; ++i) { const int p = tid + 512 * i; rv[i] = *(const pg8::u32x4*)(vg + (r0_ + (p >> 3)) * ldp + (p & 7) * 8); } } while (0)
#define RET_WRITE() do { \
        _Pragma("unroll") for (int i = 0; i < 4; ++i) { const int p = tid + 512 * i; const unsigned o_ = img_off(p >> 4, p & 15); *(LAS pg8::u32x4*)(F.lds + OFF_Q + o_) = rq[i]; *(LAS pg8::u32x4*)(F.lds + OFF_K + o_) = rk[i]; } \
        _Pragma("unroll") for (int i = 0; i < 2; ++i) { const int p = tid + 512 * i; *(LAS pg8::u32x4*)(F.lds + OFF_V + img_off(p >> 3, p & 7)) = rv[i]; } } while (0)
    RET_LOAD(0); RET_WRITE();
    __syncthreads();
#pragma unroll 1
    for (int n = 0; n < 16; ++n) {
        if (n + 1 < 16) RET_LOAD(n + 1);
        f32x16 o = {};
#pragma unroll
        for (int sp = 0; sp < 2; ++sp) {
            s16x4 br[8]; bf16x8 a[4];
#pragma unroll
            for (int u = 0; u < 4; ++u) { const int s = 4 * sp + u; a[u] = *(const LAS bf16x8*)(F.lds + OFF_Q + addr_row(lane, ib, s));
                br[2 * u] = tr_read(lbase + OFF_S + addr_tr(lane, 16 * s + 8 * hi, dh)); br[2 * u + 1] = tr_read(lbase + OFF_S + addr_tr(lane, 16 * s + 8 * hi + 4, dh)); }
            RET_LGKM0();
#pragma unroll
            for (int u = 0; u < 4; ++u) o = __builtin_amdgcn_mfma_f32_32x32x16_bf16(a[u], cat8(br[2 * u], br[2 * u + 1]), o, 0, 0, 0);
        }
#pragma unroll
        for (int jb = 0; jb < 4; ++jb) {
            if (jb <= ib) {
                s16x4 vr[4];
#pragma unroll
                for (int s = 0; s < 2; ++s) { vr[2 * s] = tr_read(lbase + OFF_V + addr_tr(lane, 32 * jb + 16 * s + 4 * hi, dh)); vr[2 * s + 1] = tr_read(lbase + OFF_V + addr_tr(lane, 32 * jb + 16 * s + 8 + 4 * hi, dh)); }
                f32x16 sacc = {};
#pragma unroll
                for (int s = 0; s < 8; ++s) {
                    const bf16x8 a = *(const LAS bf16x8*)(F.lds + OFF_K + addr_row(lane, jb, s)), bq = *(const LAS bf16x8*)(F.lds + OFF_Q + addr_row(lane, ib, s));
                    sacc = __builtin_amdgcn_mfma_f32_32x32x16_bf16(a, bq, sacc, 0, 0, 0);
                }
                if (jb == ib) {
#pragma unroll
                    for (int r = 0; r < 16; ++r) { const int jl = (r & 3) + 8 * (r >> 2) + 4 * hi; if (jl > c) sacc[r] = 0.f; }
                }
                RET_LGKM0();
#pragma unroll
                for (int s = 0; s < 2; ++s) o = __builtin_amdgcn_mfma_f32_32x32x16_bf16(pack_acc8(sacc, s), cat8(vr[2 * s], vr[2 * s + 1]), o, 0, 0, 0);
            }
        }
        f32x16 xs = {};
#pragma unroll
        for (int sp = 0; sp < 4; ++sp) {
            s16x4 ar[4], br[4];
#pragma unroll
            for (int u = 0; u < 2; ++u) { const int s = 2 * sp + u;
                ar[2 * u] = tr_read(lbase + OFF_K + addr_tr(lane, 16 * s + 8 * hi, dkb)); ar[2 * u + 1] = tr_read(lbase + OFF_K + addr_tr(lane, 16 * s + 8 * hi + 4, dkb));
                br[2 * u] = tr_read(lbase + OFF_V + addr_tr(lane, 16 * s + 8 * hi, dvb)); br[2 * u + 1] = tr_read(lbase + OFF_V + addr_tr(lane, 16 * s + 8 * hi + 4, dvb)); }
            RET_LGKM0();
#pragma unroll
            for (int u = 0; u < 2; ++u) xs = __builtin_amdgcn_mfma_f32_32x32x16_bf16(cat8(ar[2 * u], ar[2 * u + 1]), cat8(br[2 * u], br[2 * u + 1]), xs, 0, 0, 0);
        }
#pragma unroll
        for (int r = 0; r < 16; ++r) st[r] = g128 * st[r] + g127 * xs[r];
        { const size_t rowb = rowg0 + (size_t)n * 128 + ib * 32;
          epi_tile_store(o, F.lds + STG_OFF + wave * 2560, P + rowb * ldp + 2048 + h * 256 + dvq * 64 + dh * 32, ldp, F.ssq + (rowb * 8 + h) * 8 + dvq * 2 + dh, 64, lane); }
        LDS_BARRIER();
#pragma unroll
        for (int r = 0; r < 16; r += 2) { const int dk = 32 * dkb + (r & 3) + 8 * (r >> 2) + 4 * hi, dv = 32 * dvb + c; const unsigned w = cvtpk(g1 * st[r], g1 * st[r + 1]);
            *(LAS bf16*)(F.lds + OFF_S + img_off(dk, dv >> 3) + (dv & 7) * 2) = (bf16)(w & 0xffffu); *(LAS bf16*)(F.lds + OFF_S + img_off(dk + 1, dv >> 3) + (dv & 7) * 2) = (bf16)(w >> 16); }
        if (n + 1 < 16) RET_WRITE();
        LDS_BARRIER();
    }
#undef RET_LOAD
#undef RET_WRITE
}

namespace hg {
constexpr int PITCH = 132;
constexpr int OFF_Q = 0, OFF_K = 16384, OFF_V = 32768, OFF_T0 = 49152, OFF_T1 = 81920, OFF_C = 114688;
}
__device__ __forceinline__ void hgrn_prep_phase(Frame& F) {
    PHASE_IDS();
    bf16* P = F.P; constexpr int ldp = n1pad(3);
    float* tab = (float*)F.mask;
    LAS float* Lt = (LAS float*)F.lds; LAS float* segt = Lt + 64 * hg::PITCH;
    const int tok = tid >> 3, c16 = tid & 7, ch = tid & 127, seg = tid >> 7;
#pragma unroll 1
    for (int i = 0; i < 16; ++i) {
        const int it = blockIdx.x + 256 * i, bh = it >> 5, n = it & 31;
        bf16* gp = P + ((size_t)(bh >> 4) * SEQ + n * 64 + tok) * ldp + (bh & 15) * 128 + c16 * 16;
        const pg8::u32x4 q0 = *(const pg8::u32x4*)gp, q1 = *(const pg8::u32x4*)(gp + 8), f0 = *(const pg8::u32x4*)(gp + 2048), f1 = *(const pg8::u32x4*)(gp + 2056);
        float lf[16];
        { const unsigned w[8] = {f0.x, f0.y, f0.z, f0.w, f1.x, f1.y, f1.z, f1.w};
#pragma unroll
          for (int j = 0; j < 8; ++j) { lf[2 * j] = __uint_as_float(w[j] << 16); lf[2 * j + 1] = __uint_as_float(w[j] & 0xffff0000u); } }
#pragma unroll
        for (int j = 0; j < 4; ++j) *(LAS pg8::f32x4*)(Lt + tok * hg::PITCH + c16 * 16 + 4 * j) = (pg8::f32x4){lf[4 * j], lf[4 * j + 1], lf[4 * j + 2], lf[4 * j + 3]};
        __syncthreads();
        float bl[16]; float run = 0.f;
#pragma unroll
        for (int t = 0; t < 16; ++t) { run += Lt[(seg * 16 + t) * hg::PITCH + ch]; bl[t] = run; }
        segt[seg * 128 + ch] = run;
        __syncthreads();
        { const float s0 = segt[ch], s1 = segt[128 + ch], s2 = segt[256 + ch], s3 = segt[384 + ch];
          const float pre = (seg == 0) ? 0.f : (seg == 1 ? s0 : (seg == 2 ? s0 + s1 : s0 + s1 + s2)), bref = s0 + s1;
          if (seg == 0) { tab[(size_t)it * 256 + ch] = bref; tab[(size_t)it * 256 + 128 + ch] = s2 + s3; }
#pragma unroll
          for (int t = 0; t < 16; ++t) Lt[(seg * 16 + t) * hg::PITCH + ch] = __expf(pre + bl[t] - bref); }
        __syncthreads();
        float e[16];
#pragma unroll
        for (int j = 0; j < 4; ++j) { const pg8::f32x4 v = *(const LAS pg8::f32x4*)(Lt + tok * hg::PITCH + c16 * 16 + 4 * j); e[4 * j] = v[0]; e[4 * j + 1] = v[1]; e[4 * j + 2] = v[2]; e[4 * j + 3] = v[3]; }
        float qv[16];
        { const unsigned w[8] = {q0.x, q0.y, q0.z, q0.w, q1.x, q1.y, q1.z, q1.w};
#pragma unroll
          for (int j = 0; j < 8; ++j) { qv[2 * j] = __uint_as_float(w[j] << 16); qv[2 * j + 1] = __uint_as_float(w[j] & 0xffff0000u); } }
        unsigned qo[8], ko[8];
#pragma unroll
        for (int j = 0; j < 8; ++j) {
            const float ea = e[2 * j], eb = e[2 * j + 1];
            qo[j] = pg8::cvt_pk_bf16(qv[2 * j] * ea, qv[2 * j + 1] * eb);
            ko[j] = pg8::cvt_pk_bf16((1.f - __expf(lf[2 * j])) * __builtin_amdgcn_rcpf(ea), (1.f - __expf(lf[2 * j + 1])) * __builtin_amdgcn_rcpf(eb));
        }
        *(pg8::u32x4*)gp = (pg8::u32x4){qo[0], qo[1], qo[2], qo[3]}; *(pg8::u32x4*)(gp + 8) = (pg8::u32x4){qo[4], qo[5], qo[6], qo[7]};
        *(pg8::u32x4*)(gp + 2048) = (pg8::u32x4){ko[0], ko[1], ko[2], ko[3]}; *(pg8::u32x4*)(gp + 2056) = (pg8::u32x4){ko[4], ko[5], ko[6], ko[7]};
        __syncthreads();
    }
}
__device__ __forceinline__ void hgrn_seq_phase(Frame& F) {
    using namespace ret;
    PHASE_IDS();
    bf16* P = F.P; constexpr int ldp = n1pad(3);
    const float* tab = (const float*)F.mask;
    const int xcd = blockIdx.x & 7, kk = blockIdx.x >> 3, bh = xcd * 16 + (kk >> 1), dvh = kk & 1, b = bh >> 4, h = bh & 15;
    const int c = lane & 31, hi = lane >> 5;
    const unsigned lbase = (unsigned)(size_t)F.lds_gen;
    const size_t rowg0 = (size_t)b * SEQ;
    const bf16* qg = P + rowg0 * ldp + h * 128; const bf16* vg = P + rowg0 * ldp + 4096 + h * 128 + dvh * 64;
    const float* tg = tab + (size_t)bh * 32 * 256;
    LAS float* ctab = (LAS float*)(F.lds + hg::OFF_C);
    for (int i = tid; i < 65536 / 16; i += 512) *(LAS pg8::u32x4*)(F.lds + hg::OFF_T0 + i * 16) = (pg8::u32x4){0u, 0u, 0u, 0u};
    f32x16 t0 = {}, t1 = {};
    pg8::u32x4 rq[2], rk[2], rv; pg8::f32x4 ru, rb;
#define HG_LOAD(n) do { const size_t r0_ = (size_t)(n) * 64; \
        _Pragma("unroll") for (int i = 0; i < 2; ++i) { const int p = tid + 512 * i; const bf16* g_ = qg + (r0_ + (p >> 4)) * ldp + (p & 15) * 8; rq[i] = *(const pg8::u32x4*)g_; rk[i] = *(const pg8::u32x4*)(g_ + 2048); } \
        rv = *(const pg8::u32x4*)(vg + (r0_ + (tid >> 3)) * ldp + (tid & 7) * 8); \
        if (tid < 32) { ru = *(const pg8::f32x4*)(tg + (size_t)(n) * 256 + 128 + 4 * tid); rb = ((n) + 1 < 32) ? *(const pg8::f32x4*)(tg + (size_t)((n) + 1) * 256 + 4 * tid) : (pg8::f32x4){0.f, 0.f, 0.f, 0.f}; } } while (0)
#define HG_WRITE() do { \
        _Pragma("unroll") for (int i = 0; i < 2; ++i) { const int p = tid + 512 * i; const unsigned o_ = img_off(p >> 4, p & 15); *(LAS pg8::u32x4*)(F.lds + hg::OFF_Q + o_) = rq[i]; *(LAS pg8::u32x4*)(F.lds + hg::OFF_K + o_) = rk[i]; } \
        *(LAS pg8::u32x4*)(F.lds + hg::OFF_V + img_off(tid >> 3, tid & 7)) = rv; \
        if (tid < 32) *(LAS pg8::f32x4*)(ctab + 4 * tid) = (pg8::f32x4){__expf(ru[0] + rb[0]), __expf(ru[1] + rb[1]), __expf(ru[2] + rb[2]), __expf(ru[3] + rb[3])}; } while (0)
    HG_LOAD(0); HG_WRITE();
    __syncthreads();
#pragma unroll 1
    for (int n = 0; n < 32; ++n) {
        if (n + 1 < 32) HG_LOAD(n + 1);
        const int tcur = (n & 1) ? hg::OFF_T1 : hg::OFF_T0, tnxt = (n & 1) ? hg::OFF_T0 : hg::OFF_T1;
        if (wave >= 4) {
            const int dkb = wave - 4;
#pragma unroll
            for (int sp = 0; sp < 2; ++sp) {
                s16x4 ar[4], br[4], dr[4];
#pragma unroll
                for (int u = 0; u < 2; ++u) { const int s = 2 * sp + u;
                    ar[2 * u] = tr_read(lbase + hg::OFF_K + addr_tr(lane, 16 * s + 8 * hi, dkb)); ar[2 * u + 1] = tr_read(lbase + hg::OFF_K + addr_tr(lane, 16 * s + 8 * hi + 4, dkb));
                    br[2 * u] = tr_read(lbase + hg::OFF_V + addr_tr(lane, 16 * s + 8 * hi, 0)); br[2 * u + 1] = tr_read(lbase + hg::OFF_V + addr_tr(lane, 16 * s + 8 * hi + 4, 0));
                    dr[2 * u] = tr_read(lbase + hg::OFF_V + addr_tr(lane, 16 * s + 8 * hi, 1)); dr[2 * u + 1] = tr_read(lbase + hg::OFF_V + addr_tr(lane, 16 * s + 8 * hi + 4, 1)); }
                RET_LGKM0();
#pragma unroll
                for (int u = 0; u < 2; ++u) { const bf16x8 a = cat8(ar[2 * u], ar[2 * u + 1]);
                    t0 = __builtin_amdgcn_mfma_f32_32x32x16_bf16(a, cat8(br[2 * u], br[2 * u + 1]), t0, 0, 0, 0);
                    t1 = __builtin_amdgcn_mfma_f32_32x32x16_bf16(a, cat8(dr[2 * u], dr[2 * u + 1]), t1, 0, 0, 0); }
            }
#pragma unroll
            for (int g = 0; g < 4; ++g) { const pg8::f32x4 cv = *(const LAS pg8::f32x4*)(ctab + 32 * dkb + 8 * g + 4 * hi);
#pragma unroll
                for (int x = 0; x < 4; ++x) { const int r = 4 * g + x; t0[r] *= cv[x]; t1[r] *= cv[x]; } }
#pragma unroll
            for (int r = 0; r < 16; r += 2) { const int dk = 32 * dkb + (r & 3) + 8 * (r >> 2) + 4 * hi;
                const unsigned w0 = cvtpk(t0[r], t0[r + 1]), w1 = cvtpk(t1[r], t1[r + 1]);
                *(LAS bf16*)(F.lds + tnxt + img_off(dk, c >> 3) + (c & 7) * 2) = (bf16)(w0 & 0xffffu); *(LAS bf16*)(F.lds + tnxt + img_off(dk + 1, c >> 3) + (c & 7) * 2) = (bf16)(w0 >> 16);
                *(LAS bf16*)(F.lds + tnxt + img_off(dk, (32 + c) >> 3) + (c & 7) * 2) = (bf16)(w1 & 0xffffu); *(LAS bf16*)(F.lds + tnxt + img_off(dk + 1, (32 + c) >> 3) + (c & 7) * 2) = (bf16)(w1 >> 16); }
        } else {
            const int tb = wave & 1, dvb = wave >> 1;
            f32x16 o = {};
#pragma unroll
            for (int sp = 0; sp < 2; ++sp) {
                s16x4 br[8]; bf16x8 a[4];
#pragma unroll
                for (int u = 0; u < 4; ++u) { const int s = 4 * sp + u; a[u] = *(const LAS bf16x8*)(F.lds + hg::OFF_Q + addr_row(lane, tb, s));
                    br[2 * u] = tr_read(lbase + tcur + addr_tr(lane, 16 * s + 8 * hi, dvb)); br[2 * u + 1] = tr_read(lbase + tcur + addr_tr(lane, 16 * s + 8 * hi + 4, dvb)); }
                RET_LGKM0();
#pragma unroll
                for (int u = 0; u < 4; ++u) o = __builtin_amdgcn_mfma_f32_32x32x16_bf16(a[u], cat8(br[2 * u], br[2 * u + 1]), o, 0, 0, 0);
            }
#pragma unroll
            for (int sb = 0; sb < 2; ++sb) {
                if (sb <= tb) {
                    f32x16 sacc = {};
                    s16x4 vr[4];
#pragma unroll
                    for (int s = 0; s < 2; ++s) { vr[2 * s] = tr_read(lbase + hg::OFF_V + addr_tr(lane, 32 * sb + 16 * s + 4 * hi, dvb)); vr[2 * s + 1] = tr_read(lbase + hg::OFF_V + addr_tr(lane, 32 * sb + 16 * s + 8 + 4 * hi, dvb)); }
#pragma unroll
                    for (int s = 0; s < 8; ++s) {
                        const bf16x8 a = *(const LAS bf16x8*)(F.lds + hg::OFF_K + addr_row(lane, sb, s)), bq = *(const LAS bf16x8*)(F.lds + hg::OFF_Q + addr_row(lane, tb, s));
                        sacc = __builtin_amdgcn_mfma_f32_32x32x16_bf16(a, bq, sacc, 0, 0, 0);
                    }
                    if (sb == tb) {
#pragma unroll
                        for (int r = 0; r < 16; ++r) { const int sl = (r & 3) + 8 * (r >> 2) + 4 * hi; if (sl > c) sacc[r] = 0.f; }
                    }
                    RET_LGKM0();
#pragma unroll
                    for (int s = 0; s < 2; ++s) o = __builtin_amdgcn_mfma_f32_32x32x16_bf16(pack_acc8(sacc, s), cat8(vr[2 * s], vr[2 * s + 1]), o, 0, 0, 0);
                }
            }
            const size_t rowb = rowg0 + (size_t)n * 64 + tb * 32;
            epi_tile_store(o, F.lds + 116736 + wave * 2560, P + rowb * ldp + 4096 + h * 128 + dvh * 64 + dvb * 32, ldp, F.ssq + (rowb * 16 + h) * 4 + dvh * 2 + dvb, 64, lane);
        }
        LDS_BARRIER();
        if (n + 1 < 32) HG_WRITE();
        LDS_BARRIER();
    }
#undef HG_LOAD
#undef HG_WRITE
}

struct Args { const float* in[12]; float* out; unsigned char* ws; };
template <int L> __device__ __forceinline__ void mixer_phase(Frame& F, const XcdBarrier& bar) {
    if (L == 0) { index_topk_phase(F); xcd_barrier(bar); attn_phase<0>(F.P, F.mask, (char*)F.lds_gen, F.G); }
    if (L == 1) attn_phase<1>(F.P, F.mask, (char*)F.lds_gen, F.G);
    if (L == 2) ret_phase(F);
    if (L == 3) hgrn_seq_phase(F);
}
template <int L> __device__ __forceinline__ void layer_phases(Frame& F, const XcdBarrier& bar) {
    constexpr int N1 = n1pad(L);
    {
        pg8::Gemm g{F.U, F.WIN, MTOK, N1, D_MODEL, D_MODEL}; pg8::StaticOrder S; S.init(MTOK, N1, F.G, (int)blockIdx.x);
        EpiProj<L> E{F.P, N1, F.cos128, F.sin128, F.cos64, F.sin64, F.lb, (float*)F.mask};
        pg8::gemm_phase<EpiProj<L>, pg8::StaticOrder, true, true>(F.lds, g, S, E);
    }
    xcd_barrier(bar);
    mixer_phase<L>(F, bar);
    xcd_barrier(bar);
    {
        pg8::Gemm g{F.U, F.WIN + (size_t)N1 * D_MODEL, MTOK, D_INNER, D_MODEL, D_MODEL}; pg8::StaticOrder S; S.init(MTOK, D_INNER, F.G, (int)blockIdx.x);
        EpiGate<L> E{F.P + ocol(L), N1, F.ssq};
        pg8::gemm_phase<EpiGate<L>, pg8::StaticOrder, true, true>(F.lds, g, S, E);
    }
    xcd_barrier(bar);
    {
        pg8::Gemm g{F.P + ocol(L), F.WOUT, MTOK, D_MODEL, D_INNER, N1}; pg8::StaticOrder S; S.init(MTOK, D_MODEL, F.G, (int)blockIdx.x);
        EpiAddF32 E{F.H, D_MODEL, (L == 0) ? F.x : F.H};
        pg8::gemm_phase<EpiAddF32, pg8::StaticOrder, true, true>(F.lds, g, S, E);
    }
    xcd_barrier(bar);
    if (L < 3) { norm_rows(F, F.H, F.norm_g + (L + 1) * D_MODEL, nullptr); conv_weights<(L < 3 ? L + 1 : 3)>(F); xcd_barrier(bar); }
    else final_rows(F);
}
__global__ void __launch_bounds__(NWAVES * 64, 2) mega_fwd(Args args) {
    extern __shared__ __attribute__((aligned(16))) unsigned char lds_raw[];
    Frame F;
    F.lds = (LAS unsigned char*)lds_raw; F.lds_gen = lds_raw; F.MISC = (volatile LAS unsigned*)(F.lds + MISC_OFF);
    F.G = gridDim.x;
    unsigned char* ws = args.ws;
    F.ctl = (unsigned*)(ws + WS_CTL);
    F.x = args.in[0]; F.norm_g = args.in[1]; F.final_g = args.in[2];
    F.w_in[0] = args.in[3]; F.w_out[0] = args.in[4]; F.w_in[1] = args.in[5]; F.w_out[1] = args.in[6]; F.w_in[2] = args.in[7]; F.w_out[2] = args.in[8]; F.w_in[3] = args.in[9]; F.w_out[3] = args.in[10];
    F.lb_logits = args.in[11]; F.H = args.out;
    F.cos128 = (float*)(ws + WS_TAB); F.sin128 = F.cos128 + 2048 * 64; F.cos64 = F.sin128 + 2048 * 64; F.sin64 = F.cos64 + 2048 * 32; F.lb = F.sin64 + 2048 * 32;
    F.ssq = (float*)(ws + WS_SSQ); F.mask = (unsigned*)(ws + WS_MASK);
    F.WIN = (bf16*)(ws + WS_WIN); F.WOUT = (bf16*)(ws + WS_WOUT); F.U = (bf16*)(ws + WS_U); F.P = (bf16*)(ws + WS_P);
    for (int u = threadIdx.x; u < (LDS_BYTES - RING_BYTES) / 4; u += NWAVES * 64) ((LAS unsigned*)(F.lds + RING_BYTES))[u] = 0u;
    __syncthreads();
    const XcdBarrier bar = xcd_barrier_post(F.ctl + CW_BAR, F.MISC + 8);
    make_tables(F); norm_rows(F, F.x, F.norm_g, nullptr); conv_weights<0>(F);
    xcd_barrier(bar);
    layer_phases<0>(F, bar);
    layer_phases<1>(F, bar);
    layer_phases<2>(F, bar);
    layer_phases<3>(F, bar);
}

extern "C" void kernel_launch(void* const* d_in, const int* in_sizes, int n_in, void* d_out, int out_size, void* d_ws, size_t ws_size, hipStream_t stream) {
    static int grid = 0;
    if (grid == 0) {
        int dev = 0, cus = 0;
        if (hipGetDevice(&dev) != hipSuccess || hipDeviceGetAttribute(&cus, hipDeviceAttributeMultiprocessorCount, dev) != hipSuccess) { grid = -1; return; }
        if (hipFuncSetAttribute((const void*)mega_fwd, hipFuncAttributeMaxDynamicSharedMemorySize, LDS_BYTES) != hipSuccess) { grid = -1; return; }
        int per_cu = 0; (void)hipOccupancyMaxActiveBlocksPerMultiprocessor(&per_cu, (const void*)mega_fwd, NWAVES * 64, LDS_BYTES); (void)hipGetLastError();
        if (cus < 256) { fprintf(stderr, "kernel_launch: needs 256 CUs\n"); grid = -1; return; }
        grid = 256;
        if (ws_size < WS_END || n_in != 12) { fprintf(stderr, "kernel_launch: unexpected workspace / inputs\n"); grid = -1; return; }
    }
    if (grid < 0) return;
    (void)hipMemsetAsync((char*)d_ws + WS_CTL, 0, CTL_ZERO_BYTES, stream);
    Args a; for (int i = 0; i < 12; ++i) a.in[i] = (const float*)d_in[i];
    a.out = (float*)d_out; a.ws = (unsigned char*)d_ws;
    hipLaunchKernelGGL(mega_fwd, dim3(grid), dim3(NWAVES * 64), LDS_BYTES, stream, a);
}
```
